# Optimizing an MI355X kernel written in HIP

```python
import math
import jax
import jax.numpy as jnp
from jax import lax
import numpy as np

D_MODEL = 2048
BATCH = 1
SEQ = 8192
DEPTH = 4
DEC_BATCH = 16
DEC_SEQ = 16
PAST_LEN = 1024

CHUNK = 64
Q_BLOCK = 128
N_EVEN = (DEPTH + 1) // 2
N_ODD = DEPTH // 2
EPS = 1e-6
D_RNN = D_MODEL // 2
LRU_BLOCKS = 16
LRU_BW = D_RNN // LRU_BLOCKS
CONV_W = 4
LRU_C = 8.0
B_HEADS = 8
B_DH = 64
B_W = B_HEADS * 2 * B_DH
EVEN_IN = 2 * D_RNN + 3 * B_W
MIX_W = D_RNN + B_W
N_BUCKETS = 32
MAX_DIST = 512
GMLP_CHUNK = 128
D_C = D_MODEL
C_GROUPS = 16
C_GW = D_C // C_GROUPS
D_FF = 4 * D_MODEL

kernel_name = 'hybrid_rglru_diffattn_gmlp_stream_step'


def rms_norm(x, w):
    xf = x.astype(jnp.float32)
    y = xf * lax.rsqrt(jnp.mean(xf * xf, axis=-1, keepdims=True) + EPS)
    return (y * w.astype(jnp.float32)).astype(x.dtype)


def rel_bucket(rel):
    nb = N_BUCKETS // 2
    max_exact = nb // 2
    n = jnp.abs(rel)
    nf = jnp.maximum(n, 1).astype(jnp.float32)
    large = max_exact + (jnp.log(nf / max_exact) / math.log(MAX_DIST / max_exact)
                         * (nb - max_exact)).astype(jnp.int32)
    large = jnp.minimum(large, nb - 1)
    return jnp.where(rel > 0, nb, 0) + jnp.where(n < max_exact, n, large)


def rel_bias(bias_table, qpos, kpos):
    b = bias_table[rel_bucket(kpos[None, :] - qpos[:, None])]
    return jnp.transpose(b, (2, 0, 1)).astype(jnp.float32)


def causal_conv(xr, prev, w, b):
    T = xr.shape[1]
    xp = jnp.concatenate([prev.astype(xr.dtype), xr], axis=1)
    y = b + sum(xp[:, j:j + T] * w[j] for j in range(CONV_W))
    return y, xp[:, -(CONV_W - 1):]


def rg_lru(xc, h0, wa, ba, wx, bx, lru_lambda):
    B, T, _ = xc.shape
    xf = xc.astype(jnp.float32)
    xg = xf.reshape(B, T, LRU_BLOCKS, LRU_BW)
    r = jax.nn.sigmoid(jnp.einsum('btgi,gij->btgj', xg, wa.astype(jnp.float32)).reshape(B, T, D_RNN)
                       + ba.astype(jnp.float32))
    i = jax.nn.sigmoid(jnp.einsum('btgi,gij->btgj', xg, wx.astype(jnp.float32)).reshape(B, T, D_RNN)
                       + bx.astype(jnp.float32))
    log_a = -LRU_C * r * jax.nn.softplus(-lru_lambda.astype(jnp.float32))
    a = jnp.exp(log_a)
    u = jnp.sqrt(-jnp.expm1(2.0 * log_a)) * (i * xf)
    u = u.at[:, 0].add(a[:, 0] * h0.astype(jnp.float32))

    def combine(left, right):
        a_l, b_l = left
        a_r, b_r = right
        return a_l * a_r, a_r * b_l + b_r

    _, h = lax.associative_scan(combine, (a, u), axis=1)
    return h, h[:, -1]


def diff_attention(q, k, v, bias, mask, lam, subln_w, lam_init):
    q = q.astype(jnp.float32)
    k = k.astype(jnp.float32)
    v = v.astype(jnp.float32)
    scale = B_DH ** -0.5
    s1 = jnp.einsum('bqhd,bkhd->bhqk', q[..., :B_DH], k[..., :B_DH]) * scale + bias
    s2 = jnp.einsum('bqhd,bkhd->bhqk', q[..., B_DH:], k[..., B_DH:]) * scale + bias
    if mask is not None:
        s1 = jnp.where(mask, s1, -1e30)
        s2 = jnp.where(mask, s2, -1e30)
    p = jax.nn.softmax(s1, axis=-1) - lam * jax.nn.softmax(s2, axis=-1)
    o = jnp.einsum('bhqk,bkhd->bqhd', p, v)
    return rms_norm(o, subln_w) * (1.0 - lam_init)


def prompt_diff_attention(q, k, v, lam, subln_w, lam_init, bias_table):
    B, S, H, E = q.shape
    nb = S // Q_BLOCK
    kf = k.astype(jnp.float32)
    vf = v.astype(jnp.float32)
    qb = jnp.transpose(q.reshape(B, nb, Q_BLOCK, H, E), (1, 0, 2, 3, 4))
    kpos = jnp.arange(S)

    def block(args):
        bi, qi = args
        qpos = bi * Q_BLOCK + jnp.arange(Q_BLOCK)
        bias = rel_bias(bias_table, qpos, kpos)[None]
        mask = (kpos[None, :] // CHUNK) <= (qpos[:, None] // CHUNK)
        return diff_attention(qi, kf, vf, bias, mask, lam, subln_w, lam_init)

    o = lax.map(block, (jnp.arange(nb), qb))
    return jnp.transpose(o, (1, 0, 2, 3, 4)).reshape(B, S, H, E)


def even_mixer(h, conv_prev, h_prev, k_cache, v_cache, lam_init, w_in, w_out, conv_w, conv_b,
               wa, ba, wx, bx, lru_lambda, lam_vecs, subln_w, bias_table):
    B, T, _ = h.shape
    proj = h @ w_in
    g = proj[..., :D_RNN]
    xr = proj[..., D_RNN:2 * D_RNN]
    qkv = proj[..., 2 * D_RNN:].reshape(B, T, 3, B_HEADS, 2 * B_DH)
    q, k, v = qkv[:, :, 0], qkv[:, :, 1], qkv[:, :, 2]
    if conv_prev is None:
        conv_prev = jnp.zeros((B, CONV_W - 1, D_RNN), xr.dtype)
    if h_prev is None:
        h_prev = jnp.zeros((B, D_RNN), jnp.float32)
    xc, conv_new = causal_conv(xr, conv_prev, conv_w, conv_b)
    hs, h_last = rg_lru(xc, h_prev, wa, ba, wx, bx, lru_lambda)
    ya = (jax.nn.gelu(g.astype(jnp.float32)) * hs).astype(h.dtype)
    lv = lam_vecs.astype(jnp.float32)
    lam = jnp.exp(jnp.sum(lv[0] * lv[1])) - jnp.exp(jnp.sum(lv[2] * lv[3])) + lam_init
    if k_cache is None:
        yb = prompt_diff_attention(q, k, v, lam, subln_w, lam_init, bias_table)
    else:
        P = k_cache.shape[1]
        kk = jnp.concatenate([k_cache.astype(k.dtype), k], axis=1)
        vv = jnp.concatenate([v_cache.astype(v.dtype), v], axis=1)
        qpos = P + jnp.arange(T)
        kpos = jnp.arange(P + T)
        bias = rel_bias(bias_table, qpos, kpos)[None]
        yb = diff_attention(q, kk, vv, bias, None, lam, subln_w, lam_init)
    yb = yb.reshape(B, T, B_W).astype(h.dtype)
    y = jnp.concatenate([ya, yb], axis=-1) @ w_out
    return y, conv_new, h_last.astype(h.dtype), k, v


def odd_mixer(h, w_in, w_out, vnorm_w, w_s, b_s):
    B, T, _ = h.shape
    z = jax.nn.gelu(h @ w_in)
    u = z[..., :D_C]
    v = rms_norm(z[..., D_C:], vnorm_w)
    L = min(T, GMLP_CHUNK)
    n = T // L
    tri = jnp.tril(jnp.ones((GMLP_CHUNK, GMLP_CHUNK), w_s.dtype))
    ws = (w_s * tri)[:, :L, :L]
    vg = v.reshape(B, n, L, C_GROUPS, C_GW)
    mix = jnp.einsum('gts,bnsgc->bntgc', ws, vg) + jnp.transpose(b_s[:, :L])[None, None, :, :, None]
    y = (u * mix.reshape(B, T, D_C)) @ w_out
    return y, v


def sq_relu_mlp(h, w_up, w_down):
    return jnp.square(jax.nn.relu(h @ w_up)) @ w_down


def setup_inputs(seed: int = 0) -> dict:
    key = jax.random.key(seed)
    ks = jax.random.split(key, 32)
    f32 = jnp.float32
    nrm = lambda k, s, sc: jax.random.normal(k, s, f32) * sc
    a = jax.random.uniform(ks[12], (N_EVEN, D_RNN), f32, minval=0.9, maxval=0.999)
    return {
        'x_prompt': nrm(ks[0], (BATCH, SEQ, D_MODEL), 1.0),
        'x_sample': nrm(ks[1], (DEC_BATCH, DEC_SEQ, D_MODEL), 1.0),
        'state_conv': nrm(ks[2], (N_EVEN, DEC_BATCH, CONV_W - 1, D_RNN), 1.0),
        'state_lru': nrm(ks[3], (N_EVEN, DEC_BATCH, D_RNN), 0.5),
        'cache_k': nrm(ks[4], (N_EVEN, DEC_BATCH, PAST_LEN, B_HEADS, 2 * B_DH), 1.0),
        'cache_v': nrm(ks[5], (N_EVEN, DEC_BATCH, PAST_LEN, B_HEADS, 2 * B_DH), 1.0),
        'w_even_in': nrm(ks[6], (N_EVEN, D_MODEL, EVEN_IN), D_MODEL ** -0.5),
        'w_even_out': nrm(ks[7], (N_EVEN, MIX_W, D_MODEL), MIX_W ** -0.5),
        'conv_w': nrm(ks[8], (N_EVEN, CONV_W, D_RNN), CONV_W ** -0.5),
        'conv_b': nrm(ks[9], (N_EVEN, D_RNN), 0.01),
        'lru_wa': nrm(ks[10], (N_EVEN, LRU_BLOCKS, LRU_BW, LRU_BW), LRU_BW ** -0.5),
        'lru_ba': nrm(ks[11], (N_EVEN, D_RNN), 0.01),
        'lru_wx': nrm(ks[13], (N_EVEN, LRU_BLOCKS, LRU_BW, LRU_BW), LRU_BW ** -0.5),
        'lru_bx': nrm(ks[14], (N_EVEN, D_RNN), 0.01),
        'lru_lambda': jnp.log(a) - jnp.log1p(-a),
        'lam_vecs': nrm(ks[15], (N_EVEN, 4, B_DH), 0.1),
        'subln_w': 1.0 + nrm(ks[16], (N_EVEN, 2 * B_DH), 0.01),
        'rel_bias_table': nrm(ks[17], (N_BUCKETS, B_HEADS), 0.1),
        'w_odd_in': nrm(ks[18], (N_ODD, D_MODEL, 2 * D_C), D_MODEL ** -0.5),
        'w_odd_out': nrm(ks[19], (N_ODD, D_C, D_MODEL), D_C ** -0.5),
        'gmlp_vnorm_w': 1.0 + nrm(ks[20], (N_ODD, D_C), 0.01),
        'gmlp_ws': nrm(ks[21], (N_ODD, C_GROUPS, GMLP_CHUNK, GMLP_CHUNK), GMLP_CHUNK ** -0.5),
        'gmlp_bs': 1.0 + nrm(ks[22], (N_ODD, C_GROUPS, GMLP_CHUNK), 0.1),
        'norm_mix_w': 1.0 + nrm(ks[23], (DEPTH, D_MODEL), 0.01),
        'norm_ffn_w': 1.0 + nrm(ks[24], (DEPTH, D_MODEL), 0.01),
        'norm_final_w': 1.0 + nrm(ks[25], (D_MODEL,), 0.01),
        'w_ff_up': nrm(ks[26], (DEPTH, D_MODEL, D_FF), D_MODEL ** -0.5),
        'w_ff_down': nrm(ks[27], (DEPTH, D_FF, D_MODEL), D_FF ** -0.5),
    }


def reference(x_prompt, x_sample, state_conv, state_lru, cache_k, cache_v,
              w_even_in, w_even_out, conv_w, conv_b, lru_wa, lru_ba, lru_wx, lru_bx,
              lru_lambda, lam_vecs, subln_w, rel_bias_table, w_odd_in, w_odd_out,
              gmlp_vnorm_w, gmlp_ws, gmlp_bs, norm_mix_w, norm_ffn_w, norm_final_w,
              w_ff_up, w_ff_down):
    yp, ys = x_prompt, x_sample
    p_conv, p_lru, p_k, p_v = [], [], [], []
    s_conv, s_lru, s_k, s_v, s_gv = [], [], [], [], []
    for l in range(DEPTH):
        if l % 2 == 0:
            e = l // 2
            lam_init = 0.8 - 0.6 * math.exp(-0.3 * l)
            ew = (w_even_in[e], w_even_out[e], conv_w[e], conv_b[e], lru_wa[e], lru_ba[e],
                  lru_wx[e], lru_bx[e], lru_lambda[e], lam_vecs[e], subln_w[e], rel_bias_table)
            mp, c, hl, k, v = even_mixer(rms_norm(yp, norm_mix_w[l]), None, None, None, None,
                                         lam_init, *ew)
            p_conv.append(c); p_lru.append(hl); p_k.append(k); p_v.append(v)
            ms, c, hl, k, v = even_mixer(rms_norm(ys, norm_mix_w[l]), state_conv[e], state_lru[e],
                                         cache_k[e], cache_v[e], lam_init, *ew)
            s_conv.append(c); s_lru.append(hl); s_k.append(k); s_v.append(v)
        else:
            o = l // 2
            cw = (w_odd_in[o], w_odd_out[o], gmlp_vnorm_w[o], gmlp_ws[o], gmlp_bs[o])
            mp, _ = odd_mixer(rms_norm(yp, norm_mix_w[l]), *cw)
            ms, gv = odd_mixer(rms_norm(ys, norm_mix_w[l]), *cw)
            s_gv.append(gv)
        yp = yp + mp
        ys = ys + ms
        yp = yp + sq_relu_mlp(rms_norm(yp, norm_ffn_w[l]), w_ff_up[l], w_ff_down[l])
        ys = ys + sq_relu_mlp(rms_norm(ys, norm_ffn_w[l]), w_ff_up[l], w_ff_down[l])
    yp = rms_norm(yp, norm_final_w)
    ys = rms_norm(ys, norm_final_w)
    return (yp, ys, jnp.stack(p_conv), jnp.stack(p_lru), jnp.stack(p_k), jnp.stack(p_v),
            jnp.stack(s_conv), jnp.stack(s_lru), jnp.stack(s_k), jnp.stack(s_v), jnp.stack(s_gv))
```

```cpp
#include <hip/hip_runtime.h>
#include <cstdio>
#include <cstdint>
namespace pg8 {
#define PG8_LAS __attribute__((address_space(3)))
typedef unsigned short bf16_t;
typedef short bf16x8 __attribute__((ext_vector_type(8)));
typedef float f32x4 __attribute__((ext_vector_type(4)));
typedef unsigned u32x4 __attribute__((ext_vector_type(4)));
constexpr int BM = 256, BK = 64, HALF = 128, HTB = HALF * BK * 2  , STAGE_BYTES = 8 * HTB, NXCD = 8, WGM = 8;

__host__ __device__ __forceinline__ int lds_byte(int r, int c) { const int st = (r >> 4) * 2 + (c >> 5), rr = r & 15, cc = c & 31, ob = rr * 64 + cc * 2; return st * 1024 + (ob ^ (((ob >> 9) & 1) << 5)); }
__host__ __device__ __forceinline__ void stage_rc(int b, int& R, int& C) { const int st = b / 1024, sb = b % 1024, swz = sb ^ (((sb >> 9) & 1) << 5); R = (st >> 1) * 16 + swz / 64; C = (st & 1) * 32 + (swz % 64) / 2; }
__host__ __device__ __forceinline__ int perm32(int rho) { const int n = rho >> 4, i = rho & 15; return 8 * (i >> 2) + 4 * n + (i & 3); }

struct Unit { int pm, pn; };
struct Gemm { const bf16_t* A; const bf16_t* Bt; int M, N, K; };

struct StaticOrder {
    int nM, nN, nwg, G, c;
    __host__ __device__ void init(int M, int N, int G_, int c_) { nM = M / BM; nN = N / BM; nwg = nM * nN; G = G_; c = c_; }
    __host__ __device__ bool next(int i, Unit& u) const {
        const long L = (long)i * G + c; if (L >= nwg) return false;
        int wgid = (int)L; { const int q = nwg / NXCD, r = nwg % NXCD, xcd = wgid % NXCD, off = wgid / NXCD; wgid = (xcd < r ? xcd * (q + 1) : r * (q + 1) + (xcd - r) * q) + off; }
        const int nig = WGM * nN, gid = wgid / nig, fm = gid * WGM, gsz = (nM - fm) < WGM ? (nM - fm) : WGM;
        u.pm = fm + ((wgid % nig) % gsz); u.pn = (wgid % nig) / gsz; return true;
    }
    __device__ __forceinline__ void a_ready(const Unit&) const {}
    __device__ __forceinline__ void done(const Unit&) const {}
};

__device__ __forceinline__ unsigned cvt_pk_bf16(float lo, float hi) { unsigned r; asm volatile("v_cvt_pk_bf16_f32 %0, %1, %2" : "=v"(r) : "v"(lo), "v"(hi)); return r; }
typedef float f32x2 __attribute__((ext_vector_type(2)));
constexpr float RMS_EPS = 1e-6f;
constexpr float QSCALE = 0.125f * 1.4426950408889634f;
__device__ __forceinline__ float gelu_tanh(float x) {
    const float k = -2.0f * 0.7978845608028654f * 1.4426950408889634f;
    const float t = x * (1.0f + 0.044715f * x * x);
    const float e = __builtin_amdgcn_exp2f(k * t);
    return x * __builtin_amdgcn_rcpf(1.0f + e);
}
__device__ __forceinline__ u32x4 pack8(const f32x4 a, const f32x4 b) { u32x4 w; w.x = cvt_pk_bf16(a[0], a[1]); w.y = cvt_pk_bf16(a[2], a[3]); w.z = cvt_pk_bf16(b[0], b[1]); w.w = cvt_pk_bf16(b[2], b[3]); return w; }
__device__ __forceinline__ float dot8(const f32x4 a, const f32x4 b) { return (a[0] * a[0] + a[1] * a[1]) + (a[2] * a[2] + a[3] * a[3]) + (b[0] * b[0] + b[1] * b[1]) + (b[2] * b[2] + b[3] * b[3]); }
__device__ __forceinline__ void atomic_addf(float* p, float v) { __hip_atomic_fetch_add(p, v, __ATOMIC_RELAXED, __HIP_MEMORY_SCOPE_AGENT); }

struct EpiEvenIn {
    static constexpr bool PERM = true, AFTER_DRAIN = false;
    const float* ssq; unsigned char* tb  ; float* out; int e;
    __device__ __forceinline__ void operator()(const f32x4 (&acc)[2][2][4][2], const Unit& u, int wr, int wc, int fr, int fq) const {
        const int reg = u.pn >> 2;
        const int row0 = u.pm * BM + wr * 64 + fr, c0 = (u.pn & 3) * 256 + wc * 32 + 8 * fq;
        bf16_t* G = (bf16_t*)tb; float* XR = (float*)(tb + ((size_t)17 << 20)); bf16_t* Q = (bf16_t*)(tb + ((size_t)50 << 20));
        float rs[2][4];
#pragma unroll
        for (int ai = 0; ai < 2; ++ai)
#pragma unroll
            for (int m = 0; m < 4; ++m) rs[ai][m] = __builtin_amdgcn_rsqf(ssq[row0 + ai * HALF + m * 16] * (1.0f / 2048.0f) + RMS_EPS);
        if (reg == 0) {
#pragma unroll
            for (int ai = 0; ai < 2; ++ai)
#pragma unroll
                for (int m = 0; m < 4; ++m) { const size_t row = (size_t)(row0 + ai * HALF + m * 16); const float r = rs[ai][m];
#pragma unroll
                    for (int bj = 0; bj < 2; ++bj) { f32x4 v0 = acc[ai][bj][m][0] * r, v1 = acc[ai][bj][m][1] * r;
#pragma unroll
                        for (int i = 0; i < 4; ++i) { v0[i] = gelu_tanh(v0[i]); v1[i] = gelu_tanh(v1[i]); }
                        *(u32x4*)(G + row * 1024 + c0 + bj * HALF) = pack8(v0, v1); } }
        } else if (reg == 1) {
#pragma unroll
            for (int ai = 0; ai < 2; ++ai)
#pragma unroll
                for (int m = 0; m < 4; ++m) { const size_t row = (size_t)(row0 + ai * HALF + m * 16); const float r = rs[ai][m];
#pragma unroll
                    for (int bj = 0; bj < 2; ++bj) { float* p = XR + row * 1024 + c0 + bj * HALF; *(f32x4*)p = acc[ai][bj][m][0] * r; *(f32x4*)(p + 4) = acc[ai][bj][m][1] * r; } }
        } else if (reg == 2) {
#pragma unroll
            for (int ai = 0; ai < 2; ++ai)
#pragma unroll
                for (int m = 0; m < 4; ++m) { const size_t row = (size_t)(row0 + ai * HALF + m * 16); const float r = rs[ai][m] * QSCALE;
#pragma unroll
                    for (int bj = 0; bj < 2; ++bj) *(u32x4*)(Q + row * 1024 + c0 + bj * HALF) = pack8(acc[ai][bj][m][0] * r, acc[ai][bj][m][1] * r); }
        } else {
            bf16_t* B = (bf16_t*)(tb + ((size_t)(reg == 3 ? 67 : 84) << 20));
            const size_t ooff = (u.pm < 32) ? (size_t)(reg == 3 ? 17309696 : 34086912) + (size_t)e * 8192 * 1024 : (size_t)(reg == 3 ? 50995200 : 51519488) + (size_t)e * 256 * 1024;
            float* O = out + ooff; const int orow0 = (u.pm < 32) ? row0 : row0 - 8192;
#pragma unroll
            for (int ai = 0; ai < 2; ++ai)
#pragma unroll
                for (int m = 0; m < 4; ++m) { const size_t row = (size_t)(row0 + ai * HALF + m * 16), orow = (size_t)(orow0 + ai * HALF + m * 16); const float r = rs[ai][m];
#pragma unroll
                    for (int bj = 0; bj < 2; ++bj) { const f32x4 v0 = acc[ai][bj][m][0] * r, v1 = acc[ai][bj][m][1] * r;
                        *(u32x4*)(B + row * 1024 + c0 + bj * HALF) = pack8(v0, v1);
                        float* p = O + orow * 1024 + c0 + bj * HALF; *(f32x4*)p = v0; *(f32x4*)(p + 4) = v1; } }
        }
    }
};
struct EpiResid {
    static constexpr bool PERM = true, AFTER_DRAIN = false;
    float* X; bf16_t* Xb; float* ssq_next;
    __device__ __forceinline__ void operator()(const f32x4 (&acc)[2][2][4][2], const Unit& u, int wr, int wc, int fr, int fq) const {
        const int row0 = u.pm * BM + wr * 64 + fr, c0 = u.pn * BM + wc * 32 + 8 * fq;
#pragma unroll
        for (int ai = 0; ai < 2; ++ai)
#pragma unroll
            for (int m = 0; m < 4; ++m) { const size_t row = (size_t)(row0 + ai * HALF + m * 16); float s = 0.f;
#pragma unroll
                for (int bj = 0; bj < 2; ++bj) { float* p = X + row * 2048 + c0 + bj * HALF;
                    const f32x4 x0 = *(const f32x4*)p + acc[ai][bj][m][0], x1 = *(const f32x4*)(p + 4) + acc[ai][bj][m][1];
                    *(f32x4*)p = x0; *(f32x4*)(p + 4) = x1; *(u32x4*)(Xb + row * 2048 + c0 + bj * HALF) = pack8(x0, x1); s += dot8(x0, x1); }
                s += __shfl_xor(s, 16); s += __shfl_xor(s, 32);
                if (fq == 0) atomic_addf(ssq_next + row, s); }
    }
};
struct EpiUp {
    static constexpr bool PERM = true, AFTER_DRAIN = false;
    const float* ssq; bf16_t* H;
    __device__ __forceinline__ void operator()(const f32x4 (&acc)[2][2][4][2], const Unit& u, int wr, int wc, int fr, int fq) const {
        const int row0 = u.pm * BM + wr * 64 + fr, c0 = u.pn * BM + wc * 32 + 8 * fq;
#pragma unroll
        for (int ai = 0; ai < 2; ++ai)
#pragma unroll
            for (int m = 0; m < 4; ++m) { const size_t row = (size_t)(row0 + ai * HALF + m * 16); const float r = __builtin_amdgcn_rsqf(ssq[row] * (1.0f / 2048.0f) + RMS_EPS);
#pragma unroll
                for (int bj = 0; bj < 2; ++bj) { f32x4 v0 = acc[ai][bj][m][0] * r, v1 = acc[ai][bj][m][1] * r;
#pragma unroll
                    for (int i = 0; i < 4; ++i) { const float a = fmaxf(v0[i], 0.f), b = fmaxf(v1[i], 0.f); v0[i] = a * a; v1[i] = b * b; }
                    *(u32x4*)(H + row * 8192 + c0 + bj * HALF) = pack8(v0, v1); } }
    }
};
struct EpiOddIn {
    static constexpr bool PERM = true, AFTER_DRAIN = false;
    const float* ssq; bf16_t* U; bf16_t* VR; float* ssqv;
    __device__ __forceinline__ void operator()(const f32x4 (&acc)[2][2][4][2], const Unit& u, int wr, int wc, int fr, int fq) const {
        const int reg = u.pn >> 3;
        const int row0 = u.pm * BM + wr * 64 + fr, c0 = (u.pn & 7) * 256 + wc * 32 + 8 * fq;
        bf16_t* B = reg ? VR : U;
#pragma unroll
        for (int ai = 0; ai < 2; ++ai)
#pragma unroll
            for (int m = 0; m < 4; ++m) { const size_t row = (size_t)(row0 + ai * HALF + m * 16); const float r = __builtin_amdgcn_rsqf(ssq[row] * (1.0f / 2048.0f) + RMS_EPS); float s = 0.f;
#pragma unroll
                for (int bj = 0; bj < 2; ++bj) { f32x4 v0 = acc[ai][bj][m][0] * r, v1 = acc[ai][bj][m][1] * r;
#pragma unroll
                    for (int i = 0; i < 4; ++i) { v0[i] = gelu_tanh(v0[i]); v1[i] = gelu_tanh(v1[i]); }
                    *(u32x4*)(B + row * 2048 + c0 + bj * HALF) = pack8(v0, v1); s += dot8(v0, v1); }
                if (reg) { s += __shfl_xor(s, 16); s += __shfl_xor(s, 32); if (fq == 0) atomic_addf(ssqv + row, s); } }
    }
};
template <class Epi, class Sched, bool ALIGN_EPI = false, bool SP2 = false>
__device__ __forceinline__ void gemm_phase(PG8_LAS unsigned char* lds, const Gemm g, const Sched& S, const Epi& E) {
    int tid_ = threadIdx.x; asm volatile("" : "+v"(tid_));
    const int tid = tid_, wid = __builtin_amdgcn_readfirstlane(tid >> 6), lane = tid & 63, wr = wid >> 2, wc = wid & 3, fr = lane & 15, fq = lane >> 4;
    const int K = g.K, nt = K / BK;
    unsigned voffA[2], voffB[2];
#pragma unroll
    for (int i = 0; i < 2; ++i) { int R, C; stage_rc(tid * 16 + i * 8192, R, C); const int Rb = Epi::PERM ? ((R & ~31) + perm32(R & 31)) : R;
        voffA[i] = (unsigned)(R * K + C) * 2u; voffB[i] = (unsigned)(Rb * K + C) * 2u; }
    const size_t kstep = (size_t)(BK * 2);
    const size_t hstep = (size_t)HALF * K * 2;
    const size_t tstep = 2 * hstep;
    const unsigned ldsw = (unsigned)wid * 1024u;
    const int aoff = lds_byte(wr * 64 + fr, fq * 8), boff = lds_byte(wc * 32 + fr, fq * 8);
#define PG8_SA(b, h) (((b) * 2 + (h)) * HTB)
#define PG8_SB(b, h) ((4 + (b) * 2 + (h)) * HTB)
#define PG8_STAGE(bufoff, gbase, voff) do { _Pragma("unroll") for (int _i = 0; _i < 2; ++_i) \
        __builtin_amdgcn_global_load_lds((const unsigned*)((const char*)(gbase) + (voff)[_i]), (PG8_LAS unsigned*)(lds + (bufoff) + ldsw + _i * 8192), 16, 0, 0); } while (0)
#define PG8_LDA(dst, b, h) do { _Pragma("unroll") for (int m = 0; m < 4; ++m) _Pragma("unroll") for (int k = 0; k < 2; ++k) dst[m][k] = *(const PG8_LAS bf16x8*)(lds + PG8_SA(b, h) + aoff + m * 2048 + k * 1024); } while (0)
#define PG8_LDB(dst, b, h) do { _Pragma("unroll") for (int n = 0; n < 2; ++n) _Pragma("unroll") for (int k = 0; k < 2; ++k) dst[n][k] = *(const PG8_LAS bf16x8*)(lds + PG8_SB(b, h) + boff + n * 2048 + k * 1024); } while (0)
#define PG8_MMA(ai, bj, At, Bt) do { __builtin_amdgcn_s_setprio(1); _Pragma("unroll") for (int m = 0; m < 4; ++m) _Pragma("unroll") for (int n = 0; n < 2; ++n) _Pragma("unroll") for (int k = 0; k < 2; ++k) \
        acc[ai][bj][m][n] = __builtin_amdgcn_mfma_f32_16x16x32_bf16(Bt[n][k], At[m][k], acc[ai][bj][m][n], 0, 0, 0); __builtin_amdgcn_s_setprio(0); } while (0)
#define PG8_WAIT_V(n) asm volatile("s_waitcnt vmcnt(" #n ")" ::: "memory")
#define PG8_WAIT_L(n) asm volatile("s_waitcnt lgkmcnt(" #n ")" ::: "memory")
#define PG8_BAR __builtin_amdgcn_s_barrier()
#define PG8_SCHED __builtin_amdgcn_sched_barrier(0)
    Unit cur, nxt; int ui = 0;
    if (!S.next(0, cur)) return;
    f32x4 acc[2][2][4][2];
#pragma unroll
    for (int a = 0; a < 2; ++a)
#pragma unroll
        for (int b = 0; b < 2; ++b)
#pragma unroll
            for (int m = 0; m < 4; ++m)
#pragma unroll
                for (int n = 0; n < 2; ++n) acc[a][b][m][n] = (f32x4){0.f, 0.f, 0.f, 0.f};
    bf16x8 At[4][2], B0[2][2], B1[2][2];
    const char* cA = (const char*)g.A + (size_t)cur.pm * tstep; const char* cB = (const char*)g.Bt + (size_t)cur.pn * tstep;
    S.a_ready(cur);
    if constexpr (SP2) {
        PG8_STAGE(PG8_SB(0, 0), cB, voffB); PG8_STAGE(PG8_SB(0, 1), cB + hstep, voffB); PG8_STAGE(PG8_SA(0, 0), cA, voffA); PG8_STAGE(PG8_SA(0, 1), cA + hstep, voffA);
        if (wr == 1) PG8_BAR;
        PG8_WAIT_V(2); PG8_BAR;
        PG8_STAGE(PG8_SB(1, 0), cB + kstep, voffB); PG8_STAGE(PG8_SA(1, 0), cA + kstep, voffA); PG8_STAGE(PG8_SB(1, 1), cB + hstep + kstep, voffB);
        PG8_WAIT_V(6); PG8_BAR;
    } else {
        PG8_STAGE(PG8_SB(0, 0), cB, voffB); PG8_STAGE(PG8_SA(0, 0), cA, voffA); PG8_STAGE(PG8_SB(0, 1), cB + hstep, voffB); PG8_STAGE(PG8_SA(0, 1), cA + hstep, voffA);
        if (wr == 1) PG8_BAR;
        PG8_WAIT_V(4); PG8_BAR;
        PG8_STAGE(PG8_SB(1, 0), cB + kstep, voffB); PG8_STAGE(PG8_SA(1, 0), cA + kstep, voffA); PG8_STAGE(PG8_SB(1, 1), cB + hstep + kstep, voffB);
        PG8_WAIT_V(6); PG8_BAR;
    }
    for (;;) {
        const bool has_next = S.next(ui + 1, nxt);
        const char* nA = has_next ? (const char*)g.A + (size_t)nxt.pm * tstep : cA; const char* nB = has_next ? (const char*)g.Bt + (size_t)nxt.pn * tstep : cB;
        for (int t = 0; t < nt; t += 2) {
            const bool last = (t == nt - 2);
            const char* a1 = cA + (size_t)(t + 1) * kstep;
            const char* a2 = last ? nA : cA + (size_t)(t + 2) * kstep; const char* b2 = last ? nB : cB + (size_t)(t + 2) * kstep;
            const char* a3 = a2 + kstep; const char* b3 = b2 + kstep;
            if (last && has_next) S.a_ready(nxt);
            if constexpr (SP2) {
            PG8_LDB(B0, 0, 0); PG8_LDB(B1, 0, 1); PG8_SCHED; PG8_LDA(At, 0, 0); PG8_STAGE(PG8_SA(1, 1), a1 + hstep, voffA);
            PG8_WAIT_V(8); PG8_WAIT_L(0); PG8_BAR; PG8_MMA(0, 0, At, B0); PG8_MMA(0, 1, At, B1); PG8_BAR; PG8_SCHED;
            PG8_LDA(At, 0, 1); PG8_STAGE(PG8_SB(0, 0), b2, voffB); PG8_STAGE(PG8_SB(0, 1), b2 + hstep, voffB); PG8_STAGE(PG8_SA(0, 0), a2, voffA);
            PG8_WAIT_V(8); PG8_WAIT_L(0); PG8_BAR; PG8_MMA(1, 0, At, B0); PG8_MMA(1, 1, At, B1); PG8_BAR; PG8_SCHED;
            PG8_LDB(B0, 1, 0); PG8_LDB(B1, 1, 1); PG8_SCHED; PG8_LDA(At, 1, 0); PG8_STAGE(PG8_SA(0, 1), a2 + hstep, voffA);
            PG8_WAIT_V(8); PG8_WAIT_L(0); PG8_BAR; PG8_MMA(0, 0, At, B0); PG8_MMA(0, 1, At, B1); PG8_BAR; PG8_SCHED;
            PG8_LDA(At, 1, 1); PG8_STAGE(PG8_SB(1, 0), b3, voffB); PG8_STAGE(PG8_SB(1, 1), b3 + hstep, voffB); PG8_STAGE(PG8_SA(1, 0), a3, voffA);
            PG8_WAIT_V(8); PG8_WAIT_L(0); PG8_BAR; PG8_MMA(1, 0, At, B0); PG8_MMA(1, 1, At, B1); PG8_BAR; PG8_SCHED;
            } else {
            PG8_LDB(B0, 0, 0); PG8_SCHED; PG8_LDA(At, 0, 0); PG8_STAGE(PG8_SA(1, 1), a1 + hstep, voffA);
            PG8_WAIT_L(8); PG8_BAR; PG8_WAIT_L(0); PG8_MMA(0, 0, At, B0); PG8_BAR; PG8_SCHED;
            PG8_LDB(B1, 0, 1); PG8_STAGE(PG8_SB(0, 0), b2, voffB);
            PG8_BAR; PG8_WAIT_L(0); PG8_MMA(0, 1, At, B1); PG8_BAR;
            PG8_LDA(At, 0, 1); PG8_STAGE(PG8_SA(0, 0), a2, voffA);
            PG8_BAR; PG8_WAIT_L(0); PG8_MMA(1, 0, At, B0); PG8_BAR; PG8_SCHED;
            PG8_STAGE(PG8_SB(0, 1), b2 + hstep, voffB);
            PG8_WAIT_V(6); PG8_BAR; PG8_MMA(1, 1, At, B1); PG8_BAR;
            PG8_LDB(B0, 1, 0); PG8_SCHED; PG8_LDA(At, 1, 0); PG8_STAGE(PG8_SA(0, 1), a2 + hstep, voffA);
            PG8_WAIT_L(8); PG8_BAR; PG8_WAIT_L(0); PG8_MMA(0, 0, At, B0); PG8_BAR; PG8_SCHED;
            PG8_LDB(B1, 1, 1); PG8_STAGE(PG8_SB(1, 0), b3, voffB);
            PG8_BAR; PG8_WAIT_L(0); PG8_MMA(0, 1, At, B1); PG8_BAR;
            PG8_LDA(At, 1, 1); PG8_STAGE(PG8_SA(1, 0), a3, voffA);
            PG8_BAR; PG8_WAIT_L(0); PG8_MMA(1, 0, At, B0); PG8_BAR; PG8_SCHED;
            PG8_STAGE(PG8_SB(1, 1), b3 + hstep, voffB);
            PG8_WAIT_V(6); PG8_BAR; PG8_MMA(1, 1, At, B1); PG8_BAR;
            }
        }
        if constexpr (ALIGN_EPI) { if (wr == 0) PG8_BAR; }
        if constexpr (!Epi::AFTER_DRAIN) { E(acc, cur, wr, wc, fr, fq); S.done(cur); }
        if (!has_next) break;
#pragma unroll
        for (int a = 0; a < 2; ++a)
#pragma unroll
            for (int b = 0; b < 2; ++b)
#pragma unroll
                for (int m = 0; m < 4; ++m)
#pragma unroll
                    for (int n = 0; n < 2; ++n) acc[a][b][m][n] = (f32x4){0.f, 0.f, 0.f, 0.f};
        cur = nxt; cA = nA; cB = nB; ++ui;
        if constexpr (ALIGN_EPI) { if (wr == 1) PG8_BAR; }
    }
    PG8_WAIT_V(0);
    if constexpr (!ALIGN_EPI) { if (wr == 0) PG8_BAR; }
    PG8_BAR;
    if constexpr (Epi::AFTER_DRAIN) { E.fused(acc, cur, wr, wc, fr, fq, lds, wid, lane); S.done(cur); }
#undef PG8_SA
#undef PG8_SB
#undef PG8_STAGE
#undef PG8_LDA
#undef PG8_LDB
#undef PG8_MMA
#undef PG8_WAIT_V
#undef PG8_WAIT_L
#undef PG8_BAR
#undef PG8_SCHED
}
}

constexpr int DM = 2048, SEQ = 8192, NSMP = 256, MT = SEQ + NSMP  , DRNN = 1024, BW = 1024, DFF = 8192;
constexpr int NWAVES = 8;
constexpr float RMS_EPS = 1e-6f, LOG2E = 1.4426950408889634f;
constexpr size_t O_YP = 0, O_YS = O_YP + (size_t)SEQ * DM, O_PCONV = O_YS + (size_t)NSMP * DM, O_PLRU = O_PCONV + 2 * 3 * 1024, O_PK = O_PLRU + 2 * 1024, O_PV = O_PK + (size_t)2 * SEQ * 1024,
                 O_SCONV = O_PV + (size_t)2 * SEQ * 1024, O_SLRU = O_SCONV + 2 * 16 * 3 * 1024, O_SK = O_SLRU + 2 * 16 * 1024, O_SV = O_SK + (size_t)2 * NSMP * 1024, O_SGV = O_SV + (size_t)2 * NSMP * 1024,
                 O_END = O_SGV + (size_t)2 * NSMP * 2048;
constexpr size_t MiB = 1u << 20;
constexpr size_t WS_CTL = 0, CTL_ZERO_BYTES = 1 * MiB;
constexpr size_t WS_CS = 1 * MiB;
constexpr size_t WS_WAT = 2 * MiB, WS_WXT = WS_WAT + 256 * 1024, WS_WSB = 3 * MiB;
constexpr size_t WS_WEI = 4 * MiB, WS_WEO = 44 * MiB, WS_WOI = 60 * MiB, WS_WOO = 92 * MiB, WS_WUP = 108 * MiB, WS_WDN = 236 * MiB;
constexpr size_t WS_X = 364 * MiB, WS_XB = 430 * MiB, WS_YC = 463 * MiB;
constexpr size_t WS_T = 496 * MiB;
constexpr size_t WS_H = WS_T;
constexpr size_t WS_G = WS_T, WS_XR = WS_T + 17 * MiB, WS_Q = WS_T + 50 * MiB, WS_KB = WS_T + 67 * MiB, WS_VB = WS_T + 84 * MiB, WS_OS = WS_T + 101 * MiB;
constexpr size_t WS_U = WS_T, WS_VR = WS_T + 33 * MiB;
constexpr size_t WS_END = WS_T + 168 * MiB;
static_assert(WS_G == WS_T && WS_XR == WS_T + (17u << 20) && WS_Q == WS_T + (50u << 20) && WS_KB == WS_T + (67u << 20) && WS_VB == WS_T + (84u << 20), "EpiEvenIn offsets");
static_assert(O_PK == 17309696 && O_PV == 34086912 && O_SK == 50995200 && O_SV == 51519488, "EpiEvenIn output offsets");
constexpr int CW_TMO = 0, CW_CODE = 1, CW_BAR = 4096, CW_SSQ = 8192;
static_assert((CW_SSQ + 11 * MT) * 4 <= (int)CTL_ZERO_BYTES, "CTL");
constexpr int RING_BYTES = 131072, LDSCTL_OFF = RING_BYTES, MISC_OFF = LDSCTL_OFF + 320, LDS_BYTES = 147456;

#define GAS __attribute__((address_space(1)))
#define LAS __attribute__((address_space(3)))
typedef unsigned short bf16;
typedef unsigned v4u __attribute__((ext_vector_type(4)));
typedef float f32x4 __attribute__((ext_vector_type(4)));
typedef short bf16x8 __attribute__((ext_vector_type(8)));
typedef GAS unsigned gu32;
typedef GAS unsigned long long gu64;
#define RLX_AGENT __ATOMIC_RELAXED, __HIP_MEMORY_SCOPE_AGENT
#define LDS_WAIT() asm volatile("s_waitcnt lgkmcnt(0)" ::: "memory")
#define VM_WAIT() asm volatile("s_waitcnt vmcnt(0)" ::: "memory")
__device__ __forceinline__ unsigned long long rt() { return __builtin_amdgcn_s_memrealtime(); }
__device__ __forceinline__ unsigned f2bf(float f) { unsigned u = __builtin_bit_cast(unsigned, f); return (u + 0x7fffu + ((u >> 16) & 1u)) >> 16; }
__device__ __forceinline__ unsigned pk2(float lo, float hi) { return f2bf(lo) | (f2bf(hi) << 16); }

#define XB_TMO      128
#define XB_XCNT(j)  (256  + 64 * (j))
#define XB_XSUB(j)  (1280 + 64 * (j))
#define XB_XGEN(j)  (2304 + 64 * (j))
#define XB_TOP      3328
#define XB_TOPGEN   3392
#define XCD_BAR_WORDS 3456
#define XB_SPIN_CAP (1u << 18)

__device__ __forceinline__ unsigned xb_ld(unsigned* p)              { return __hip_atomic_load(p, __ATOMIC_RELAXED, __HIP_MEMORY_SCOPE_AGENT); }
__device__ __forceinline__ unsigned xb_add(unsigned* p, unsigned v) { return __hip_atomic_fetch_add(p, v, __ATOMIC_RELAXED, __HIP_MEMORY_SCOPE_AGENT); }
__device__ __forceinline__ unsigned xb_xcc_id() { return (unsigned)__builtin_amdgcn_s_getreg((3 << 11) | 20) & 0xFu; }
#define XB_SPIN(cond, bar) do { unsigned _sp = 0; while (cond) { __builtin_amdgcn_s_sleep(1); \
    if ((++_sp & 255u) == 0u) { if (xb_ld(&(bar)[XB_TMO])) break; if (_sp > XB_SPIN_CAP) { atomicAdd(&(bar)[XB_TMO], 1u); break; } } } } while (0)

struct XcdBarrier {
    unsigned* bar; unsigned x;
    volatile LAS unsigned* st;
};

__device__ __forceinline__ XcdBarrier xcd_barrier_post(unsigned* bar, volatile LAS unsigned* st) {
    XcdBarrier b; b.bar = bar; b.x = xb_xcc_id(); b.st = st;
    if (threadIdx.x == 0) (void)xb_add(&bar[XB_XCNT(b.x)], 1u);
    return b;
}
__device__ __forceinline__ void xcd_barrier_complete(unsigned* bar, unsigned x, unsigned& nloc, unsigned& nx) {
    const unsigned G = gridDim.x * gridDim.y * gridDim.z;
    unsigned sum, cnt, mine, sp = 0u;
    for (;;) {
        sum = 0u; cnt = 0u; mine = 0u;
#pragma unroll
        for (unsigned j = 0; j < 16; ++j) { const unsigned c = xb_ld(&bar[XB_XCNT(j)]); sum += c; cnt += (c > 0u) ? 1u : 0u; mine = (j == x) ? c : mine; }
        if (sum == G) break;
        __builtin_amdgcn_s_sleep(1);
        if ((++sp & 255u) == 0u) { if (xb_ld(&bar[XB_TMO])) break; if (sp > XB_SPIN_CAP) { atomicAdd(&bar[XB_TMO], 1u); break; } }
    }
    nloc = mine > 0u ? mine : 1u; nx = cnt > 0u ? cnt : 1u;
}

__device__ __forceinline__ void xcd_barrier(const XcdBarrier& b) {
    asm volatile("s_waitcnt vmcnt(0)" ::: "memory");
    __syncthreads();
    if (threadIdx.x == 0) {
        unsigned* bar = b.bar;
        __builtin_amdgcn_s_waitcnt(0);
        unsigned nloc = b.st[0], nx = b.st[1];
        if (nloc == 0u) { xcd_barrier_complete(bar, b.x, nloc, nx); b.st[0] = nloc; b.st[1] = nx; }
        const unsigned old = xb_add(&bar[XB_XSUB(b.x)], 1u);
        const unsigned gen = old / nloc;
        if (old + 1u == (gen + 1u) * nloc) {
            __builtin_amdgcn_fence(__ATOMIC_RELEASE, "agent");
            asm volatile("s_waitcnt vmcnt(0)" ::: "memory");
            const unsigned og = xb_add(&bar[XB_TOP], 1u);
            const unsigned tg = og / nx;
            if (og + 1u == (tg + 1u) * nx) xb_add(&bar[XB_TOPGEN], 1u);
            else XB_SPIN(xb_ld(&bar[XB_TOPGEN]) == tg, bar);
            __builtin_amdgcn_fence(__ATOMIC_ACQUIRE, "agent");
            xb_add(&bar[XB_XGEN(b.x)], 1u);
            asm volatile("s_waitcnt vmcnt(0)" ::: "memory");
        } else {
            XB_SPIN(xb_ld(&bar[XB_XGEN(b.x)]) == gen, bar);
            __builtin_amdgcn_fence(__ATOMIC_ACQUIRE, "agent");
            asm volatile("s_waitcnt vmcnt(0)" ::: "memory");
        }
    }
    __syncthreads();
}


struct Args { const float* in[28]; float* out; unsigned char* ws; };
typedef const __attribute__((address_space(4))) Args* ArgsP;
__device__ __forceinline__ ArgsP args_ptr() { ArgsP p = (ArgsP)__builtin_amdgcn_kernarg_segment_ptr(); asm volatile("" : "+s"(p)); return p; }
struct Frame { LAS unsigned char* lds; int tid, lane, wave, vcu, G; };
__device__ __forceinline__ Frame phase_frame(const Frame& F0) { Frame F = F0; int t = F0.tid; asm volatile("" : "+v"(t)); F.tid = t; F.lane = t & 63; F.wave = __builtin_amdgcn_readfirstlane(t >> 6); int v = F0.vcu; asm volatile("" : "+s"(v)); F.vcu = v; return F; }

__device__ __forceinline__ float wave_sum(float v) {
#pragma unroll
    for (int o = 1; o < 64; o <<= 1) v += __shfl_xor(v, o);
    return v;
}
__device__ __forceinline__ float bf_lo(unsigned w) { return __uint_as_float(w << 16); }
__device__ __forceinline__ float bf_hi(unsigned w) { return __uint_as_float(w & 0xffff0000u); }
__device__ __forceinline__ float sigmoidf_(float x) { return __builtin_amdgcn_rcpf(1.0f + __builtin_amdgcn_exp2f(-LOG2E * x)); }

__device__ __forceinline__ void p0_transpose_item(const float* W, int K, int N, bf16* WT, const float* sc, LAS float* scr, int item, int lane) {
    const int nblk = N / 32, kb = item / nblk, nb = item % nblk, k0 = 64 * kb, n0 = 32 * nb;
#pragma unroll 8
    for (int i = 0; i < 32; ++i) { const int kk = 2 * i + (lane >> 5); const float s = sc ? sc[k0 + kk] : 1.0f; scr[kk * 33 + (lane & 31)] = W[(size_t)(k0 + kk) * N + n0 + (lane & 31)] * s; }
    LDS_WAIT(); asm volatile("" ::: "memory");
    const int c = lane & 7;
#pragma unroll
    for (int j = 0; j < 4; ++j) { const int n = (lane >> 3) + 8 * j; const LAS float* s = scr + (8 * c) * 33 + n;
        v4u o; o.x = pk2(s[0 * 33], s[1 * 33]); o.y = pk2(s[2 * 33], s[3 * 33]); o.z = pk2(s[4 * 33], s[5 * 33]); o.w = pk2(s[6 * 33], s[7 * 33]);
        *(GAS v4u*)(WT + (size_t)(n0 + n) * K + k0 + 8 * c) = o; }
    LDS_WAIT(); asm volatile("" ::: "memory");
}
__device__ __forceinline__ void p0_prologue(const Frame& F0) {
    const ArgsP A = args_ptr();
    const Frame F = phase_frame(F0);
    LAS float* scr = (LAS float*)(F.lds + F.wave * 16384);
    const int gw = F.vcu * NWAVES + F.wave, NGW = F.G * NWAVES;
    unsigned char* ws = A->ws;
    constexpr int I_EI = 32 * 160, I_EO = 32 * 64, I_OI = 32 * 128, I_OO = 32 * 64, I_UP = 32 * 256, I_DN = 128 * 64;
    constexpr int NIT = 2 * I_EI + 2 * I_EO + 2 * I_OI + 2 * I_OO + 4 * I_UP + 4 * I_DN;
    for (int it = gw; it < NIT; it += NGW) {
        int r = it; const float* W; const float* sc; bf16* WT; int K, N;
        if (r < 2 * I_EI) { const int e = r / I_EI; r -= e * I_EI; K = 2048; N = 5120; W = A->in[6] + (size_t)e * K * N; WT = (bf16*)(ws + WS_WEI) + (size_t)e * K * N; sc = A->in[23] + (2 * e) * 2048; }
        else if ((r -= 2 * I_EI) < 2 * I_EO) { const int e = r / I_EO; r -= e * I_EO; K = 2048; N = 2048; W = A->in[7] + (size_t)e * K * N; WT = (bf16*)(ws + WS_WEO) + (size_t)e * K * N; sc = nullptr; }
        else if ((r -= 2 * I_EO) < 2 * I_OI) { const int o = r / I_OI; r -= o * I_OI; K = 2048; N = 4096; W = A->in[18] + (size_t)o * K * N; WT = (bf16*)(ws + WS_WOI) + (size_t)o * K * N; sc = A->in[23] + (2 * o + 1) * 2048; }
        else if ((r -= 2 * I_OI) < 2 * I_OO) { const int o = r / I_OO; r -= o * I_OO; K = 2048; N = 2048; W = A->in[19] + (size_t)o * K * N; WT = (bf16*)(ws + WS_WOO) + (size_t)o * K * N; sc = nullptr; }
        else if ((r -= 2 * I_OO) < 4 * I_UP) { const int l = r / I_UP; r -= l * I_UP; K = 2048; N = 8192; W = A->in[26] + (size_t)l * K * N; WT = (bf16*)(ws + WS_WUP) + (size_t)l * K * N; sc = A->in[24] + l * 2048; }
        else { r -= 4 * I_UP; const int l = r / I_DN; r -= l * I_DN; K = 8192; N = 2048; W = A->in[27] + (size_t)l * K * N; WT = (bf16*)(ws + WS_WDN) + (size_t)l * K * N; sc = nullptr; }
        p0_transpose_item(W, K, N, WT, sc, scr, r, F.lane);
    }
    float* X = (float*)(ws + WS_X); bf16* Xb = (bf16*)(ws + WS_XB); float* ssq0 = (float*)(ws + WS_CTL) + CW_SSQ;
    for (int m = gw; m < MT; m += NGW) {
        const float* src = m < SEQ ? A->in[0] + (size_t)m * DM : A->in[1] + (size_t)(m - SEQ) * DM;
        f32x4 v[8]; float s = 0.f;
#pragma unroll
        for (int j = 0; j < 8; ++j) { v[j] = ((const GAS f32x4*)src)[F.lane + 64 * j]; s += (v[j].x * v[j].x + v[j].y * v[j].y) + (v[j].z * v[j].z + v[j].w * v[j].w); }
        s = wave_sum(s);
#pragma unroll
        for (int j = 0; j < 8; ++j) { ((GAS f32x4*)(X + (size_t)m * DM))[F.lane + 64 * j] = v[j];
            ((GAS unsigned long long*)(Xb + (size_t)m * DM))[F.lane + 64 * j] = (unsigned long long)pk2(v[j].x, v[j].y) | ((unsigned long long)pk2(v[j].z, v[j].w) << 32); }
        if (F.lane == 0) ssq0[m] = s;
    }
    const int gt = gw * 64 + F.lane, NGT = NGW * 64;
    bf16* waT = (bf16*)(ws + WS_WAT); bf16* wxT = (bf16*)(ws + WS_WXT); bf16* wsb = (bf16*)(ws + WS_WSB);
    for (int idx = gt; idx < 2 * 16 * 64 * 64; idx += NGT) { const int eg = idx >> 12, j = (idx >> 6) & 63, i = idx & 63; const int src = (eg * 64 + i) * 64 + j;
        waT[idx] = (bf16)f2bf(A->in[10][src]); wxT[idx] = (bf16)f2bf(A->in[12][src]); }
    for (int idx = gt; idx < 2 * 16 * 128 * 128; idx += NGT) { const int t = (idx >> 7) & 127, s = idx & 127; wsb[idx] = s <= t ? (bf16)f2bf(A->in[21][idx]) : (bf16)0; }
}

typedef short bf16x8 __attribute__((ext_vector_type(8)));
typedef float f32x16 __attribute__((ext_vector_type(16)));
template <int PASS>
__device__ __forceinline__ void lru_tasks(const Frame& F0, int e) {
    const ArgsP A = args_ptr();
    const Frame F = phase_frame(F0);
    LAS float* xs = (LAS float*)(F.lds + F.wave * 6144);
    LAS float* cwl = xs + 19 * 64;
    const int lane = F.lane, j16 = lane & 15, q4 = lane >> 4;
    const int gw = F.vcu * NWAVES + F.wave, NGW = F.G * NWAVES;
    unsigned char* ws = A->ws;
    const float* XR = (const float*)(ws + WS_XR); const bf16* G = (const bf16*)(ws + WS_G); bf16* YC = (bf16*)(ws + WS_YC);
    float* CSA = (float*)(ws + WS_CS); float* CSB = CSA + 128 * 1024;
    const bf16* waT = (const bf16*)(ws + WS_WAT); const bf16* wxT = (const bf16*)(ws + WS_WXT);
    constexpr int NTASK = PASS == 1 ? 2048 : 2304;
    for (int task = gw; task < NTASK; task += NGW) {
        const bool smp = task >= 2048;
        const int g = task & 15, ci = smp ? ((task - 2048) >> 4) : (task >> 4);
        const int R0 = smp ? SEQ + 16 * ci : 64 * ci, ntile = smp ? 1 : 4, chb = 64 * g;
#pragma unroll
        for (int j = 0; j < 4; ++j) cwl[j * 64 + lane] = A->in[8][(e * 4 + j) * 1024 + chb + lane];
        cwl[256 + lane] = A->in[9][e * 1024 + chb + lane];
        bf16x8 waB[4][2], wxB[4][2];
#pragma unroll
        for (int n = 0; n < 4; ++n)
#pragma unroll
            for (int ks = 0; ks < 2; ++ks) { const size_t off = ((size_t)((e * 16 + g) * 64 + 16 * n + j16)) * 64 + 32 * ks + 8 * q4;
                waB[n][ks] = *(const bf16x8*)(waT + off); wxB[n][ks] = *(const bf16x8*)(wxT + off); }
        float ba[4], bx[4], nl8[4], hin[4], Ac[4], Bc[4];
#pragma unroll
        for (int n = 0; n < 4; ++n) { const int c = chb + 16 * n + j16; ba[n] = A->in[11][e * 1024 + c]; bx[n] = A->in[13][e * 1024 + c];
            nl8[n] = -8.0f * log1pf(__expf(-A->in[14][e * 1024 + c])); Ac[n] = 1.f; Bc[n] = 0.f; hin[n] = 0.f; }
        if (PASS == 2) {
            if (smp) {
#pragma unroll
                for (int n = 0; n < 4; ++n) hin[n] = A->in[3][(e * 16 + ci) * 1024 + chb + 16 * n + j16];
            } else {
                for (int j = 0; j < ci; ++j) {
#pragma unroll
                    for (int n = 0; n < 4; ++n) { const int c = j * 1024 + chb + 16 * n + j16; hin[n] = CSA[c] * hin[n] + CSB[c]; }
                }
            }
        }
        for (int ti = 0; ti < ntile; ++ti) {
            const int t0 = R0 + 16 * ti;
#pragma unroll
            for (int rr = 0; rr < 19; ++rr) {
                float x;
                if (!smp) { const int row = t0 - 3 + rr; x = row >= 0 ? XR[(size_t)row * 1024 + chb + lane] : 0.f; }
                else { const int li = rr - 3; x = li >= 0 ? XR[(size_t)(R0 + li) * 1024 + chb + lane] : A->in[2][((e * 16 + ci) * 3 + (3 + li)) * 1024 + chb + lane]; }
                xs[rr * 64 + lane] = x;
            }
            bf16x8 xa[2];
#pragma unroll
            for (int ks = 0; ks < 2; ++ks) { float a8[8]; const int c0 = 32 * ks + 8 * q4;
#pragma unroll
                for (int jj = 0; jj < 8; ++jj) { const int ch = c0 + jj; float acc = cwl[256 + ch];
#pragma unroll
                    for (int j = 0; j < 4; ++j) acc += cwl[j * 64 + ch] * xs[(j16 + j) * 64 + ch];
                    a8[jj] = acc; }
                v4u w; w.x = pk2(a8[0], a8[1]); w.y = pk2(a8[2], a8[3]); w.z = pk2(a8[4], a8[5]); w.w = pk2(a8[6], a8[7]); xa[ks] = __builtin_bit_cast(bf16x8, w); }
            f32x4 racc[4], iacc[4];
#pragma unroll
            for (int n = 0; n < 4; ++n) { const f32x4 z = {0.f, 0.f, 0.f, 0.f};
                racc[n] = __builtin_amdgcn_mfma_f32_16x16x32_bf16(xa[0], waB[n][0], z, 0, 0, 0); racc[n] = __builtin_amdgcn_mfma_f32_16x16x32_bf16(xa[1], waB[n][1], racc[n], 0, 0, 0);
                iacc[n] = __builtin_amdgcn_mfma_f32_16x16x32_bf16(xa[0], wxB[n][0], z, 0, 0, 0); iacc[n] = __builtin_amdgcn_mfma_f32_16x16x32_bf16(xa[1], wxB[n][1], iacc[n], 0, 0, 0); }
#pragma unroll
            for (int n = 0; n < 4; ++n) { const int ch = 16 * n + j16;
                float xv[7];
#pragma unroll
                for (int k = 0; k < 7; ++k) xv[k] = xs[(4 * q4 + k) * 64 + ch];
                const float w0 = cwl[ch], w1 = cwl[64 + ch], w2 = cwl[128 + ch], w3 = cwl[192 + ch], cb = cwl[256 + ch];
                float pa[4], pb[4];
#pragma unroll
                for (int v = 0; v < 4; ++v) { const float xc = cb + w0 * xv[v] + w1 * xv[v + 1] + w2 * xv[v + 2] + w3 * xv[v + 3];
                    const float r = sigmoidf_(racc[n][v] + ba[n]), ig = sigmoidf_(iacc[n][v] + bx[n]);
                    const float la = nl8[n] * r, a = __builtin_amdgcn_exp2f(LOG2E * la), mult = sqrtf(fmaxf(1.0f - __builtin_amdgcn_exp2f(2.0f * LOG2E * la), 0.f)), uu = mult * ig * xc;
                    pa[v] = v ? pa[v - 1] * a : a; pb[v] = v ? a * pb[v - 1] + uu : uu; }
                float Ai = pa[3], Bi = pb[3];
                { const float A1 = __shfl_up(Ai, 16), B1 = __shfl_up(Bi, 16); if (q4 >= 1) { Bi = Ai * B1 + Bi; Ai = Ai * A1; } }
                { const float A2 = __shfl_up(Ai, 32), B2 = __shfl_up(Bi, 32); if (q4 >= 2) { Bi = Ai * B2 + Bi; Ai = Ai * A2; } }
                float Ae = __shfl_up(Ai, 16), Be = __shfl_up(Bi, 16); if (q4 == 0) { Ae = 1.f; Be = 0.f; }
                const float At = __shfl(Ai, 48 + j16), Bt = __shfl(Bi, 48 + j16);
                if (PASS == 1) { Bc[n] = At * Bc[n] + Bt; Ac[n] = At * Ac[n]; }
                else {
                    const float carry = Ae * hin[n] + Be;
#pragma unroll
                    for (int v = 0; v < 4; ++v) { const float hv = pa[v] * carry + pb[v]; const size_t row = (size_t)(t0 + 4 * q4 + v);
                        const float gg = __uint_as_float((unsigned)G[row * 1024 + chb + ch] << 16);
                        YC[row * 2048 + chb + ch] = (bf16)f2bf(gg * hv);
                        if (v == 3 && q4 == 3 && ti == ntile - 1) {
                            if (smp) A->out[O_SLRU + (size_t)(e * 16 + ci) * 1024 + chb + ch] = hv;
                            else if (ci == 127) A->out[O_PLRU + (size_t)e * 1024 + chb + ch] = hv;
                        } }
                    hin[n] = At * hin[n] + Bt;
                }
            }
        }
        if (PASS == 1) { if (q4 == 0) {
#pragma unroll
                for (int n = 0; n < 4; ++n) { CSA[ci * 1024 + chb + 16 * n + j16] = Ac[n]; CSB[ci * 1024 + chb + 16 * n + j16] = Bc[n]; } }
        } else {
            if (smp) {
#pragma unroll
                for (int rr = 0; rr < 3; ++rr) A->out[O_SCONV + (size_t)((e * 16 + ci) * 3 + rr) * 1024 + chb + lane] = XR[(size_t)(R0 + 13 + rr) * 1024 + chb + lane];
            } else if (ci == 127) {
#pragma unroll
                for (int rr = 0; rr < 3; ++rr) A->out[O_PCONV + (size_t)(e * 3 + rr) * 1024 + chb + lane] = XR[(size_t)(SEQ - 3 + rr) * 1024 + chb + lane];
            }
        }
    }
}

namespace att {
constexpr int KP = 144, VP = 320, KT = 64 * KP, VT = 64 * VP, BUFB = KT + VT, LUT_OFF = 2 * BUFB, LUT_N = 576;
constexpr float NEG = -1e30f;
__device__ __forceinline__ int crow(int r, int hi) { return (r & 3) + 8 * (r >> 2) + 4 * hi; }
__device__ __forceinline__ int rel_bucket(int rel) {
    const int n = rel < 0 ? -rel : rel;
    const int b = n < 8 ? n : (n < 14 ? 8 : n < 23 ? 9 : n < 39 ? 10 : n < 64 ? 11 : n < 108 ? 12 : n < 182 ? 13 : n < 305 ? 14 : 15);
    return (rel > 0 ? 16 : 0) + b;
}
typedef short v4i16_t __attribute__((ext_vector_type(4)));
__device__ __forceinline__ v4i16_t vtr(const LAS unsigned char* p) { return __builtin_amdgcn_ds_read_tr16_b64_v4i16((LAS v4i16_t*)p); }

template <bool SAMPLE>
__device__ __forceinline__ void attn_sweep(const Frame& F0, int e, int s, int h, int qi  ) {
    const ArgsP A = args_ptr();
    const Frame F = phase_frame(F0);
    LAS unsigned char* lds = F.lds;
    LAS float* lut = (LAS float*)(lds + LUT_OFF);
    const int tid = F.tid, lane = F.lane, w = F.wave, r32 = lane & 31, hi = lane >> 5;
    unsigned char* ws = A->ws;
    const bf16* Qb = (const bf16*)(ws + WS_Q); const bf16* Kb = (const bf16*)(ws + WS_KB); const bf16* Vb = (const bf16*)(ws + WS_VB);
    float* OS = (float*)(ws + WS_OS) + (size_t)s * MT * 1024;
    const float* ck = A->in[4] + (size_t)(e * 16 + qi) * 1024 * 1024; const float* cv = A->in[5] + (size_t)(e * 16 + qi) * 1024 * 1024;
    const int NT = SAMPLE ? 17 : 4 * qi + 4;
    const int tmax = SAMPLE ? (w == 0 ? 16 : -1) : 4 * qi + (w >> 1);
    const int grow = SAMPLE ? SEQ + 16 * qi + (r32 & 15) : 256 * qi + 32 * w + r32;
    const int qpos = SAMPLE ? 1024 + (r32 & 15) : grow;
    const int q0w = SAMPLE ? 1024 : 256 * qi + 32 * w;
    for (int i = tid; i < LUT_N; i += 512) lut[i] = LOG2E * A->in[17][rel_bucket(i - 511) * 8 + h];
    const float c15 = LOG2E * A->in[17][15 * 8 + h];
    bf16x8 qf[4];
#pragma unroll
    for (int d0 = 0; d0 < 4; ++d0) qf[d0] = *(const bf16x8*)(Qb + (size_t)grow * 1024 + h * 128 + s * 64 + d0 * 16 + hi * 8);
    const int kr = tid >> 3, kc = tid & 7, vr = tid >> 4, vc = tid & 15;
    v4u kq, vq0, vq1;
    auto load_tile = [&](int t) __attribute__((always_inline)) {
        if (!SAMPLE) {
            kq = *(const v4u*)(Kb + (size_t)(64 * t + kr) * 1024 + h * 128 + s * 64 + kc * 8);
            vq0 = *(const v4u*)(Vb + (size_t)(64 * t + vr) * 1024 + h * 128 + vc * 8);
            vq1 = *(const v4u*)(Vb + (size_t)(64 * t + vr + 32) * 1024 + h * 128 + vc * 8);
        } else if (t < 16) {
            { const float* p = ck + (size_t)(64 * t + kr) * 1024 + h * 128 + s * 64 + kc * 8; const f32x4 a = *(const f32x4*)p, b = *(const f32x4*)(p + 4);
              kq.x = pk2(a.x, a.y); kq.y = pk2(a.z, a.w); kq.z = pk2(b.x, b.y); kq.w = pk2(b.z, b.w); }
            { const float* p = cv + (size_t)(64 * t + vr) * 1024 + h * 128 + vc * 8; const f32x4 a = *(const f32x4*)p, b = *(const f32x4*)(p + 4);
              vq0.x = pk2(a.x, a.y); vq0.y = pk2(a.z, a.w); vq0.z = pk2(b.x, b.y); vq0.w = pk2(b.z, b.w); }
            { const float* p = cv + (size_t)(64 * t + vr + 32) * 1024 + h * 128 + vc * 8; const f32x4 a = *(const f32x4*)p, b = *(const f32x4*)(p + 4);
              vq1.x = pk2(a.x, a.y); vq1.y = pk2(a.z, a.w); vq1.z = pk2(b.x, b.y); vq1.w = pk2(b.z, b.w); }
        } else {
            const v4u z = {0u, 0u, 0u, 0u};
            kq = kr < 16 ? *(const v4u*)(Kb + (size_t)(SEQ + 16 * qi + kr) * 1024 + h * 128 + s * 64 + kc * 8) : z;
            vq0 = vr < 16 ? *(const v4u*)(Vb + (size_t)(SEQ + 16 * qi + vr) * 1024 + h * 128 + vc * 8) : z;
            vq1 = z;
        }
    };
    auto store_tile = [&](int b) __attribute__((always_inline)) {
        LAS unsigned char* Kt = lds + b * BUFB; LAS unsigned char* Vt = Kt + KT;
        *(LAS v4u*)(Kt + kr * KP + kc * 16) = kq;
        *(LAS v4u*)(Vt + vr * VP + vc * 16) = vq0;
        *(LAS v4u*)(Vt + (vr + 32) * VP + vc * 16) = vq1;
    };
    float m = NEG, l = 0.f;
    f32x16 o[4];
#pragma unroll
    for (int c = 0; c < 4; ++c)
#pragma unroll
        for (int r = 0; r < 16; ++r) o[c][r] = 0.f;
    load_tile(0); store_tile(0);
    __syncthreads();
    for (int t = 0; t < NT; ++t) {
        const bool more = t + 1 < NT;
        if (more) load_tile(t + 1);
        if (t <= tmax) {
            const LAS unsigned char* Kt = lds + (t & 1) * BUFB; const LAS unsigned char* Vt = Kt + KT;
            const bool nearb = 64 * t >= q0w - 480;
            const float ci = nearb ? 0.f : c15;
            f32x16 p0, p1;
#pragma unroll
            for (int r = 0; r < 16; ++r) { p0[r] = ci; p1[r] = ci; }
#pragma unroll
            for (int d0 = 0; d0 < 4; ++d0) {
                const bf16x8 a0 = *(const LAS bf16x8*)(Kt + r32 * KP + d0 * 32 + hi * 16);
                const bf16x8 a1 = *(const LAS bf16x8*)(Kt + (32 + r32) * KP + d0 * 32 + hi * 16);
                p0 = __builtin_amdgcn_mfma_f32_32x32x16_bf16(a0, qf[d0], p0, 0, 0, 0);
                p1 = __builtin_amdgcn_mfma_f32_32x32x16_bf16(a1, qf[d0], p1, 0, 0, 0);
            }
            if (nearb) {
                const LAS float* lp = lut + (64 * t - qpos + 511 + 4 * hi);
#pragma unroll
                for (int r = 0; r < 16; ++r) { p0[r] += lp[(r & 3) + 8 * (r >> 2)]; p1[r] += lp[32 + (r & 3) + 8 * (r >> 2)]; }
            }
            if (SAMPLE && t == 16) {
#pragma unroll
                for (int r = 0; r < 16; ++r) { if (r >= 8) p0[r] = NEG; p1[r] = NEG; }
            }
            float mx = p0[0];
#pragma unroll
            for (int r = 1; r < 16; ++r) mx = fmaxf(mx, p0[r]);
#pragma unroll
            for (int r = 0; r < 16; ++r) mx = fmaxf(mx, p1[r]);
            mx = fmaxf(mx, __shfl_xor(mx, 32));
            const float mn = fmaxf(m, mx), alpha = __builtin_amdgcn_exp2f(m - mn);
            m = mn;
            float rsum = 0.f;
#pragma unroll
            for (int r = 0; r < 16; ++r) { p0[r] = __builtin_amdgcn_exp2f(p0[r] - mn); p1[r] = __builtin_amdgcn_exp2f(p1[r] - mn); rsum += p0[r] + p1[r]; }
            rsum += __shfl_xor(rsum, 32);
            l = l * alpha + rsum;
#pragma unroll
            for (int c = 0; c < 4; ++c)
#pragma unroll
                for (int r = 0; r < 16; ++r) o[c][r] *= alpha;
            bf16x8 pb[4];
            { v4u w0, w1, w2, w3;
              w0.x = pk2(p0[0], p0[1]); w0.y = pk2(p0[2], p0[3]); w0.z = pk2(p0[4], p0[5]); w0.w = pk2(p0[6], p0[7]);
              w1.x = pk2(p0[8], p0[9]); w1.y = pk2(p0[10], p0[11]); w1.z = pk2(p0[12], p0[13]); w1.w = pk2(p0[14], p0[15]);
              w2.x = pk2(p1[0], p1[1]); w2.y = pk2(p1[2], p1[3]); w2.z = pk2(p1[4], p1[5]); w2.w = pk2(p1[6], p1[7]);
              w3.x = pk2(p1[8], p1[9]); w3.y = pk2(p1[10], p1[11]); w3.z = pk2(p1[12], p1[13]); w3.w = pk2(p1[14], p1[15]);
              pb[0] = __builtin_bit_cast(bf16x8, w0); pb[1] = __builtin_bit_cast(bf16x8, w1); pb[2] = __builtin_bit_cast(bf16x8, w2); pb[3] = __builtin_bit_cast(bf16x8, w3); }
            const LAS unsigned char* vb = Vt + (4 * hi + ((lane & 15) >> 2)) * VP + ((lane >> 4) & 1) * 32 + (lane & 3) * 8;
#pragma unroll
            for (int s4 = 0; s4 < 4; ++s4)
#pragma unroll
                for (int c = 0; c < 4; ++c) {
                    const v4i16_t lo = vtr(vb + (16 * s4) * VP + 64 * c), hh = vtr(vb + (16 * s4 + 8) * VP + 64 * c);
                    const bf16x8 vf = {lo[0], lo[1], lo[2], lo[3], hh[0], hh[1], hh[2], hh[3]};
                    o[c] = __builtin_amdgcn_mfma_f32_32x32x16_bf16(vf, pb[s4], o[c], 0, 0, 0);
                }
        }
        if (more) store_tile((t + 1) & 1);
        __syncthreads();
    }
    if (tmax >= 0 && (!SAMPLE || r32 < 16)) {
        const float inv = 1.0f / l;
        float* orow = OS + (size_t)grow * 1024 + h * 128 + 4 * hi;
#pragma unroll
        for (int c = 0; c < 4; ++c)
#pragma unroll
            for (int rq = 0; rq < 4; ++rq) { f32x4 v = {o[c][4 * rq] * inv, o[c][4 * rq + 1] * inv, o[c][4 * rq + 2] * inv, o[c][4 * rq + 3] * inv}; *(f32x4*)(orow + 32 * c + 8 * rq) = v; }
    }
}
}

__device__ __forceinline__ void attn_combine(const Frame& F0, int e, float lam_init) {
    const ArgsP A = args_ptr();
    const Frame F = phase_frame(F0);
    const int lane = F.lane, gw = F.vcu * NWAVES + F.wave, NGW = F.G * NWAVES;
    const float* lv = A->in[15] + e * 256;
    const float s1 = wave_sum(lv[lane] * lv[64 + lane]), s2 = wave_sum(lv[128 + lane] * lv[192 + lane]);
    const float lam = __expf(s1) - __expf(s2) + lam_init;
    const float* OS0 = (const float*)(A->ws + WS_OS); const float* OS1 = OS0 + (size_t)MT * 1024; bf16* YC = (bf16*)(A->ws + WS_YC);
    const int hd = lane >> 3, d0 = (lane & 7) * 16;
    f32x4 sw[4];
#pragma unroll
    for (int j = 0; j < 4; ++j) sw[j] = *(const f32x4*)(A->in[16] + e * 128 + d0 + 4 * j);
    for (int row = gw; row < MT; row += NGW) {
        const size_t off = (size_t)row * 1024 + hd * 128 + d0;
        f32x4 d[4]; float q = 0.f;
#pragma unroll
        for (int j = 0; j < 4; ++j) { const f32x4 a = *(const f32x4*)(OS0 + off + 4 * j), b = *(const f32x4*)(OS1 + off + 4 * j); d[j] = a - lam * b; q += (d[j].x * d[j].x + d[j].y * d[j].y) + (d[j].z * d[j].z + d[j].w * d[j].w); }
        q += __shfl_xor(q, 1); q += __shfl_xor(q, 2); q += __shfl_xor(q, 4);
        const float sc = __builtin_amdgcn_rsqf(q * (1.0f / 128.0f) + RMS_EPS) * (1.0f - lam_init);
        v4u w0, w1;
        { const f32x4 a = d[0] * sw[0] * sc, b = d[1] * sw[1] * sc; w0.x = pk2(a.x, a.y); w0.y = pk2(a.z, a.w); w0.z = pk2(b.x, b.y); w0.w = pk2(b.z, b.w); }
        { const f32x4 a = d[2] * sw[2] * sc, b = d[3] * sw[3] * sc; w1.x = pk2(a.x, a.y); w1.y = pk2(a.z, a.w); w1.z = pk2(b.x, b.y); w1.w = pk2(b.z, b.w); }
        bf16* yp = YC + (size_t)row * 2048 + 1024 + hd * 128 + d0;
        *(v4u*)yp = w0; *(v4u*)(yp + 8) = w1;
    }
}

__device__ __forceinline__ void gmlp_phase(const Frame& F0, int o) {
    const ArgsP A = args_ptr();
    const Frame F = phase_frame(F0);
    LAS unsigned char* Vt = F.lds;
    constexpr int VP = 320;
    const int tid = F.tid, lane = F.lane, w = F.wave, r32 = lane & 31, hi = lane >> 5;
    unsigned char* ws = A->ws;
    const bf16* U = (const bf16*)(ws + WS_U); const bf16* VR = (const bf16*)(ws + WS_VR); bf16* YC = (bf16*)(ws + WS_YC);
    const bf16* wsb = (const bf16*)(ws + WS_WSB);
    const float* ssqv = (const float*)(ws + WS_CTL) + CW_SSQ + (9 + o) * MT;
    const float* vnw = A->in[20] + o * 2048; const float* bs = A->in[22] + o * 16 * 128;
    for (int u = F.vcu; u < 1280; u += F.G) {
        const bool smp = u >= 1024; const int g = u & 15;
        const int R0 = smp ? SEQ + 16 * ((u - 1024) >> 4) : 128 * (u >> 4), nrows = smp ? 16 : 128;
#pragma unroll
        for (int i = 0; i < 4; ++i) { const int idx = tid + 512 * i, row = idx >> 4, ch = idx & 15; v4u wv = {0u, 0u, 0u, 0u};
            if (row < nrows) { const size_t grow = (size_t)(R0 + row); const v4u raw = *(const v4u*)(VR + grow * 2048 + 128 * g + ch * 8);
                const float rs = __builtin_amdgcn_rsqf(ssqv[grow] * (1.0f / 2048.0f) + RMS_EPS);
                const f32x4 n0 = *(const f32x4*)(vnw + 128 * g + ch * 8), n1 = *(const f32x4*)(vnw + 128 * g + ch * 8 + 4);
                f32x4 a = {bf_lo(raw.x), bf_hi(raw.x), bf_lo(raw.y), bf_hi(raw.y)}, b = {bf_lo(raw.z), bf_hi(raw.z), bf_lo(raw.w), bf_hi(raw.w)};
                a = a * rs * n0; b = b * rs * n1;
                if (smp) { float* gv = A->out + O_SGV + ((size_t)o * NSMP + (grow - SEQ)) * 2048 + 128 * g + ch * 8; *(f32x4*)gv = a; *(f32x4*)(gv + 4) = b; }
                wv.x = pk2(a.x, a.y); wv.y = pk2(a.z, a.w); wv.z = pk2(b.x, b.y); wv.w = pk2(b.z, b.w); }
            *(LAS v4u*)(Vt + row * VP + ch * 16) = wv; }
        __syncthreads();
        const int tb = w & 3, chh = w >> 2;
        if (!smp || tb == 0) {
            const LAS unsigned char* vb = Vt + (8 * hi + ((lane & 15) >> 2)) * VP + ((lane >> 4) & 1) * 32 + (lane & 3) * 8;
            const bf16* arow = wsb + ((size_t)(o * 16 + g) * 128 + 32 * tb + r32) * 128 + 8 * hi;
#pragma unroll
            for (int nn = 0; nn < 2; ++nn) { const int cb = chh * 2 + nn;
                f32x16 acc;
#pragma unroll
                for (int r = 0; r < 16; ++r) acc[r] = 0.f;
                for (int ks = 0; ks < 2 * tb + 2; ++ks) {
                    const bf16x8 af = *(const bf16x8*)(arow + 16 * ks);
                    const att::v4i16_t lo = att::vtr(vb + (16 * ks) * VP + 64 * cb), hh = att::vtr(vb + (16 * ks + 4) * VP + 64 * cb);
                    const bf16x8 bfr = {lo[0], lo[1], lo[2], lo[3], hh[0], hh[1], hh[2], hh[3]};
                    acc = __builtin_amdgcn_mfma_f32_32x32x16_bf16(af, bfr, acc, 0, 0, 0);
                }
#pragma unroll
                for (int r = 0; r < 16; ++r) { const int t = 32 * tb + att::crow(r, hi);
                    if (t < nrows) { const size_t row = (size_t)(R0 + t); const int col = 128 * g + 32 * cb + r32;
                        const float mix = acc[r] + bs[g * 128 + t];
                        const float uu = __uint_as_float((unsigned)U[row * 2048 + col] << 16);
                        YC[row * 2048 + col] = (bf16)f2bf(uu * mix); } }
            }
        }
        __syncthreads();
    }
}

__device__ __forceinline__ void final_norm(const Frame& F0) {
    const ArgsP A = args_ptr();
    const Frame F = phase_frame(F0);
    const int gw = F.vcu * NWAVES + F.wave, NGW = F.G * NWAVES;
    const float* X = (const float*)(A->ws + WS_X); const float* ssq = (const float*)(A->ws + WS_CTL) + CW_SSQ + 8 * MT;
    f32x4 wv[8];
#pragma unroll
    for (int j = 0; j < 8; ++j) wv[j] = ((const f32x4*)A->in[25])[F.lane + 64 * j];
    for (int m = gw; m < MT; m += NGW) {
        const float rs = __builtin_amdgcn_rsqf(ssq[m] * (1.0f / 2048.0f) + RMS_EPS);
        float* dst = m < SEQ ? A->out + O_YP + (size_t)m * DM : A->out + O_YS + (size_t)(m - SEQ) * DM;
#pragma unroll
        for (int j = 0; j < 8; ++j) { const f32x4 v = ((const f32x4*)(X + (size_t)m * DM))[F.lane + 64 * j]; ((f32x4*)dst)[F.lane + 64 * j] = v * rs * wv[j]; }
    }
}

__global__ void __launch_bounds__(NWAVES * 64, 2) mk_fwd(Args Aval) {
    extern __shared__ __attribute__((aligned(16))) unsigned char lds[];
    Frame F;
    F.lds = (LAS unsigned char*)lds;
    volatile LAS unsigned* MISC = (volatile LAS unsigned*)(F.lds + MISC_OFF);
    F.tid = threadIdx.x; F.lane = F.tid & 63; F.wave = __builtin_amdgcn_readfirstlane(F.tid >> 6);
    F.G = gridDim.x; { const int bx = blockIdx.x; F.vcu = (F.G % 8 == 0) ? (bx % 8) * (F.G / 8) + bx / 8 : bx; }
    for (int u = F.tid; u < (LDS_BYTES - LDSCTL_OFF) / 4; u += NWAVES * 64) ((LAS unsigned*)(F.lds + LDSCTL_OFF))[u] = 0u;
    __syncthreads();
    (void)xcd_barrier_post((unsigned*)(Aval.ws + WS_CTL) + CW_BAR, MISC + 8);
#define GRID_BAR() do { XcdBarrier b_; b_.bar = (unsigned*)(args_ptr()->ws + WS_CTL) + CW_BAR; b_.x = xb_xcc_id(); b_.st = (volatile LAS unsigned*)(F.lds + MISC_OFF) + 8; xcd_barrier(b_); } while (0)
#define PHASE_PTRS() const ArgsP A = args_ptr(); unsigned char* ws = A->ws; float* SSQ = (float*)(ws + WS_CTL) + CW_SSQ; (void)SSQ; int bid = blockIdx.x, GG = F.G; asm volatile("" : "+s"(bid), "+s"(GG))

    p0_prologue(F);
    GRID_BAR();

    for (int l = 0; l < 4; ++l) {
        for (int sub = 0; sub < 2; ++sub) {
            if (sub == 0) {
                if ((l & 1) == 0) {
                    const int e = l >> 1;
                    {
                        PHASE_PTRS();
                        pg8::Gemm g{(const bf16*)(ws + WS_XB), (const bf16*)(ws + WS_WEI) + (size_t)e * 2048 * 5120, MT, 5120, 2048}; pg8::StaticOrder S; S.init(MT, 5120, GG, bid);
                        pg8::EpiEvenIn E{SSQ + (2 * l) * MT, ws + WS_T, A->out, e};
                        pg8::gemm_phase<pg8::EpiEvenIn, pg8::StaticOrder, true, true>(F.lds, g, S, E);
                    }
                    GRID_BAR();
                    {
                        lru_tasks<1>(F, e);
                        __syncthreads();
                        for (int u = F.vcu; u < 256; u += F.G) {
                            const int h = u >> 5, s = (u >> 4) & 1, p = u & 15;
                            for (int k = 0; k < 2; ++k) att::attn_sweep<false>(F, e, s, h, k ? 31 - p : p);
                            att::attn_sweep<true>(F, e, s, h, p);
                        }
                    }
                    GRID_BAR();
                    {
                        lru_tasks<2>(F, e);
                        attn_combine(F, e, 0.8f - 0.6f * __expf(-0.3f * (float)l));
                    }
                } else {
                    const int o = l >> 1;
                    {
                        PHASE_PTRS();
                        pg8::Gemm g{(const bf16*)(ws + WS_XB), (const bf16*)(ws + WS_WOI) + (size_t)o * 2048 * 4096, MT, 4096, 2048}; pg8::StaticOrder S; S.init(MT, 4096, GG, bid);
                        pg8::EpiOddIn E{SSQ + (2 * l) * MT, (bf16*)(ws + WS_U), (bf16*)(ws + WS_VR), SSQ + (9 + o) * MT};
                        pg8::gemm_phase<pg8::EpiOddIn, pg8::StaticOrder, true, true>(F.lds, g, S, E);
                    }
                    GRID_BAR();
                    gmlp_phase(F, o);
                }
            } else {
                PHASE_PTRS();
                pg8::Gemm g{(const bf16*)(ws + WS_XB), (const bf16*)(ws + WS_WUP) + (size_t)l * 2048 * 8192, MT, 8192, 2048}; pg8::StaticOrder S; S.init(MT, 8192, GG, bid);
                pg8::EpiUp E{SSQ + (2 * l + 1) * MT, (bf16*)(ws + WS_H)};
                pg8::gemm_phase<pg8::EpiUp, pg8::StaticOrder, true, true>(F.lds, g, S, E);
            }
            GRID_BAR();
            {
                PHASE_PTRS();
                const bf16* Wt = sub == 0 ? ((l & 1) == 0 ? (const bf16*)(ws + WS_WEO) + (size_t)(l >> 1) * 2048 * 2048 : (const bf16*)(ws + WS_WOO) + (size_t)(l >> 1) * 2048 * 2048)
                                          : (const bf16*)(ws + WS_WDN) + (size_t)l * 2048 * 8192;
                pg8::Gemm g{sub == 0 ? (const bf16*)(ws + WS_YC) : (const bf16*)(ws + WS_H), Wt, MT, 2048, sub == 0 ? 2048 : 8192}; pg8::StaticOrder S; S.init(MT, 2048, GG, bid);
                pg8::EpiResid E{(float*)(ws + WS_X), (bf16*)(ws + WS_XB), SSQ + (2 * l + 1 + sub) * MT};
                pg8::gemm_phase<pg8::EpiResid, pg8::StaticOrder, true, true>(F.lds, g, S, E);
            }
            GRID_BAR();
        }
    }
    final_norm(F);
}

extern "C" void kernel_launch(void* const* d_in, const int* in_sizes, int n_in, void* d_out, int out_size, void* d_ws, size_t ws_size, hipStream_t stream) {
    static int grid = 0;
    if (grid == 0) {
        if (n_in != 28 || (size_t)out_size != O_END || ws_size < WS_END) { fprintf(stderr, "kernel_launch: unexpected shapes (n_in %d out %d ws %zu)\n", n_in, out_size, ws_size); grid = -1; return; }
        int dev = 0, cus = 0, per_cu = 0;
        if (hipGetDevice(&dev) != hipSuccess || hipDeviceGetAttribute(&cus, hipDeviceAttributeMultiprocessorCount, dev) != hipSuccess) { grid = -1; return; }
        if (hipFuncSetAttribute((const void*)mk_fwd, hipFuncAttributeMaxDynamicSharedMemorySize, LDS_BYTES) != hipSuccess) { fprintf(stderr, "kernel_launch: hipFuncSetAttribute failed\n"); grid = -1; return; }
        if (hipOccupancyMaxActiveBlocksPerMultiprocessor(&per_cu, (const void*)mk_fwd, NWAVES * 64, LDS_BYTES) != hipSuccess || per_cu < 1) { fprintf(stderr, "kernel_launch: occupancy query says %d\n", per_cu); }
        (void)hipGetLastError();
        grid = cus;
    }
    if (grid < 0) return;
    if (hipMemsetAsync((char*)d_ws + WS_CTL, 0, CTL_ZERO_BYTES, stream) != hipSuccess) return;
    Args a{};
    for (int i = 0; i < 28; ++i) a.in[i] = (const float*)d_in[i];
    a.out = (float*)d_out; a.ws = (unsigned char*)d_ws;
    hipLaunchKernelGGL(mk_fwd, dim3(grid), dim3(NWAVES * 64), LDS_BYTES, stream, a);
}
```

```cpp
#include <hip/hip_runtime.h>
#include <cstdio>
#include <cstdint>
namespace pg8 {
#define PG8_LAS __attribute__((address_space(3)))
typedef unsigned short bf16_t;
typedef short bf16x8 __attribute__((ext_vector_type(8)));
typedef float f32x4 __attribute__((ext_vector_type(4)));
typedef unsigned u32x4 __attribute__((ext_vector_type(4)));
constexpr int BM = 256, BK = 64, HALF = 128, HTB = HALF * BK * 2  , STAGE_BYTES = 8 * HTB, NXCD = 8, WGM = 8;

__host__ __device__ __forceinline__ int lds_byte(int r, int c) { const int st = (r >> 4) * 2 + (c >> 5), rr = r & 15, cc = c & 31, ob = rr * 64 + cc * 2; return st * 1024 + (ob ^ (((ob >> 9) & 1) << 5)); }
__host__ __device__ __forceinline__ void stage_rc(int b, int& R, int& C) { const int st = b / 1024, sb = b % 1024, swz = sb ^ (((sb >> 9) & 1) << 5); R = (st >> 1) * 16 + swz / 64; C = (st & 1) * 32 + (swz % 64) / 2; }
__host__ __device__ __forceinline__ int perm32(int rho) { const int n = rho >> 4, i = rho & 15; return 8 * (i >> 2) + 4 * n + (i & 3); }

struct Unit { int pm, pn, ks; };
struct Gemm { const bf16_t* A; const bf16_t* Bt; int M, N, K, ld; };

struct StaticOrder {
    int nM, nN, nwg, G, c;
    __host__ __device__ void init(int M, int N, int G_, int c_) { nM = M / BM; nN = N / BM; nwg = nM * nN; G = G_; c = c_; }
    __host__ __device__ bool next(int i, Unit& u) const {
        const long L = (long)i * G + c; if (L >= nwg) return false;
        int wgid = (int)L; { const int q = nwg / NXCD, r = nwg % NXCD, xcd = wgid % NXCD, off = wgid / NXCD; wgid = (xcd < r ? xcd * (q + 1) : r * (q + 1) + (xcd - r) * q) + off; }
        const int nig = WGM * nN, gid = wgid / nig, fm = gid * WGM, gsz = (nM - fm) < WGM ? (nM - fm) : WGM;
        u.pm = fm + ((wgid % nig) % gsz); u.pn = (wgid % nig) / gsz; u.ks = 0; return true;
    }
    __device__ __forceinline__ void a_ready(const Unit&) const {}
    __device__ __forceinline__ void done(const Unit&) const {}
};

__device__ __forceinline__ unsigned cvt_pk_bf16(float lo, float hi) { unsigned r; asm volatile("v_cvt_pk_bf16_f32 %0, %1, %2" : "=v"(r) : "v"(lo), "v"(hi)); return r; }
struct SplitOrder {
    int pm, nN, nsplit, G, c;
    __host__ __device__ bool next(int i, Unit& u) const { const int L = i * G + c; if (L >= nN * nsplit) return false; u.pm = pm; u.pn = L % nN; u.ks = L / nN; return true; }
    __device__ __forceinline__ void a_ready(const Unit&) const {}
    __device__ __forceinline__ void done(const Unit&) const {}
};
struct DepOrder : StaticOrder {
    unsigned* cnt; unsigned need; int dep_pm; unsigned* tmo;
    __device__ __forceinline__ void a_ready(const Unit& u) const {
        if (need == 0u || u.pm != dep_pm) return;
        if (threadIdx.x < 64) {
            unsigned sp = 0u;
            while ((unsigned)__builtin_amdgcn_readfirstlane((int)__hip_atomic_load(cnt, __ATOMIC_RELAXED, __HIP_MEMORY_SCOPE_AGENT)) < need) {
                __builtin_amdgcn_s_sleep(2);
                if ((++sp & 255u) == 0u) { if (__hip_atomic_load(tmo, __ATOMIC_RELAXED, __HIP_MEMORY_SCOPE_AGENT)) break; if (sp > (1u << 18)) { __hip_atomic_fetch_add(tmo, 1u, __ATOMIC_RELAXED, __HIP_MEMORY_SCOPE_AGENT); break; } } }
            __builtin_amdgcn_fence(__ATOMIC_ACQUIRE, "agent");
            asm volatile("s_waitcnt vmcnt(0)" ::: "memory");
        }
        asm volatile("" ::: "memory"); __builtin_amdgcn_s_barrier(); asm volatile("" ::: "memory");
    }
};
typedef float f32x2 __attribute__((ext_vector_type(2)));
constexpr float RMS_EPS = 1e-6f;
constexpr float QSCALE = 0.125f * 1.4426950408889634f;
template <int O> __device__ __forceinline__ float xorl(float v) { return __builtin_bit_cast(float, __builtin_amdgcn_ds_swizzle(__builtin_bit_cast(int, v), (O << 10) | 0x1f)); }
__device__ __forceinline__ float sum_x32(float v) { auto rr = __builtin_amdgcn_permlane32_swap(__float_as_uint(v), __float_as_uint(v), false, false); const unsigned r0 = rr[0], r1 = rr[1]; return __uint_as_float(r0) + __uint_as_float(r1); }
__device__ __forceinline__ float max_x32(float v) { auto rr = __builtin_amdgcn_permlane32_swap(__float_as_uint(v), __float_as_uint(v), false, false); const unsigned r0 = rr[0], r1 = rr[1]; return fmaxf(__uint_as_float(r0), __uint_as_float(r1)); }
typedef unsigned long long ssq_t;
constexpr float SSQ_FX = 1048576.0f, SSQ_INV = 1.0f / 1048576.0f;
__device__ __forceinline__ ssq_t ssq_fx(float s) { return (ssq_t)(s * SSQ_FX + 0.5f); }
__device__ __forceinline__ float ssq_rstd(ssq_t q) { return __builtin_amdgcn_rsqf((float)q * (SSQ_INV / 2048.0f) + RMS_EPS); }
__device__ __forceinline__ void atomic_addq(ssq_t* p, float v) { __hip_atomic_fetch_add(p, ssq_fx(v), __ATOMIC_RELAXED, __HIP_MEMORY_SCOPE_AGENT); }
__device__ __forceinline__ void gelu8(f32x4& a, f32x4& b) {
    constexpr float C1 = -2.0f * 0.7978845608028654f * 1.4426950408889634f, C2 = C1 * 0.044715f;
    const f32x4 ya = a * (a * a * C2 + C1), yb = b * (b * b * C2 + C1);
    f32x4 ea, eb;
#pragma unroll
    for (int i = 0; i < 4; ++i) { ea[i] = __builtin_amdgcn_exp2f(ya[i]); eb[i] = __builtin_amdgcn_exp2f(yb[i]); }
    const f32x4 da = ea + 1.0f, db = eb + 1.0f;
    f32x4 ra, rb;
#pragma unroll
    for (int i = 0; i < 4; ++i) { ra[i] = __builtin_amdgcn_rcpf(da[i]); rb[i] = __builtin_amdgcn_rcpf(db[i]); }
    a = a * ra; b = b * rb;
}
__device__ __forceinline__ u32x4 pack8(const f32x4 a, const f32x4 b) { u32x4 w; w.x = cvt_pk_bf16(a[0], a[1]); w.y = cvt_pk_bf16(a[2], a[3]); w.z = cvt_pk_bf16(b[0], b[1]); w.w = cvt_pk_bf16(b[2], b[3]); return w; }
__device__ __forceinline__ float dot8(const f32x4 a, const f32x4 b) { return (a[0] * a[0] + a[1] * a[1]) + (a[2] * a[2] + a[3] * a[3]) + (b[0] * b[0] + b[1] * b[1]) + (b[2] * b[2] + b[3] * b[3]); }

struct EpiEvenIn {
    static constexpr bool PERM = true, AFTER_DRAIN = false;
    const ssq_t* ssq; unsigned char* tb  ; float* out; int e;
    __device__ __forceinline__ void operator()(const f32x4 (&acc)[2][2][4][2], const Unit& u, int wr, int wc, int fr, int fq) const {
        const int reg = u.pn >> 2;
        const int row0 = u.pm * BM + wr * 64 + fr, c0 = (u.pn & 3) * 256 + wc * 32 + 8 * fq;
        bf16_t* G = (bf16_t*)tb; float* XR = (float*)(tb + ((size_t)17 << 20)); bf16_t* Q = (bf16_t*)(tb + ((size_t)50 << 20));
        float rs[2][4];
#pragma unroll
        for (int ai = 0; ai < 2; ++ai)
#pragma unroll
            for (int m = 0; m < 4; ++m) rs[ai][m] = ssq_rstd(ssq[row0 + ai * HALF + m * 16]);
        if (reg == 0) {
#pragma unroll
            for (int ai = 0; ai < 2; ++ai)
#pragma unroll
                for (int m = 0; m < 4; ++m) { const size_t row = (size_t)(row0 + ai * HALF + m * 16); const float r = rs[ai][m];
#pragma unroll
                    for (int bj = 0; bj < 2; ++bj) { f32x4 v0 = acc[ai][bj][m][0] * r, v1 = acc[ai][bj][m][1] * r;
#pragma unroll
                        for (int i = 0; i < 1; ++i) gelu8(v0, v1);
                        *(u32x4*)(G + row * 1024 + c0 + bj * HALF) = pack8(v0, v1); } }
        } else if (reg == 1) {
#pragma unroll
            for (int ai = 0; ai < 2; ++ai)
#pragma unroll
                for (int m = 0; m < 4; ++m) { const size_t row = (size_t)(row0 + ai * HALF + m * 16); const float r = rs[ai][m];
#pragma unroll
                    for (int bj = 0; bj < 2; ++bj) { float* p = XR + row * 1024 + c0 + bj * HALF; *(f32x4*)p = acc[ai][bj][m][0] * r; *(f32x4*)(p + 4) = acc[ai][bj][m][1] * r; } }
        } else if (reg == 2) {
#pragma unroll
            for (int ai = 0; ai < 2; ++ai)
#pragma unroll
                for (int m = 0; m < 4; ++m) { const size_t row = (size_t)(row0 + ai * HALF + m * 16); const float r = rs[ai][m] * QSCALE;
#pragma unroll
                    for (int bj = 0; bj < 2; ++bj) *(u32x4*)(Q + row * 1024 + c0 + bj * HALF) = pack8(acc[ai][bj][m][0] * r, acc[ai][bj][m][1] * r); }
        } else {
            bf16_t* B = (bf16_t*)(tb + ((size_t)(reg == 3 ? 67 : 84) << 20));
            const size_t ooff = (u.pm < 32) ? (size_t)(reg == 3 ? 17309696 : 34086912) + (size_t)e * 8192 * 1024 : (size_t)(reg == 3 ? 50995200 : 51519488) + (size_t)e * 256 * 1024;
            float* O = out + ooff; const int orow0 = (u.pm < 32) ? row0 : row0 - 8192;
#pragma unroll
            for (int ai = 0; ai < 2; ++ai)
#pragma unroll
                for (int m = 0; m < 4; ++m) { const size_t row = (size_t)(row0 + ai * HALF + m * 16), orow = (size_t)(orow0 + ai * HALF + m * 16); const float r = rs[ai][m];
#pragma unroll
                    for (int bj = 0; bj < 2; ++bj) { const f32x4 v0 = acc[ai][bj][m][0] * r, v1 = acc[ai][bj][m][1] * r;
                        *(u32x4*)(B + row * 1024 + c0 + bj * HALF) = pack8(v0, v1);
                        float* p = O + orow * 1024 + c0 + bj * HALF; *(f32x4*)p = v0; *(f32x4*)(p + 4) = v1; } }
        }
    }
};
struct EpiResid {
    static constexpr bool PERM = true, AFTER_DRAIN = false;
    bf16_t* Xb; ssq_t* ssq_next;
    __device__ __forceinline__ void operator()(const f32x4 (&acc)[2][2][4][2], const Unit& u, int wr, int wc, int fr, int fq) const {
        const int row0 = u.pm * BM + wr * 64 + fr, c0 = u.pn * BM + wc * 32 + 8 * fq;
#pragma unroll
        for (int ai = 0; ai < 2; ++ai)
#pragma unroll
            for (int m = 0; m < 4; ++m) { const size_t row = (size_t)(row0 + ai * HALF + m * 16); float s = 0.f;
#pragma unroll
                for (int bj = 0; bj < 2; ++bj) { bf16_t* p = Xb + row * 2048 + c0 + bj * HALF; const u32x4 r = *(const u32x4*)p;
                    const f32x4 x0 = (f32x4){__uint_as_float(r.x << 16), __uint_as_float(r.x & 0xffff0000u), __uint_as_float(r.y << 16), __uint_as_float(r.y & 0xffff0000u)} + acc[ai][bj][m][0];
                    const f32x4 x1 = (f32x4){__uint_as_float(r.z << 16), __uint_as_float(r.z & 0xffff0000u), __uint_as_float(r.w << 16), __uint_as_float(r.w & 0xffff0000u)} + acc[ai][bj][m][1];
                    *(u32x4*)p = pack8(x0, x1); s += dot8(x0, x1); }
                s += xorl<16>(s); s = sum_x32(s);
                if (fq == 0) atomic_addq(ssq_next + row, s); }
    }
};
struct EpiUp {
    static constexpr bool PERM = true, AFTER_DRAIN = false;
    const ssq_t* ssq; bf16_t* H;
    __device__ __forceinline__ void operator()(const f32x4 (&acc)[2][2][4][2], const Unit& u, int wr, int wc, int fr, int fq) const {
        const int row0 = u.pm * BM + wr * 64 + fr, c0 = u.pn * BM + wc * 32 + 8 * fq;
#pragma unroll
        for (int ai = 0; ai < 2; ++ai)
#pragma unroll
            for (int m = 0; m < 4; ++m) { const size_t row = (size_t)(row0 + ai * HALF + m * 16); const float r = ssq_rstd(ssq[row]);
#pragma unroll
                for (int bj = 0; bj < 2; ++bj) { f32x4 v0 = acc[ai][bj][m][0] * r, v1 = acc[ai][bj][m][1] * r;
#pragma unroll
                    for (int i = 0; i < 4; ++i) { const float a = fmaxf(v0[i], 0.f), b = fmaxf(v1[i], 0.f); v0[i] = a * a; v1[i] = b * b; }
                    *(u32x4*)(H + row * 8192 + c0 + bj * HALF) = pack8(v0, v1); } }
    }
};
struct EpiOddIn {
    static constexpr bool PERM = true, AFTER_DRAIN = false;
    const ssq_t* ssq; bf16_t* U; bf16_t* VR; ssq_t* ssqv;
    __device__ __forceinline__ void operator()(const f32x4 (&acc)[2][2][4][2], const Unit& u, int wr, int wc, int fr, int fq) const {
        const int reg = u.pn >> 3;
        const int row0 = u.pm * BM + wr * 64 + fr, c0 = (u.pn & 7) * 256 + wc * 32 + 8 * fq;
        bf16_t* B = reg ? VR : U;
#pragma unroll
        for (int ai = 0; ai < 2; ++ai)
#pragma unroll
            for (int m = 0; m < 4; ++m) { const size_t row = (size_t)(row0 + ai * HALF + m * 16); const float r = ssq_rstd(ssq[row]); float s = 0.f;
#pragma unroll
                for (int bj = 0; bj < 2; ++bj) { f32x4 v0 = acc[ai][bj][m][0] * r, v1 = acc[ai][bj][m][1] * r;
#pragma unroll
                    for (int i = 0; i < 1; ++i) gelu8(v0, v1);
                    *(u32x4*)(B + row * 2048 + c0 + bj * HALF) = pack8(v0, v1); s += dot8(v0, v1); }
                if (reg) { s += xorl<16>(s); s = sum_x32(s); if (fq == 0) atomic_addq(ssqv + row, s); } }
    }
};
struct EpiSlab {
    static constexpr bool PERM = true, AFTER_DRAIN = false;
    float* slab; int N;
    __device__ __forceinline__ void operator()(const f32x4 (&acc)[2][2][4][2], const Unit& u, int wr, int wc, int fr, int fq) const {
        const int r0 = wr * 64 + fr, c0 = u.pn * BM + wc * 32 + 8 * fq;
#pragma unroll
        for (int ai = 0; ai < 2; ++ai)
#pragma unroll
            for (int m = 0; m < 4; ++m) { float* p = slab + ((size_t)(u.ks * 256 + r0 + ai * HALF + m * 16)) * N + c0;
#pragma unroll
                for (int bj = 0; bj < 2; ++bj) { *(f32x4*)(p + bj * HALF) = acc[ai][bj][m][0]; *(f32x4*)(p + bj * HALF + 4) = acc[ai][bj][m][1]; } }
    }
};
template <class Epi, class Sched, bool ALIGN_EPI = false, bool SP2 = false>
__device__ __forceinline__ void gemm_phase(PG8_LAS unsigned char* lds, const Gemm g, const Sched& S, const Epi& E, int wave0) {
    int wid_ = wave0; asm volatile("" : "+s"(wid_)); int lane_; asm volatile("v_mbcnt_lo_u32_b32 %0, -1, 0\n\tv_mbcnt_hi_u32_b32 %0, -1, %0" : "=v"(lane_));
    const int wid = wid_, lane = lane_, tid = wid * 64 + lane, wr = wid >> 2, wc = wid & 3, fr = lane & 15, fq = lane >> 4;
    const int K = g.K, nt = K / BK, ld = g.ld;
    unsigned voffA[2], voffB[2];
#pragma unroll
    for (int i = 0; i < 2; ++i) { int R, C; stage_rc(tid * 16 + i * 8192, R, C); const int Rb = Epi::PERM ? ((R & ~31) + perm32(R & 31)) : R;
        voffA[i] = (unsigned)(R * ld + C) * 2u; voffB[i] = (unsigned)(Rb * ld + C) * 2u; }
    const size_t kstep = (size_t)(BK * 2);
    const size_t hstep = (size_t)HALF * ld * 2; const size_t sstep = (size_t)K * 2  ;
    const size_t tstep = 2 * hstep;
    const unsigned ldsw = (unsigned)wid * 1024u;
    const int aoff = lds_byte(wr * 64 + fr, fq * 8), boff = lds_byte(wc * 32 + fr, fq * 8);
#define PG8_SA(b, h) (((b) * 2 + (h)) * HTB)
#define PG8_SB(b, h) ((4 + (b) * 2 + (h)) * HTB)
#define PG8_STAGE(bufoff, gbase, voff) do { _Pragma("unroll") for (int _i = 0; _i < 2; ++_i) \
        __builtin_amdgcn_global_load_lds((const unsigned*)((const char*)(gbase) + (voff)[_i]), (PG8_LAS unsigned*)(lds + (bufoff) + ldsw + _i * 8192), 16, 0, 0); } while (0)
#define PG8_LDA(dst, b, h) do { _Pragma("unroll") for (int m = 0; m < 4; ++m) _Pragma("unroll") for (int k = 0; k < 2; ++k) dst[m][k] = *(const PG8_LAS bf16x8*)(lds + PG8_SA(b, h) + aoff + m * 2048 + k * 1024); } while (0)
#define PG8_LDB(dst, b, h) do { _Pragma("unroll") for (int n = 0; n < 2; ++n) _Pragma("unroll") for (int k = 0; k < 2; ++k) dst[n][k] = *(const PG8_LAS bf16x8*)(lds + PG8_SB(b, h) + boff + n * 2048 + k * 1024); } while (0)
#define PG8_MMA(ai, bj, At, Bt) do { __builtin_amdgcn_s_setprio(1); _Pragma("unroll") for (int m = 0; m < 4; ++m) _Pragma("unroll") for (int n = 0; n < 2; ++n) _Pragma("unroll") for (int k = 0; k < 2; ++k) \
        acc[ai][bj][m][n] = __builtin_amdgcn_mfma_f32_16x16x32_bf16(Bt[n][k], At[m][k], acc[ai][bj][m][n], 0, 0, 0); __builtin_amdgcn_s_setprio(0); } while (0)
#define PG8_WAIT_V(n) asm volatile("s_waitcnt vmcnt(" #n ")" ::: "memory")
#define PG8_WAIT_L(n) asm volatile("s_waitcnt lgkmcnt(" #n ")" ::: "memory")
#define PG8_BAR __builtin_amdgcn_s_barrier()
#define PG8_SCHED __builtin_amdgcn_sched_barrier(0)
    Unit cur, nxt; int ui = 0;
    if (!S.next(0, cur)) return;
    f32x4 acc[2][2][4][2];
#pragma unroll
    for (int a = 0; a < 2; ++a)
#pragma unroll
        for (int b = 0; b < 2; ++b)
#pragma unroll
            for (int m = 0; m < 4; ++m)
#pragma unroll
                for (int n = 0; n < 2; ++n) acc[a][b][m][n] = (f32x4){0.f, 0.f, 0.f, 0.f};
    bf16x8 At[4][2], B0[2][2], B1[2][2];
    const char* cA = (const char*)g.A + (size_t)cur.pm * tstep + (size_t)cur.ks * sstep; const char* cB = (const char*)g.Bt + (size_t)cur.pn * tstep + (size_t)cur.ks * sstep;
    S.a_ready(cur);
    if constexpr (SP2) {
        PG8_STAGE(PG8_SB(0, 0), cB, voffB); PG8_STAGE(PG8_SB(0, 1), cB + hstep, voffB); PG8_STAGE(PG8_SA(0, 0), cA, voffA); PG8_STAGE(PG8_SA(0, 1), cA + hstep, voffA);
        if (wr == 1) PG8_BAR;
        PG8_WAIT_V(2); PG8_BAR;
        PG8_STAGE(PG8_SB(1, 0), cB + kstep, voffB); PG8_STAGE(PG8_SA(1, 0), cA + kstep, voffA); PG8_STAGE(PG8_SB(1, 1), cB + hstep + kstep, voffB);
        PG8_WAIT_V(6); PG8_BAR;
    } else {
        PG8_STAGE(PG8_SB(0, 0), cB, voffB); PG8_STAGE(PG8_SA(0, 0), cA, voffA); PG8_STAGE(PG8_SB(0, 1), cB + hstep, voffB); PG8_STAGE(PG8_SA(0, 1), cA + hstep, voffA);
        if (wr == 1) PG8_BAR;
        PG8_WAIT_V(4); PG8_BAR;
        PG8_STAGE(PG8_SB(1, 0), cB + kstep, voffB); PG8_STAGE(PG8_SA(1, 0), cA + kstep, voffA); PG8_STAGE(PG8_SB(1, 1), cB + hstep + kstep, voffB);
        PG8_WAIT_V(6); PG8_BAR;
    }
    for (;;) {
        const bool has_next = S.next(ui + 1, nxt);
        const char* nA = has_next ? (const char*)g.A + (size_t)nxt.pm * tstep + (size_t)nxt.ks * sstep : cA; const char* nB = has_next ? (const char*)g.Bt + (size_t)nxt.pn * tstep + (size_t)nxt.ks * sstep : cB;
        for (int t = 0; t < nt; t += 2) {
            const bool last = (t == nt - 2);
            const char* a1 = cA + (size_t)(t + 1) * kstep;
            const char* a2 = last ? nA : cA + (size_t)(t + 2) * kstep; const char* b2 = last ? nB : cB + (size_t)(t + 2) * kstep;
            const char* a3 = a2 + kstep; const char* b3 = b2 + kstep;
            if (last && has_next) S.a_ready(nxt);
            if constexpr (SP2) {
            PG8_LDB(B0, 0, 0); PG8_LDB(B1, 0, 1); PG8_SCHED; PG8_LDA(At, 0, 0); PG8_STAGE(PG8_SA(1, 1), a1 + hstep, voffA);
            PG8_WAIT_V(8); PG8_WAIT_L(0); PG8_BAR; PG8_MMA(0, 0, At, B0); PG8_MMA(0, 1, At, B1); PG8_BAR; PG8_SCHED;
            PG8_LDA(At, 0, 1); PG8_STAGE(PG8_SB(0, 0), b2, voffB); PG8_STAGE(PG8_SB(0, 1), b2 + hstep, voffB); PG8_STAGE(PG8_SA(0, 0), a2, voffA);
            PG8_WAIT_V(8); PG8_WAIT_L(0); PG8_BAR; PG8_MMA(1, 0, At, B0); PG8_MMA(1, 1, At, B1); PG8_BAR; PG8_SCHED;
            PG8_LDB(B0, 1, 0); PG8_LDB(B1, 1, 1); PG8_SCHED; PG8_LDA(At, 1, 0); PG8_STAGE(PG8_SA(0, 1), a2 + hstep, voffA);
            PG8_WAIT_V(8); PG8_WAIT_L(0); PG8_BAR; PG8_MMA(0, 0, At, B0); PG8_MMA(0, 1, At, B1); PG8_BAR; PG8_SCHED;
            PG8_LDA(At, 1, 1); PG8_STAGE(PG8_SB(1, 0), b3, voffB); PG8_STAGE(PG8_SB(1, 1), b3 + hstep, voffB); PG8_STAGE(PG8_SA(1, 0), a3, voffA);
            PG8_WAIT_V(8); PG8_WAIT_L(0); PG8_BAR; PG8_MMA(1, 0, At, B0); PG8_MMA(1, 1, At, B1); PG8_BAR; PG8_SCHED;
            } else {
            PG8_LDB(B0, 0, 0); PG8_SCHED; PG8_LDA(At, 0, 0); PG8_STAGE(PG8_SA(1, 1), a1 + hstep, voffA);
            PG8_WAIT_L(8); PG8_BAR; PG8_WAIT_L(0); PG8_MMA(0, 0, At, B0); PG8_BAR; PG8_SCHED;
            PG8_LDB(B1, 0, 1); PG8_STAGE(PG8_SB(0, 0), b2, voffB);
            PG8_BAR; PG8_WAIT_L(0); PG8_MMA(0, 1, At, B1); PG8_BAR;
            PG8_LDA(At, 0, 1); PG8_STAGE(PG8_SA(0, 0), a2, voffA);
            PG8_BAR; PG8_WAIT_L(0); PG8_MMA(1, 0, At, B0); PG8_BAR; PG8_SCHED;
            PG8_STAGE(PG8_SB(0, 1), b2 + hstep, voffB);
            PG8_WAIT_V(6); PG8_BAR; PG8_MMA(1, 1, At, B1); PG8_BAR;
            PG8_LDB(B0, 1, 0); PG8_SCHED; PG8_LDA(At, 1, 0); PG8_STAGE(PG8_SA(0, 1), a2 + hstep, voffA);
            PG8_WAIT_L(8); PG8_BAR; PG8_WAIT_L(0); PG8_MMA(0, 0, At, B0); PG8_BAR; PG8_SCHED;
            PG8_LDB(B1, 1, 1); PG8_STAGE(PG8_SB(1, 0), b3, voffB);
            PG8_BAR; PG8_WAIT_L(0); PG8_MMA(0, 1, At, B1); PG8_BAR;
            PG8_LDA(At, 1, 1); PG8_STAGE(PG8_SA(1, 0), a3, voffA);
            PG8_BAR; PG8_WAIT_L(0); PG8_MMA(1, 0, At, B0); PG8_BAR; PG8_SCHED;
            PG8_STAGE(PG8_SB(1, 1), b3 + hstep, voffB);
            PG8_WAIT_V(6); PG8_BAR; PG8_MMA(1, 1, At, B1); PG8_BAR;
            }
        }
        if constexpr (ALIGN_EPI) { if (wr == 0) PG8_BAR; }
        if constexpr (!Epi::AFTER_DRAIN) { E(acc, cur, wr, wc, fr, fq); S.done(cur); }
        if (!has_next) break;
#pragma unroll
        for (int a = 0; a < 2; ++a)
#pragma unroll
            for (int b = 0; b < 2; ++b)
#pragma unroll
                for (int m = 0; m < 4; ++m)
#pragma unroll
                    for (int n = 0; n < 2; ++n) acc[a][b][m][n] = (f32x4){0.f, 0.f, 0.f, 0.f};
        cur = nxt; cA = nA; cB = nB; ++ui;
        if constexpr (ALIGN_EPI) { if (wr == 1) PG8_BAR; }
    }
    PG8_WAIT_V(0);
    if constexpr (!ALIGN_EPI) { if (wr == 0) PG8_BAR; }
    PG8_BAR;
    if constexpr (Epi::AFTER_DRAIN) { E.fused(acc, cur, wr, wc, fr, fq, lds, wid, lane); S.done(cur); }
#undef PG8_SA
#undef PG8_SB
#undef PG8_STAGE
#undef PG8_LDA
#undef PG8_LDB
#undef PG8_MMA
#undef PG8_WAIT_V
#undef PG8_WAIT_L
#undef PG8_BAR
#undef PG8_SCHED
}
}

constexpr int DM = 2048, SEQ = 8192, NSMP = 256, MT = SEQ + NSMP  , DRNN = 1024, BW = 1024, DFF = 8192;
constexpr int NWAVES = 8;
constexpr float RMS_EPS = 1e-6f, LOG2E = 1.4426950408889634f;
constexpr size_t O_YP = 0, O_YS = O_YP + (size_t)SEQ * DM, O_PCONV = O_YS + (size_t)NSMP * DM, O_PLRU = O_PCONV + 2 * 3 * 1024, O_PK = O_PLRU + 2 * 1024, O_PV = O_PK + (size_t)2 * SEQ * 1024,
                 O_SCONV = O_PV + (size_t)2 * SEQ * 1024, O_SLRU = O_SCONV + 2 * 16 * 3 * 1024, O_SK = O_SLRU + 2 * 16 * 1024, O_SV = O_SK + (size_t)2 * NSMP * 1024, O_SGV = O_SV + (size_t)2 * NSMP * 1024,
                 O_END = O_SGV + (size_t)2 * NSMP * 2048;
constexpr size_t MiB = 1u << 20;
constexpr size_t WS_CTL = 0, CTL_ZERO_BYTES = 1 * MiB;
constexpr size_t WS_CS = 1 * MiB;
constexpr size_t WS_WAT = 2 * MiB, WS_WXT = WS_WAT + 256 * 1024, WS_WSB = 3 * MiB;
constexpr size_t WS_WEI = 4 * MiB, WS_WEO = 44 * MiB, WS_WOI = 60 * MiB, WS_WOO = 92 * MiB, WS_WUP = 108 * MiB, WS_WDN = 236 * MiB;
constexpr size_t WS_X = 364 * MiB, WS_XB = 430 * MiB, WS_YC = 463 * MiB;
constexpr size_t WS_T = 496 * MiB;
constexpr size_t WS_H = WS_T;
constexpr size_t WS_G = WS_T, WS_XR = WS_T + 17 * MiB, WS_Q = WS_T + 50 * MiB, WS_KB = WS_T + 67 * MiB, WS_VB = WS_T + 84 * MiB, WS_OS = WS_T + 101 * MiB;
constexpr size_t WS_U = WS_T, WS_VR = WS_T + 33 * MiB;
constexpr size_t WS_SLAB = WS_T + 168 * MiB;
constexpr size_t WS_END = WS_SLAB + 64 * MiB;
static_assert(WS_G == WS_T && WS_XR == WS_T + (17u << 20) && WS_Q == WS_T + (50u << 20) && WS_KB == WS_T + (67u << 20) && WS_VB == WS_T + (84u << 20), "EpiEvenIn offsets");
static_assert(O_PK == 17309696 && O_PV == 34086912 && O_SK == 50995200 && O_SV == 51519488, "EpiEvenIn output offsets");
constexpr int CW_TMO = 0, CW_CODE = 1, CW_BAR = 4096, CW_SSQ = 8192;
constexpr int CW_FIN2 = CW_SSQ + 2 * 11 * MT + 2560;
constexpr int CW_FIN = CW_SSQ + 2 * 11 * MT + 512;
static_assert((CW_FIN + 64 * 9) * 4 <= (int)CTL_ZERO_BYTES, "CTL");
constexpr int RING_BYTES = 131072, LDSCTL_OFF = RING_BYTES, MISC_OFF = LDSCTL_OFF + 320, LDS_BYTES = 147456;

#define GAS __attribute__((address_space(1)))
#define LAS __attribute__((address_space(3)))
typedef unsigned short bf16;
typedef unsigned v4u __attribute__((ext_vector_type(4)));
typedef float f32x4 __attribute__((ext_vector_type(4)));
typedef short bf16x8 __attribute__((ext_vector_type(8)));
typedef GAS unsigned gu32;
typedef GAS unsigned long long gu64;
#define RLX_AGENT __ATOMIC_RELAXED, __HIP_MEMORY_SCOPE_AGENT
#define LDS_WAIT() asm volatile("s_waitcnt lgkmcnt(0)" ::: "memory")
#define VM_WAIT() asm volatile("s_waitcnt vmcnt(0)" ::: "memory")
__device__ __forceinline__ unsigned long long rt() { return __builtin_amdgcn_s_memrealtime(); }
__device__ __forceinline__ unsigned f2bf(float f) { unsigned u = __builtin_bit_cast(unsigned, f); return (u + 0x7fffu + ((u >> 16) & 1u)) >> 16; }
typedef float f32x2_t __attribute__((ext_vector_type(2))); typedef __bf16 bf16x2_t __attribute__((ext_vector_type(2)));
__device__ __forceinline__ unsigned pk2(float lo, float hi) { f32x2_t v = {lo, hi}; bf16x2_t b = __builtin_convertvector(v, bf16x2_t); return __builtin_bit_cast(unsigned, b); }

#define XB_TMO      128
#define XB_XCNT(j)  (256  + 64 * (j))
#define XB_XSUB(j)  (1280 + 64 * (j))
#define XB_XGEN(j)  (2304 + 64 * (j))
#define XB_TOP      3328
#define XB_TOPGEN   3392
#define XCD_BAR_WORDS 3456
#define XB_SPIN_CAP (1u << 18)

__device__ __forceinline__ unsigned xb_ld(unsigned* p)              { return __hip_atomic_load(p, __ATOMIC_RELAXED, __HIP_MEMORY_SCOPE_AGENT); }
__device__ __forceinline__ unsigned xb_add(unsigned* p, unsigned v) { return __hip_atomic_fetch_add(p, v, __ATOMIC_RELAXED, __HIP_MEMORY_SCOPE_AGENT); }
__device__ __forceinline__ unsigned xb_xcc_id() { return (unsigned)__builtin_amdgcn_s_getreg((3 << 11) | 20) & 0xFu; }
#define XB_SPIN(cond, bar) do { unsigned _sp = 0; while (cond) { __builtin_amdgcn_s_sleep(1); \
    if ((++_sp & 255u) == 0u) { if (xb_ld(&(bar)[XB_TMO])) break; if (_sp > XB_SPIN_CAP) { atomicAdd(&(bar)[XB_TMO], 1u); break; } } } } while (0)

struct XcdBarrier {
    unsigned* bar; unsigned x;
    volatile LAS unsigned* st;
};

__device__ __forceinline__ XcdBarrier xcd_barrier_post(unsigned* bar, volatile LAS unsigned* st) {
    XcdBarrier b; b.bar = bar; b.x = xb_xcc_id(); b.st = st;
    if (threadIdx.x == 0) (void)xb_add(&bar[XB_XCNT(b.x)], 1u);
    return b;
}
__device__ __forceinline__ void xcd_barrier_complete(unsigned* bar, unsigned x, unsigned& nloc, unsigned& nx) {
    const unsigned G = gridDim.x * gridDim.y * gridDim.z;
    unsigned sum, cnt, mine, sp = 0u;
    for (;;) {
        sum = 0u; cnt = 0u; mine = 0u;
#pragma unroll
        for (unsigned j = 0; j < 16; ++j) { const unsigned c = xb_ld(&bar[XB_XCNT(j)]); sum += c; cnt += (c > 0u) ? 1u : 0u; mine = (j == x) ? c : mine; }
        if (sum == G) break;
        __builtin_amdgcn_s_sleep(1);
        if ((++sp & 255u) == 0u) { if (xb_ld(&bar[XB_TMO])) break; if (sp > XB_SPIN_CAP) { atomicAdd(&bar[XB_TMO], 1u); break; } }
    }
    nloc = mine > 0u ? mine : 1u; nx = cnt > 0u ? cnt : 1u;
}

__device__ __forceinline__ void xcd_barrier(const XcdBarrier& b) {
    asm volatile("s_waitcnt vmcnt(0)" ::: "memory");
    __syncthreads();
    if (threadIdx.x == 0) {
        unsigned* bar = b.bar;
        __builtin_amdgcn_s_waitcnt(0);
        unsigned nloc = b.st[0], nx = b.st[1];
        if (nloc == 0u) { xcd_barrier_complete(bar, b.x, nloc, nx); b.st[0] = nloc; b.st[1] = nx; }
        const unsigned old = xb_add(&bar[XB_XSUB(b.x)], 1u);
        const unsigned gen = old / nloc;
        if (old + 1u == (gen + 1u) * nloc) {
            __builtin_amdgcn_fence(__ATOMIC_RELEASE, "agent");
            asm volatile("s_waitcnt vmcnt(0)" ::: "memory");
            const unsigned og = xb_add(&bar[XB_TOP], 1u);
            const unsigned tg = og / nx;
            if (og + 1u == (tg + 1u) * nx) xb_add(&bar[XB_TOPGEN], 1u);
            else XB_SPIN(xb_ld(&bar[XB_TOPGEN]) == tg, bar);
            __builtin_amdgcn_fence(__ATOMIC_ACQUIRE, "agent");
            xb_add(&bar[XB_XGEN(b.x)], 1u);
            asm volatile("s_waitcnt vmcnt(0)" ::: "memory");
        } else {
            XB_SPIN(xb_ld(&bar[XB_XGEN(b.x)]) == gen, bar);
            __builtin_amdgcn_fence(__ATOMIC_ACQUIRE, "agent");
            asm volatile("s_waitcnt vmcnt(0)" ::: "memory");
        }
    }
    __syncthreads();
}


struct Args { const float* in[28]; float* out; unsigned char* ws; };
typedef const __attribute__((address_space(4))) Args* ArgsP;
__device__ __forceinline__ ArgsP args_ptr() { ArgsP p = (ArgsP)__builtin_amdgcn_kernarg_segment_ptr(); asm volatile("" : "+s"(p)); return p; }
struct Frame { LAS unsigned char* lds; int tid, lane, wave, vcu, G; };
__device__ __forceinline__ int lane_id() { int l; asm volatile("v_mbcnt_lo_u32_b32 %0, -1, 0\n\tv_mbcnt_hi_u32_b32 %0, -1, %0" : "=v"(l)); return l; }
__device__ __forceinline__ Frame phase_frame(const Frame& F0) { Frame F = F0; int w = F0.wave, v = F0.vcu; asm volatile("" : "+s"(w), "+s"(v)); int ln = lane_id(); F.wave = w; F.vcu = v; F.lane = ln; F.tid = w * 64 + ln; return F; }

__device__ __forceinline__ float wave_sum(float v) { v += pg8::xorl<1>(v); v += pg8::xorl<2>(v); v += pg8::xorl<4>(v); v += pg8::xorl<8>(v); v += pg8::xorl<16>(v); return pg8::sum_x32(v); }
__device__ __forceinline__ float bperm(int srclane, float v) { return __builtin_bit_cast(float, __builtin_amdgcn_ds_bpermute(srclane << 2, __builtin_bit_cast(int, v))); }
__device__ __forceinline__ float bf_lo(unsigned w) { return __uint_as_float(w << 16); }
__device__ __forceinline__ float bf_hi(unsigned w) { return __uint_as_float(w & 0xffff0000u); }
__device__ __forceinline__ float sigmoidf_(float x) { return __builtin_amdgcn_rcpf(1.0f + __builtin_amdgcn_exp2f(-LOG2E * x)); }

struct P0Item { const float* W; const float* sc; bf16* WT; int K, N, k0, n0; };
__host__ __device__ constexpr int p0_layer_items(int l) { return (l & 1) ? 32 * 128 + 32 * 64 + 32 * 256 + 128 * 64 : 32 * 160 + 32 * 64 + 32 * 256 + 128 * 64; }
__device__ __forceinline__ P0Item p0_decode(const ArgsP A, unsigned char* ws, int l, int r) {
    constexpr int I_EO = 32 * 64, I_UP = 32 * 256;
    const int hl = l >> 1, I_IN = (l & 1) ? 32 * 128 : 32 * 160; P0Item P;
    if (r < I_IN) {
        if (l & 1) { P.K = 2048; P.N = 4096; P.W = A->in[18] + (size_t)hl * 2048 * 4096; P.WT = (bf16*)(ws + WS_WOI) + (size_t)hl * 2048 * 4096; }
        else { P.K = 2048; P.N = 5120; P.W = A->in[6] + (size_t)hl * 2048 * 5120; P.WT = (bf16*)(ws + WS_WEI) + (size_t)hl * 2048 * 5120; }
        P.sc = A->in[23] + l * 2048; }
    else if ((r -= I_IN) < I_EO) { P.K = 2048; P.N = 2048; P.W = ((l & 1) ? A->in[19] : A->in[7]) + (size_t)hl * 2048 * 2048; P.WT = (bf16*)(ws + ((l & 1) ? WS_WOO : WS_WEO)) + (size_t)hl * 2048 * 2048; P.sc = nullptr; }
    else if ((r -= I_EO) < I_UP) { P.K = 2048; P.N = 8192; P.W = A->in[26] + (size_t)l * 2048 * 8192; P.WT = (bf16*)(ws + WS_WUP) + (size_t)l * 2048 * 8192; P.sc = A->in[24] + l * 2048; }
    else { r -= I_UP; P.K = 8192; P.N = 2048; P.W = A->in[27] + (size_t)l * 8192 * 2048; P.WT = (bf16*)(ws + WS_WDN) + (size_t)l * 8192 * 2048; P.sc = nullptr; }
    const int nblk = P.N / 32; P.k0 = 64 * (r / nblk); P.n0 = 32 * (r % nblk);
    return P;
}
__device__ __forceinline__ void p0_load(const P0Item& P, f32x4 (&v)[8], int lane) {
    const int kr = lane >> 3, c4 = (lane & 7) * 4;
#pragma unroll
    for (int i = 0; i < 8; ++i) v[i] = __builtin_nontemporal_load((const GAS f32x4*)(P.W + (size_t)(P.k0 + 8 * i + kr) * P.N + P.n0 + c4));
}
__device__ __forceinline__ void p0_finish(const P0Item& P, const f32x4 (&v)[8], LAS float* scr, int lane) {
    const int kr = lane >> 3, c4 = (lane & 7) * 4;
#pragma unroll
    for (int i = 0; i < 8; ++i) { const int kk = 8 * i + kr; const float s = P.sc ? P.sc[P.k0 + kk] : 1.0f; LAS float* d = scr + kk * 33 + c4; d[0] = v[i].x * s; d[1] = v[i].y * s; d[2] = v[i].z * s; d[3] = v[i].w * s; }
    LDS_WAIT(); asm volatile("" ::: "memory");
    const int c = lane & 7;
#pragma unroll
    for (int j = 0; j < 4; ++j) { const int n = (lane >> 3) + 8 * j; const LAS float* s = scr + (8 * c) * 33 + n;
        v4u o; o.x = pk2(s[0 * 33], s[1 * 33]); o.y = pk2(s[2 * 33], s[3 * 33]); o.z = pk2(s[4 * 33], s[5 * 33]); o.w = pk2(s[6 * 33], s[7 * 33]);
        __builtin_nontemporal_store(o, (GAS v4u*)(P.WT + (size_t)(P.n0 + n) * P.K + P.k0 + 8 * c)); }
    LDS_WAIT(); asm volatile("" ::: "memory");
}
__device__ __forceinline__ void p0_prologue(const Frame& F0) {
    const ArgsP A = args_ptr();
    const Frame F = phase_frame(F0);
    LAS float* scr = (LAS float*)(F.lds + F.wave * 16384);
    const int gw = F.vcu * NWAVES + F.wave, NGW = F.G * NWAVES;
    unsigned char* ws = A->ws;
    constexpr int NIT = 32 * 160;
    {
        f32x4 va[8], vb[8]; P0Item Pa, Pb;
        int it = gw;
        if (it < NIT) { Pa = p0_decode(A, ws, 0, it); p0_load(Pa, va, F.lane); }
        for (; it < NIT; it += 2 * NGW) {
            const bool hb = it + NGW < NIT;
            if (hb) { Pb = p0_decode(A, ws, 0, it + NGW); p0_load(Pb, vb, F.lane); }
            p0_finish(Pa, va, scr, F.lane);
            if (it + 2 * NGW < NIT) { Pa = p0_decode(A, ws, 0, it + 2 * NGW); p0_load(Pa, va, F.lane); }
            if (hb) p0_finish(Pb, vb, scr, F.lane);
        }
    }
    bf16* Xb = (bf16*)(ws + WS_XB); pg8::ssq_t* ssq0 = (pg8::ssq_t*)((float*)(ws + WS_CTL) + CW_SSQ);
    for (int m = gw; m < MT; m += NGW) {
        const float* src = m < SEQ ? A->in[0] + (size_t)m * DM : A->in[1] + (size_t)(m - SEQ) * DM;
        f32x4 v[8]; float s = 0.f;
#pragma unroll
        for (int j = 0; j < 8; ++j) { v[j] = ((const GAS f32x4*)src)[F.lane + 64 * j]; s += (v[j].x * v[j].x + v[j].y * v[j].y) + (v[j].z * v[j].z + v[j].w * v[j].w); }
        s = wave_sum(s);
#pragma unroll
        for (int j = 0; j < 8; ++j)
            ((GAS unsigned long long*)(Xb + (size_t)m * DM))[F.lane + 64 * j] = (unsigned long long)pk2(v[j].x, v[j].y) | ((unsigned long long)pk2(v[j].z, v[j].w) << 32);
        if (F.lane == 0) ssq0[m] = pg8::ssq_fx(s);
    }
    const int gt = gw * 64 + F.lane, NGT = NGW * 64;
    bf16* waT = (bf16*)(ws + WS_WAT); bf16* wxT = (bf16*)(ws + WS_WXT); bf16* wsb = (bf16*)(ws + WS_WSB);
    for (int idx = gt; idx < 2 * 16 * 64 * 64; idx += NGT) { const int eg = idx >> 12, j = (idx >> 6) & 63, i = idx & 63; const int src = (eg * 64 + i) * 64 + j;
        waT[idx] = (bf16)f2bf(A->in[10][src]); wxT[idx] = (bf16)f2bf(A->in[12][src]); }
    for (int idx = gt; idx < 2 * 16 * 128 * 128; idx += NGT) { const int t = (idx >> 7) & 127, s = idx & 127; wsb[idx] = s <= t ? (bf16)f2bf(A->in[21][idx]) : (bf16)0; }
}

__device__ __forceinline__ void weight_items(const Frame& F0, int l, int first, int n, int cui, int ncu) {
    const ArgsP A = args_ptr();
    const Frame F = phase_frame(F0);
    LAS float* scr = (LAS float*)(F.lds + F.wave * 16384);
    unsigned char* ws = A->ws;
    const int end = first + n, stride = ncu * NWAVES;
    f32x4 va[8], vb[8]; P0Item Pa, Pb;
    int it = first + cui * NWAVES + F.wave;
    if (it < end) { Pa = p0_decode(A, ws, l, it); p0_load(Pa, va, F.lane); }
    for (; it < end; it += 2 * stride) {
        const bool hb = it + stride < end;
        if (hb) { Pb = p0_decode(A, ws, l, it + stride); p0_load(Pb, vb, F.lane); }
        p0_finish(Pa, va, scr, F.lane);
        if (it + 2 * stride < end) { Pa = p0_decode(A, ws, l, it + 2 * stride); p0_load(Pa, va, F.lane); }
        if (hb) p0_finish(Pb, vb, scr, F.lane);
    }
}
constexpr int GE_E1 = 224, GE_O1 = 176, GE_F1 = 216;
__device__ __forceinline__ void conv_phase(const Frame& F, int kind  , int l, int cui, int ncu) {
    constexpr int IE = 32 * 160, IO = 32 * 128, IX = 32 * 64, IU = 32 * 256, ID = 128 * 64;
    int la, fa, na, nb;
    if (kind == 0) { la = l; fa = l == 0 ? IE : IE + IX; na = IE + IX + IU - fa; nb = 0; }
    else if (kind == 1) { la = l; fa = IO; na = IX + IU + ID; nb = 0; }
    else if (!(l & 1)) { la = l; fa = IE + IX + IU; na = ID; nb = IO; }
    else { la = l; fa = 0; na = 0; nb = l < 3 ? IE + IX : 0; }
    if (na) weight_items(F, la, fa, na, cui, ncu);
    if (nb) weight_items(F, l + 1, 0, nb, cui, ncu);
}

typedef short bf16x8 __attribute__((ext_vector_type(8)));
typedef float f32x16 __attribute__((ext_vector_type(16)));
template <int PASS>
__device__ __forceinline__ void lru_tasks(const Frame& F0, int e) {
    const ArgsP A = args_ptr();
    const Frame F = phase_frame(F0);
    LAS unsigned char* wl = F.lds + F.wave * 10752;
    LAS unsigned short* xcT = (LAS unsigned short*)wl;
    LAS float* GR = (LAS float*)(wl + 2304);
    LAS float* GI = GR + 1024;
    const int lane = F.lane, j16 = lane & 15, q4 = lane >> 4;
    const int gw = F.vcu * NWAVES + F.wave, NGW = F.G * NWAVES;
    unsigned char* ws = A->ws;
    const float* XR = (const float*)(ws + WS_XR); const bf16* G = (const bf16*)(ws + WS_G); bf16* YC = (bf16*)(ws + WS_YC);
    float* CSA = (float*)(ws + WS_CS); float* CSB = CSA + 128 * 1024;
    const bf16* waT = (const bf16*)(ws + WS_WAT); const bf16* wxT = (const bf16*)(ws + WS_WXT);
    constexpr int NTASK = PASS == 1 ? 2048 : 2304;
    for (int task = gw; task < NTASK; task += NGW) {
        const bool smp = task >= 2048;
        const int g = task & 15, ci = smp ? ((task - 2048) >> 4) : (task >> 4);
        const int R0 = smp ? SEQ + 16 * ci : 64 * ci, ntile = smp ? 1 : 4, chb = 64 * g, c = chb + lane;
        const float cw0 = A->in[8][(e * 4 + 0) * 1024 + c], cw1 = A->in[8][(e * 4 + 1) * 1024 + c], cw2 = A->in[8][(e * 4 + 2) * 1024 + c], cw3 = A->in[8][(e * 4 + 3) * 1024 + c];
        const float cb = A->in[9][e * 1024 + c], ba = A->in[11][e * 1024 + c], bx = A->in[13][e * 1024 + c];
        const float nl8 = -8.0f * LOG2E * log1pf(__expf(-A->in[14][e * 1024 + c]));
        float h = 0.f;
        if (PASS == 2) {
            if (smp) h = A->in[3][(e * 16 + ci) * 1024 + c];
            else {
                const int len = (ci + 3) >> 2;
                float As[4], Bs[4]; float one_ = 1.f, zero_ = 0.f; asm volatile("" : "+v"(one_), "+v"(zero_));
#pragma unroll
                for (int q = 0; q < 4; ++q) { As[q] = one_; Bs[q] = zero_; }
                for (int j0 = 0; j0 < len; j0 += 4) {
                    float av[4][4], bv[4][4];
#pragma unroll
                    for (int dj = 0; dj < 4; ++dj)
#pragma unroll
                        for (int q = 0; q < 4; ++q) { const int jj = q * len + j0 + dj; const bool ok = j0 + dj < len && jj < ci; const int jc = ok ? jj : 0;
                            const float a = ((const GAS float*)CSA)[jc * 1024 + c], bq = ((const GAS float*)CSB)[jc * 1024 + c]; av[dj][q] = ok ? a : one_; bv[dj][q] = ok ? bq : zero_; }
#pragma unroll
                    for (int dj = 0; dj < 4; ++dj)
#pragma unroll
                        for (int q = 0; q < 4; ++q) { Bs[q] = av[dj][q] * Bs[q] + bv[dj][q]; As[q] = av[dj][q] * As[q]; }
                }
#pragma unroll
                for (int q = 0; q < 4; ++q) h = As[q] * h + Bs[q];
            }
        }
        bf16x8 waB[4][2], wxB[4][2];
#pragma unroll
        for (int n = 0; n < 4; ++n)
#pragma unroll
            for (int ks = 0; ks < 2; ++ks) { const size_t off = ((size_t)((e * 16 + g) * 64 + 16 * n + j16)) * 64 + 32 * ks + 8 * q4;
                waB[n][ks] = *(const bf16x8*)(waT + off); wxB[n][ks] = *(const bf16x8*)(wxT + off); }
        float Ac = 1.f, Bc = 0.f;
        float xv[19];
#pragma unroll
        for (int rr = 0; rr < 3; ++rr) {
            if (!smp) { const int row = R0 - 3 + rr; xv[rr] = row >= 0 ? XR[(size_t)row * 1024 + c] : 0.f; }
            else xv[rr] = A->in[2][((e * 16 + ci) * 3 + rr) * 1024 + c];
        }
#pragma unroll
        for (int rr = 0; rr < 16; ++rr) xv[3 + rr] = XR[(size_t)(R0 + rr) * 1024 + c];
        for (int ti = 0; ti < ntile; ++ti) {
            const int t0 = R0 + 16 * ti;
            float xn[16]; unsigned short gv[16];
            if (ti + 1 < ntile) {
#pragma unroll
                for (int rr = 0; rr < 16; ++rr) xn[rr] = XR[(size_t)(t0 + 16 + rr) * 1024 + c];
            }
            if (PASS == 2) {
#pragma unroll
                for (int rr = 0; rr < 16; ++rr) gv[rr] = G[(size_t)(t0 + rr) * 1024 + c];
            }
            float xc[16];
#pragma unroll
            for (int t = 0; t < 16; ++t) { xc[t] = cb + cw0 * xv[t] + cw1 * xv[t + 1] + cw2 * xv[t + 2] + cw3 * xv[t + 3]; xcT[t * 72 + lane] = (unsigned short)f2bf(xc[t]); }
            bf16x8 xa[2];
#pragma unroll
            for (int ks = 0; ks < 2; ++ks) xa[ks] = *(const LAS bf16x8*)((const LAS unsigned char*)xcT + j16 * 144 + (32 * ks + 8 * q4) * 2);
#pragma unroll
            for (int n = 0; n < 4; ++n) { const f32x4 z = {0.f, 0.f, 0.f, 0.f};
                f32x4 ra = __builtin_amdgcn_mfma_f32_16x16x32_bf16(xa[0], waB[n][0], z, 0, 0, 0); ra = __builtin_amdgcn_mfma_f32_16x16x32_bf16(xa[1], waB[n][1], ra, 0, 0, 0);
                f32x4 ia = __builtin_amdgcn_mfma_f32_16x16x32_bf16(xa[0], wxB[n][0], z, 0, 0, 0); ia = __builtin_amdgcn_mfma_f32_16x16x32_bf16(xa[1], wxB[n][1], ia, 0, 0, 0);
#pragma unroll
                for (int v = 0; v < 4; ++v) { GR[(4 * q4 + v) * 64 + 16 * n + j16] = ra[v]; GI[(4 * q4 + v) * 64 + 16 * n + j16] = ia[v]; } }
            f32x4 av[4], uv[4];
#pragma unroll
            for (int q = 0; q < 4; ++q) {
                f32x4 gr, gi, xq;
#pragma unroll
                for (int v = 0; v < 4; ++v) { gr[v] = GR[(4 * q + v) * 64 + lane]; gi[v] = GI[(4 * q + v) * 64 + lane]; xq[v] = xc[4 * q + v]; }
                gr = (gr + ba) * (-LOG2E); gi = (gi + bx) * (-LOG2E);
                f32x4 er, ei;
#pragma unroll
                for (int v = 0; v < 4; ++v) { er[v] = __builtin_amdgcn_exp2f(gr[v]); ei[v] = __builtin_amdgcn_exp2f(gi[v]); }
                er = er + 1.0f; ei = ei + 1.0f;
                f32x4 rr, ig;
#pragma unroll
                for (int v = 0; v < 4; ++v) { rr[v] = __builtin_amdgcn_rcpf(er[v]); ig[v] = __builtin_amdgcn_rcpf(ei[v]); }
                rr = rr * nl8;
                f32x4 a4;
#pragma unroll
                for (int v = 0; v < 4; ++v) a4[v] = __builtin_amdgcn_exp2f(rr[v]);
                f32x4 om = 1.0f - a4 * a4;
#pragma unroll
                for (int v = 0; v < 4; ++v) om[v] = __builtin_amdgcn_sqrtf(fmaxf(om[v], 0.f));
                av[q] = a4; uv[q] = om * ig * xq;
            }
#pragma unroll
            for (int t = 0; t < 16; ++t) {
                const float a = av[t >> 2][t & 3], uu = uv[t >> 2][t & 3];
                if (PASS == 1) { Bc = a * Bc + uu; Ac = a * Ac; }
                else { h = a * h + uu; YC[(size_t)(t0 + t) * 2048 + c] = (bf16)f2bf(__uint_as_float((unsigned)gv[t] << 16) * h); }
            }
#pragma unroll
            for (int rr = 0; rr < 3; ++rr) xv[rr] = xv[16 + rr];
            if (ti + 1 < ntile) {
#pragma unroll
                for (int rr = 0; rr < 16; ++rr) xv[3 + rr] = xn[rr];
            }
        }
        if (PASS == 1) { CSA[ci * 1024 + c] = Ac; CSB[ci * 1024 + c] = Bc; }
        else {
            if (smp) { A->out[O_SLRU + (size_t)(e * 16 + ci) * 1024 + c] = h;
#pragma unroll
                for (int rr = 0; rr < 3; ++rr) A->out[O_SCONV + (size_t)((e * 16 + ci) * 3 + rr) * 1024 + c] = xv[rr]; }
            else if (ci == 127) { A->out[O_PLRU + (size_t)e * 1024 + c] = h;
#pragma unroll
                for (int rr = 0; rr < 3; ++rr) A->out[O_PCONV + (size_t)(e * 3 + rr) * 1024 + c] = xv[rr]; }
        }
    }
}

namespace att {
constexpr int PKT = 8192, PBUF = PKT + 16384;
constexpr int KP = 144, VP = 320, KT = 64 * KP, VT = 64 * VP, BUFB = KT + VT, NBUF = 4  , LUT_OFF = NBUF * BUFB, LUT_N = 832, LUT_Z = 767;
constexpr float NEG = -1e30f;
__device__ __forceinline__ int crow(int r, int hi) { return (r & 3) + 8 * (r >> 2) + 4 * hi; }
__device__ __forceinline__ int rel_bucket(int rel) {
    const int n = rel < 0 ? -rel : rel;
    const int b = n < 8 ? n : (n < 14 ? 8 : n < 23 ? 9 : n < 39 ? 10 : n < 64 ? 11 : n < 108 ? 12 : n < 182 ? 13 : n < 305 ? 14 : 15);
    return (rel > 0 ? 16 : 0) + b;
}
typedef short v4i16_t __attribute__((ext_vector_type(4)));
__device__ __forceinline__ float max3f(float a, float b, float c) { return __builtin_fmaxf(__builtin_fmaxf(a, b), c); }
__device__ __forceinline__ v4i16_t vtr(const LAS unsigned char* p) { return __builtin_amdgcn_ds_read_tr16_b64_v4i16((LAS v4i16_t*)p); }
#define ATT_BAR() do { asm volatile("s_waitcnt lgkmcnt(0)" ::: "memory"); __builtin_amdgcn_s_barrier(); asm volatile("" ::: "memory"); } while (0)

template <bool SAMPLE>
__device__ __forceinline__ void attn_sweep(const Frame& F0, int e, int s, int h, int qi  ) {
    const ArgsP A = args_ptr();
    const Frame F = phase_frame(F0);
    LAS unsigned char* lds = F.lds;
    LAS float* lut = (LAS float*)(lds + LUT_OFF);
    const int tid = F.tid, lane = F.lane, w = F.wave, r32 = lane & 31, hi = lane >> 5;
    unsigned char* ws = A->ws;
    const bf16* Qb = (const bf16*)(ws + WS_Q); const bf16* Kb = (const bf16*)(ws + WS_KB); const bf16* Vb = (const bf16*)(ws + WS_VB);
    bf16* OS = (bf16*)(ws + WS_OS) + (size_t)s * MT * 1024;
    const float* ck = A->in[4] + (size_t)(e * 16 + qi) * 1024 * 1024; const float* cv = A->in[5] + (size_t)(e * 16 + qi) * 1024 * 1024;
    const int NT = SAMPLE ? 17 : 4 * qi + 4;
    const int tfar = SAMPLE ? 10 : (4 * qi - 6 > 0 ? 4 * qi - 6 : 0);
    const int tmax = SAMPLE ? (w == 0 ? 16 : -1) : 4 * qi + (w >> 1);
    const int grow = SAMPLE ? SEQ + 16 * qi + (r32 & 15) : 256 * qi + 32 * w + r32;
    const int qpos = SAMPLE ? 1024 + (r32 & 15) : grow;
    for (int i = tid; i < LUT_N; i += 512) lut[i] = LOG2E * A->in[17][rel_bucket(i - LUT_Z) * 8 + h];
    const float c15 = LOG2E * A->in[17][15 * 8 + h];
    bf16x8 qf[4];
#pragma unroll
    for (int d0 = 0; d0 < 4; ++d0) qf[d0] = *(const bf16x8*)(Qb + (size_t)grow * 1024 + h * 128 + s * 64 + d0 * 16 + hi * 8);
    const int kr = tid >> 3, kc = tid & 7, vr = tid >> 4, vc = tid & 15;
    struct TileRegs { v4u k, v0, v1; };
    TileRegs RA, RB;
    auto load_tile = [&](int t, TileRegs& R) __attribute__((always_inline)) {
        if (!SAMPLE) {
            R.k = *(const v4u*)(Kb + (size_t)(64 * t + kr) * 1024 + h * 128 + s * 64 + kc * 8);
            R.v0 = *(const v4u*)(Vb + (size_t)(64 * t + vr) * 1024 + h * 128 + vc * 8);
            R.v1 = *(const v4u*)(Vb + (size_t)(64 * t + vr + 32) * 1024 + h * 128 + vc * 8);
        } else if (t < 16) {
            { const float* p = ck + (size_t)(64 * t + kr) * 1024 + h * 128 + s * 64 + kc * 8; const f32x4 a = *(const f32x4*)p, b = *(const f32x4*)(p + 4);
              R.k.x = pk2(a.x, a.y); R.k.y = pk2(a.z, a.w); R.k.z = pk2(b.x, b.y); R.k.w = pk2(b.z, b.w); }
            { const float* p = cv + (size_t)(64 * t + vr) * 1024 + h * 128 + vc * 8; const f32x4 a = *(const f32x4*)p, b = *(const f32x4*)(p + 4);
              R.v0.x = pk2(a.x, a.y); R.v0.y = pk2(a.z, a.w); R.v0.z = pk2(b.x, b.y); R.v0.w = pk2(b.z, b.w); }
            { const float* p = cv + (size_t)(64 * t + vr + 32) * 1024 + h * 128 + vc * 8; const f32x4 a = *(const f32x4*)p, b = *(const f32x4*)(p + 4);
              R.v1.x = pk2(a.x, a.y); R.v1.y = pk2(a.z, a.w); R.v1.z = pk2(b.x, b.y); R.v1.w = pk2(b.z, b.w); }
        } else {
            const v4u z = {0u, 0u, 0u, 0u};
            R.k = kr < 16 ? *(const v4u*)(Kb + (size_t)(SEQ + 16 * qi + kr) * 1024 + h * 128 + s * 64 + kc * 8) : z;
            R.v0 = vr < 16 ? *(const v4u*)(Vb + (size_t)(SEQ + 16 * qi + vr) * 1024 + h * 128 + vc * 8) : z;
            R.v1 = z;
        }
    };
    auto store_tile = [&](int boff, const TileRegs& R) __attribute__((always_inline)) {
        LAS unsigned char* Kt = lds + boff; LAS unsigned char* Vt = Kt + KT;
        *(LAS v4u*)(Kt + kr * KP + kc * 16) = R.k;
        *(LAS v4u*)(Vt + vr * VP + vc * 16) = R.v0;
        *(LAS v4u*)(Vt + (vr + 32) * VP + vc * 16) = R.v1;
    };
    constexpr float THR = 8.0f;
    float m = 0.f, l = 0.f, alpha = 1.f; bool resc = false, first = true;
    bf16x8 pb[4];
    f32x16 o[4];
#pragma unroll
    for (int c = 0; c < 4; ++c)
#pragma unroll
        for (int r = 0; r < 16; ++r) o[c][r] = 0.f;
    f32x16 pA0, pA1, pB0, pB1;
    bf16x8 ka[4]; int kboff = 0;
    auto KRD = [&](int boff) __attribute__((always_inline)) {
        const LAS unsigned char* Kt = lds + boff; kboff = boff;
#pragma unroll
        for (int d0 = 0; d0 < 4; ++d0) ka[d0] = *(const LAS bf16x8*)(SAMPLE ? Kt + r32 * KP + d0 * 32 + hi * 16 : Kt + d0 * 2048 + hi * 1024 + r32 * 16);
        __builtin_amdgcn_sched_barrier(0);
    };
    auto QKM = [&](f32x16& d0_, f32x16& d1_, bool nearb) __attribute__((always_inline)) {
        const LAS unsigned char* Kt = lds + kboff;
        bf16x8 kb[4];
#pragma unroll
        for (int d0 = 0; d0 < 4; ++d0) kb[d0] = *(const LAS bf16x8*)(SAMPLE ? Kt + (32 + r32) * KP + d0 * 32 + hi * 16 : Kt + d0 * 2048 + hi * 1024 + 512 + r32 * 16);
        const float ci = (nearb ? 0.f : c15) - m;
#pragma unroll
        for (int r = 0; r < 16; ++r) { d0_[r] = ci; d1_[r] = ci; }
        __builtin_amdgcn_sched_barrier(0);
#pragma unroll
        for (int d0 = 0; d0 < 4; ++d0) d0_ = __builtin_amdgcn_mfma_f32_32x32x16_bf16(ka[d0], qf[d0], d0_, 0, 0, 0);
        __builtin_amdgcn_sched_barrier(0);
#pragma unroll
        for (int d0 = 0; d0 < 4; ++d0) d1_ = __builtin_amdgcn_mfma_f32_32x32x16_bf16(kb[d0], qf[d0], d1_, 0, 0, 0);
        __builtin_amdgcn_sched_barrier(0);
    };
    auto SMA = [&](f32x16& p0, f32x16& p1, int t, bool nearb) __attribute__((always_inline)) {
        if (nearb) {
            const LAS float* lp = lut + (64 * t - qpos + LUT_Z + 4 * hi);
#pragma unroll
            for (int r = 0; r < 16; ++r) { p0[r] += lp[(r & 3) + 8 * (r >> 2)]; p1[r] += lp[32 + (r & 3) + 8 * (r >> 2)]; }
            if (SAMPLE && t == 16) {
#pragma unroll
                for (int r = 0; r < 16; ++r) { if (r >= 8) p0[r] = NEG; p1[r] = NEG; }
            }
        }
        float mx = max3f(p0[0], p0[1], p1[0]), mx2 = max3f(p0[2], p0[3], p1[1]);
#pragma unroll
        for (int r = 2; r < 8; ++r) { mx = max3f(mx, p0[2 * r], p0[2 * r + 1]); mx2 = max3f(mx2, p1[2 * r], p1[2 * r + 1]); }
        mx = max3f(mx, p1[2], p1[3]); mx = fmaxf(mx, mx2);
        mx = pg8::max_x32(mx);
        const bool upd = first || (mx > THR);
        const float delta = upd ? mx : 0.f;
        m += delta; alpha = (upd && !first) ? __builtin_amdgcn_exp2f(-delta) : 1.f;
        first = false;
        resc = __any(upd);
        if (resc) {
#pragma unroll
            for (int r = 0; r < 16; ++r) { p0[r] -= delta; p1[r] -= delta; }
        }
        __builtin_amdgcn_sched_barrier(0);
    };
    auto SMB = [&](f32x16& p0, f32x16& p1) __attribute__((always_inline)) {
        float rsum = 0.f;
#pragma unroll
        for (int r = 0; r < 16; ++r) { p0[r] = __builtin_amdgcn_exp2f(p0[r]); p1[r] = __builtin_amdgcn_exp2f(p1[r]); rsum += p0[r] + p1[r]; }
        rsum = pg8::sum_x32(rsum);
        l = l * alpha + rsum;
        v4u w0, w1, w2, w3;
        w0.x = pk2(p0[0], p0[1]); w0.y = pk2(p0[2], p0[3]); w0.z = pk2(p0[4], p0[5]); w0.w = pk2(p0[6], p0[7]);
        w1.x = pk2(p0[8], p0[9]); w1.y = pk2(p0[10], p0[11]); w1.z = pk2(p0[12], p0[13]); w1.w = pk2(p0[14], p0[15]);
        w2.x = pk2(p1[0], p1[1]); w2.y = pk2(p1[2], p1[3]); w2.z = pk2(p1[4], p1[5]); w2.w = pk2(p1[6], p1[7]);
        w3.x = pk2(p1[8], p1[9]); w3.y = pk2(p1[10], p1[11]); w3.z = pk2(p1[12], p1[13]); w3.w = pk2(p1[14], p1[15]);
        pb[0] = __builtin_bit_cast(bf16x8, w0); pb[1] = __builtin_bit_cast(bf16x8, w1); pb[2] = __builtin_bit_cast(bf16x8, w2); pb[3] = __builtin_bit_cast(bf16x8, w3);
    };
    auto PV = [&](int boff) __attribute__((always_inline)) {
        const LAS unsigned char* Vt = lds + boff + (SAMPLE ? KT : PKT);
        if (resc) {
#pragma unroll
            for (int c = 0; c < 4; ++c)
#pragma unroll
                for (int r = 0; r < 16; ++r) o[c][r] *= alpha;
        }
        const LAS unsigned char* vb = Vt + (4 * hi + ((lane & 15) >> 2)) * (SAMPLE ? VP : 64) + ((lane >> 4) & 1) * 32 + (lane & 3) * 8;
        bf16x8 vfa[4], vfb[4];
#define ATT_RDV(dst, s4) do { _Pragma("unroll") for (int c = 0; c < 4; ++c) { const v4i16_t lo = vtr(SAMPLE ? vb + (16 * (s4)) * VP + 64 * c : vb + (s4) * 1024 + c * 4096), hh = vtr(SAMPLE ? vb + (16 * (s4) + 8) * VP + 64 * c : vb + (s4) * 1024 + 512 + c * 4096); \
            dst[c] = (bf16x8){lo[0], lo[1], lo[2], lo[3], hh[0], hh[1], hh[2], hh[3]}; } } while (0)
#define ATT_PV(src, s4) do { _Pragma("unroll") for (int c = 0; c < 4; ++c) o[c] = __builtin_amdgcn_mfma_f32_32x32x16_bf16(src[c], pb[s4], o[c], 0, 0, 0); } while (0)
        ATT_RDV(vfa, 0); ATT_RDV(vfb, 1); __builtin_amdgcn_sched_barrier(0);
        ATT_PV(vfa, 0); __builtin_amdgcn_sched_barrier(0);
        ATT_RDV(vfa, 2); __builtin_amdgcn_sched_barrier(0);
        ATT_PV(vfb, 1); __builtin_amdgcn_sched_barrier(0);
        ATT_RDV(vfb, 3); __builtin_amdgcn_sched_barrier(0);
        ATT_PV(vfa, 2); __builtin_amdgcn_sched_barrier(0);
        ATT_PV(vfb, 3); __builtin_amdgcn_sched_barrier(0);
#undef ATT_RDV
#undef ATT_PV
    };
    if (!SAMPLE) {
        const bf16* psrc[3]; int pdst[3];
        psrc[0] = Kb + (size_t)lane * 1024 + h * 128 + s * 64 + w * 8; pdst[0] = w * 1024;
#pragma unroll
        for (int i = 1; i < 3; ++i) { const int p = w + 8 * (i - 1);
            psrc[i] = Vb + (size_t)(16 * (p & 3) + (lane >> 2)) * 1024 + h * 128 + (p >> 2) * 32 + (lane & 3) * 8; pdst[i] = PKT + p * 1024; }
        const unsigned lds0 = (unsigned)(uintptr_t)lds;
        auto dma_tile = [&](int t, int boff) __attribute__((always_inline)) {
#pragma unroll
            for (int i = 0; i < 3; ++i) { unsigned keep; const bf16* g = psrc[i] + (size_t)t * 65536; const unsigned d = (unsigned)__builtin_amdgcn_readfirstlane((int)(lds0 + (unsigned)(boff + pdst[i])));
                asm volatile("s_mov_b32 %0, m0\n\ts_mov_b32 m0, %2\n\ts_nop 0\n\tglobal_load_lds_dwordx4 %1, off\n\ts_mov_b32 m0, %0" : "=&s"(keep) : "v"(g), "s"(d) : "memory"); }
        };
        dma_tile(0, 0); dma_tile(1, PBUF); dma_tile(2, 2 * PBUF);
        asm volatile("s_waitcnt vmcnt(3)" ::: "memory");
        ATT_BAR();
        int bcur = 0, bnx = PBUF, bdma = 3 * PBUF;
#define ATT_DMA(t) do { if ((t) + 3 < NT) dma_tile((t) + 3, bdma); } while (0)
#define ATT_END(t) do { if ((t) + 3 < NT) asm volatile("s_waitcnt vmcnt(3)" ::: "memory"); else asm volatile("s_waitcnt vmcnt(0)" ::: "memory"); \
        ATT_BAR(); bcur = bnx; bnx = bnx == 3 * PBUF ? 0 : bnx + PBUF; bdma = bdma == 3 * PBUF ? 0 : bdma + PBUF; } while (0)
        auto NEARADD = [&](f32x16& p0, f32x16& p1, int t) __attribute__((always_inline)) {
            const LAS float* lp = lut + (64 * t - qpos + LUT_Z + 4 * hi);
#pragma unroll
            for (int r = 0; r < 16; ++r) { p0[r] += lp[(r & 3) + 8 * (r >> 2)]; p1[r] += lp[32 + (r & 3) + 8 * (r >> 2)]; }
            __builtin_amdgcn_sched_barrier(0);
        };
        auto ROWMAX = [&](const f32x16& p0, const f32x16& p1) __attribute__((always_inline)) -> float {
            float mx = max3f(p0[0], p0[1], p1[0]), mx2 = max3f(p0[2], p0[3], p1[1]);
#pragma unroll
            for (int r = 2; r < 8; ++r) { mx = max3f(mx, p0[2 * r], p0[2 * r + 1]); mx2 = max3f(mx2, p1[2 * r], p1[2 * r + 1]); }
            mx = max3f(mx, p1[2], p1[3]); return fmaxf(mx, mx2);
        };
        auto REFUPD = [&](f32x16& p0, f32x16& p1, float mx) __attribute__((always_inline)) {
            mx = pg8::max_x32(mx);
            const bool upd = first || (mx > THR);
            const float delta = upd ? mx : 0.f;
            m += delta; alpha = (upd && !first) ? __builtin_amdgcn_exp2f(-delta) : 1.f;
            first = false;
            if (__any(upd)) {
#pragma unroll
                for (int r = 0; r < 16; ++r) { p0[r] -= delta; p1[r] -= delta; }
#pragma unroll
                for (int c = 0; c < 4; ++c)
#pragma unroll
                    for (int r = 0; r < 16; ++r) o[c][r] *= alpha;
            }
            __builtin_amdgcn_sched_barrier(0);
        };
        auto B1 = [&](f32x16& n0, f32x16& n1, bool nearn, f32x16& c0, f32x16& c1) __attribute__((always_inline)) {
            const LAS unsigned char* Kt = lds + kboff;
            bf16x8 kb[4];
#pragma unroll
            for (int d0 = 0; d0 < 4; ++d0) kb[d0] = *(const LAS bf16x8*)(SAMPLE ? Kt + (32 + r32) * KP + d0 * 32 + hi * 16 : Kt + d0 * 2048 + hi * 1024 + 512 + r32 * 16);
            const float ci = (nearn ? 0.f : c15) - m;
#pragma unroll
            for (int r = 0; r < 16; ++r) { n0[r] = ci; n1[r] = ci; }
            __builtin_amdgcn_sched_barrier(0);
            float rs0 = 0.f, rs1 = 0.f; unsigned wq[16];
#define ATT_CH(i, MF) do { MF; \
            c0[2 * (i)] = __builtin_amdgcn_exp2f(c0[2 * (i)]); c0[2 * (i) + 1] = __builtin_amdgcn_exp2f(c0[2 * (i) + 1]); c1[2 * (i)] = __builtin_amdgcn_exp2f(c1[2 * (i)]); c1[2 * (i) + 1] = __builtin_amdgcn_exp2f(c1[2 * (i) + 1]); \
            rs0 += c0[2 * (i)] + c0[2 * (i) + 1]; rs1 += c1[2 * (i)] + c1[2 * (i) + 1]; \
            wq[(i)] = pk2(c0[2 * (i)], c0[2 * (i) + 1]); wq[8 + (i)] = pk2(c1[2 * (i)], c1[2 * (i) + 1]); \
            __builtin_amdgcn_sched_barrier(0); } while (0)
            ATT_CH(0, n0 = __builtin_amdgcn_mfma_f32_32x32x16_bf16(ka[0], qf[0], n0, 0, 0, 0));
            ATT_CH(1, n0 = __builtin_amdgcn_mfma_f32_32x32x16_bf16(ka[1], qf[1], n0, 0, 0, 0));
            ATT_CH(2, n0 = __builtin_amdgcn_mfma_f32_32x32x16_bf16(ka[2], qf[2], n0, 0, 0, 0));
            ATT_CH(3, n0 = __builtin_amdgcn_mfma_f32_32x32x16_bf16(ka[3], qf[3], n0, 0, 0, 0));
            ATT_CH(4, n1 = __builtin_amdgcn_mfma_f32_32x32x16_bf16(kb[0], qf[0], n1, 0, 0, 0));
            ATT_CH(5, n1 = __builtin_amdgcn_mfma_f32_32x32x16_bf16(kb[1], qf[1], n1, 0, 0, 0));
            ATT_CH(6, n1 = __builtin_amdgcn_mfma_f32_32x32x16_bf16(kb[2], qf[2], n1, 0, 0, 0));
            ATT_CH(7, n1 = __builtin_amdgcn_mfma_f32_32x32x16_bf16(kb[3], qf[3], n1, 0, 0, 0));
#undef ATT_CH
            const float rsum = pg8::sum_x32(rs0 + rs1);
            l = l * alpha + rsum;
            { const v4u w0 = {wq[0], wq[1], wq[2], wq[3]}, w1 = {wq[4], wq[5], wq[6], wq[7]}, w2 = {wq[8], wq[9], wq[10], wq[11]}, w3 = {wq[12], wq[13], wq[14], wq[15]};
              pb[0] = __builtin_bit_cast(bf16x8, w0); pb[1] = __builtin_bit_cast(bf16x8, w1); pb[2] = __builtin_bit_cast(bf16x8, w2); pb[3] = __builtin_bit_cast(bf16x8, w3); }
            __builtin_amdgcn_sched_barrier(0);
        };
        auto B2 = [&](int boff, const f32x16& n0, const f32x16& n1) __attribute__((always_inline)) -> float {
            const LAS unsigned char* vb = lds + boff + PKT + (4 * hi + ((lane & 15) >> 2)) * 64 + ((lane >> 4) & 1) * 32 + (lane & 3) * 8;
            bf16x8 vfa[4], vfb[4];
#define ATT_RDV(dst, s4) do { _Pragma("unroll") for (int c = 0; c < 4; ++c) { const v4i16_t lo = vtr(vb + (s4) * 1024 + c * 4096), hh = vtr(vb + (s4) * 1024 + 512 + c * 4096); \
            dst[c] = (bf16x8){lo[0], lo[1], lo[2], lo[3], hh[0], hh[1], hh[2], hh[3]}; } } while (0)
#define ATT_PV(src, s4) do { _Pragma("unroll") for (int c = 0; c < 4; ++c) o[c] = __builtin_amdgcn_mfma_f32_32x32x16_bf16(src[c], pb[s4], o[c], 0, 0, 0); } while (0)
            ATT_RDV(vfa, 0); ATT_RDV(vfb, 1);
            ATT_PV(vfa, 0); ATT_RDV(vfa, 2); ATT_PV(vfb, 1); ATT_RDV(vfb, 3); ATT_PV(vfa, 2); ATT_PV(vfb, 3);
            const float mx = ROWMAX(n0, n1);
            __builtin_amdgcn_sched_group_barrier(0x100, 16, 0);
#pragma unroll
            for (int i = 0; i < 8; ++i) { __builtin_amdgcn_sched_group_barrier(0x008, 1, 0); __builtin_amdgcn_sched_group_barrier(0x100, 2, 0); __builtin_amdgcn_sched_group_barrier(0x002, 2, 0); }
#pragma unroll
            for (int i = 0; i < 8; ++i) { __builtin_amdgcn_sched_group_barrier(0x008, 1, 0); __builtin_amdgcn_sched_group_barrier(0x002, 2, 0); }
            __builtin_amdgcn_sched_barrier(0);
#undef ATT_RDV
#undef ATT_PV
            return mx;
        };
#define ATT_STEP(t, C0, C1, N0, N1) do { ATT_DMA(t); KRD(bnx); \
        B1(N0, N1, (t) + 1 >= tfar, C0, C1); \
        if ((t) + 1 >= tfar) NEARADD(N0, N1, (t) + 1); \
        { const float mx_ = B2(bcur, N0, N1); REFUPD(N0, N1, mx_); } \
        ATT_END(t); } while (0)
        KRD(0); QKM(pA0, pA1, tfar == 0);
        if (0 >= tfar) NEARADD(pA0, pA1, 0);
        { const float mx_ = ROWMAX(pA0, pA1); REFUPD(pA0, pA1, mx_); }
        int t = 0;
        for (; t + 1 < tmax; t += 2) { ATT_STEP(t, pA0, pA1, pB0, pB1); ATT_STEP(t + 1, pB0, pB1, pA0, pA1); }
        if (t < tmax) { ATT_STEP(t, pA0, pA1, pB0, pB1); ATT_DMA(tmax); SMB(pB0, pB1); PV(bcur); ATT_END(tmax); }
        else { ATT_DMA(tmax); SMB(pA0, pA1); PV(bcur); ATT_END(tmax); }
        for (int ti = tmax + 1; ti < NT; ++ti) { asm volatile("s_waitcnt vmcnt(0)" ::: "memory"); ATT_BAR(); }
#undef ATT_STEP
#undef ATT_DMA
#undef ATT_END
    } else if (w == 0) {
        ATT_BAR();
        int bcur = 0, bnx = BUFB, bst = 2 * BUFB;
        KRD(0); QKM(pA0, pA1, false);
#define ATT_SIT(t, C0, C1, N0, N1) do { const bool on_ = (t) < 17, onn_ = (t) + 1 < 17; \
        if (onn_) KRD(bnx); \
        if (on_) SMA(C0, C1, (t), (t) >= tfar); \
        if (onn_) QKM(N0, N1, (t) + 1 >= tfar); \
        if (on_) { SMB(C0, C1); PV(bcur); } \
        ATT_BAR(); { const int x_ = bcur; bcur = bnx; bnx = bst; bst = x_; } } while (0)
        for (int t = 0; t < 18; t += 2) { ATT_SIT(t, pA0, pA1, pB0, pB1); ATT_SIT(t + 1, pB0, pB1, pA0, pA1); }
#undef ATT_SIT
    } else {
        const int lt = tid - 64;
        struct Chunk { f32x4 a, b; };
        Chunk S0[4], S1[4], S2[4];
        auto ldt = [&](int t, Chunk (&S)[4]) __attribute__((always_inline)) {
#pragma unroll
            for (int i = 0; i < 4; ++i) { const int c = lt + 448 * i;
                if (c < 1536) {
                    const bool isk = c < 512; const int cc = isk ? c : c - 512, row = isk ? cc >> 3 : cc >> 4, col = isk ? s * 64 + (cc & 7) * 8 : (cc & 15) * 8;
                    if (t < 16) { const float* p = (isk ? ck : cv) + (size_t)(64 * t + row) * 1024 + h * 128 + col; S[i].a = *(const f32x4*)p; S[i].b = *(const f32x4*)(p + 4); }
                    else {
                        const v4u z = {0u, 0u, 0u, 0u};
                        const v4u r = row < 16 ? *(const v4u*)((isk ? Kb : Vb) + (size_t)(SEQ + 16 * qi + row) * 1024 + h * 128 + col) : z;
                        S[i].a = (f32x4){bf_lo(r.x), bf_hi(r.x), bf_lo(r.y), bf_hi(r.y)}; S[i].b = (f32x4){bf_lo(r.z), bf_hi(r.z), bf_lo(r.w), bf_hi(r.w)}; }
                } }
        };
        auto stt = [&](int boff, const Chunk (&S)[4]) __attribute__((always_inline)) {
#pragma unroll
            for (int i = 0; i < 4; ++i) { const int c = lt + 448 * i;
                if (c < 1536) {
                    const bool isk = c < 512; const int cc = isk ? c : c - 512;
                    v4u wv; wv.x = pk2(S[i].a.x, S[i].a.y); wv.y = pk2(S[i].a.z, S[i].a.w); wv.z = pk2(S[i].b.x, S[i].b.y); wv.w = pk2(S[i].b.z, S[i].b.w);
                    LAS unsigned char* dst = isk ? lds + boff + (cc >> 3) * KP + (cc & 7) * 16 : lds + boff + KT + (cc >> 4) * VP + (cc & 15) * 16;
                    *(LAS v4u*)dst = wv; } }
        };
        ldt(0, S0); ldt(1, S1); ldt(2, S2);
        stt(0, S0); ldt(3, S0);
        stt(BUFB, S1); ldt(4, S1);
        ATT_BAR();
        int bst = 2 * BUFB;
#define ATT_LIT(t, S) do { if ((t) + 2 < 17) { stt(bst, S); if ((t) + 5 < 17) ldt((t) + 5, S); } ATT_BAR(); bst = bst == 2 * BUFB ? 0 : bst + BUFB; } while (0)
        for (int t = 0; t < 18; t += 3) { ATT_LIT(t, S2); ATT_LIT(t + 1, S0); ATT_LIT(t + 2, S1); }
#undef ATT_LIT
    }
    if (tmax >= 0) {
        const float inv = 1.0f / l;
        LAS float* ot = (LAS float*)(lds + w * 8704);
        const int rowbase = SAMPLE ? SEQ + 16 * qi : 256 * qi + 32 * w;
#pragma unroll
        for (int half = 0; half < 2; ++half) {
#pragma unroll
            for (int cc = 0; cc < 2; ++cc)
#pragma unroll
                for (int r = 0; r < 16; ++r) ot[r32 * 68 + 32 * cc + crow(r, hi)] = o[2 * half + cc][r] * inv;
#pragma unroll
            for (int j = 0; j < 4; ++j) { const int id = lane + 64 * j, row = id >> 3, chn = id & 7;
                const f32x4 va = *(const LAS f32x4*)(ot + row * 68 + chn * 8), vb2 = *(const LAS f32x4*)(ot + row * 68 + chn * 8 + 4);
                v4u wv; wv.x = pk2(va.x, va.y); wv.y = pk2(va.z, va.w); wv.z = pk2(vb2.x, vb2.y); wv.w = pk2(vb2.z, vb2.w);
                if (!SAMPLE || row < 16) *(v4u*)(OS + (size_t)(rowbase + row) * 1024 + h * 128 + half * 64 + chn * 8) = wv; }
        }
    }
    ATT_BAR();
}
#undef ATT_BAR
}

__device__ __forceinline__ void attn_combine(const Frame& F0, int e0) {
    const ArgsP A = args_ptr();
    int e = e0; asm volatile("" : "+s"(e));
    const float lam_init = e == 0 ? 0.2f : 0.47071302f;
    const Frame F = phase_frame(F0);
    const int lane = F.lane, gw = F.vcu * NWAVES + F.wave, NGW = F.G * NWAVES;
    const float* lv = A->in[15] + e * 256;
    const float s1 = wave_sum(lv[lane] * lv[64 + lane]), s2 = wave_sum(lv[128 + lane] * lv[192 + lane]);
    const float lam = __expf(s1) - __expf(s2) + lam_init;
    const bf16* OS0 = (const bf16*)(A->ws + WS_OS); const bf16* OS1 = OS0 + (size_t)MT * 1024; bf16* YC = (bf16*)(A->ws + WS_YC);
    const int hd = lane >> 3, d0 = (lane & 7) * 16;
    f32x4 sw[4];
#pragma unroll
    for (int j = 0; j < 4; ++j) sw[j] = *(const f32x4*)(A->in[16] + e * 128 + d0 + 4 * j);
    for (int row0 = gw; row0 < MT; row0 += 5 * NGW) {
        v4u ra[5][2], rb[5][2];
#pragma unroll
        for (int k = 0; k < 5; ++k) { const int row = row0 + k * NGW;
            if (row < MT) { const size_t off = (size_t)row * 1024 + hd * 128 + d0;
#pragma unroll
                for (int j = 0; j < 2; ++j) { ra[k][j] = *(const GAS v4u*)(OS0 + off + 8 * j); rb[k][j] = *(const GAS v4u*)(OS1 + off + 8 * j); } } }
#pragma unroll
        for (int k = 0; k < 5; ++k) { const int row = row0 + k * NGW;
            if (row < MT) {
                f32x4 d[4]; float q = 0.f;
#pragma unroll
                for (int j = 0; j < 2; ++j) { const v4u xa = ra[k][j], xb = rb[k][j];
                    const f32x4 a0 = {bf_lo(xa.x), bf_hi(xa.x), bf_lo(xa.y), bf_hi(xa.y)}, a1 = {bf_lo(xa.z), bf_hi(xa.z), bf_lo(xa.w), bf_hi(xa.w)};
                    const f32x4 b0 = {bf_lo(xb.x), bf_hi(xb.x), bf_lo(xb.y), bf_hi(xb.y)}, b1 = {bf_lo(xb.z), bf_hi(xb.z), bf_lo(xb.w), bf_hi(xb.w)};
                    d[2 * j] = a0 - lam * b0; d[2 * j + 1] = a1 - lam * b1; }
#pragma unroll
                for (int j = 0; j < 4; ++j) q += (d[j].x * d[j].x + d[j].y * d[j].y) + (d[j].z * d[j].z + d[j].w * d[j].w);
                q += pg8::xorl<1>(q); q += pg8::xorl<2>(q); q += pg8::xorl<4>(q);
                const float sc = __builtin_amdgcn_rsqf(q * (1.0f / 128.0f) + RMS_EPS) * (1.0f - lam_init);
                v4u w0, w1;
                { const f32x4 a = d[0] * sw[0] * sc, b = d[1] * sw[1] * sc; w0.x = pk2(a.x, a.y); w0.y = pk2(a.z, a.w); w0.z = pk2(b.x, b.y); w0.w = pk2(b.z, b.w); }
                { const f32x4 a = d[2] * sw[2] * sc, b = d[3] * sw[3] * sc; w1.x = pk2(a.x, a.y); w1.y = pk2(a.z, a.w); w1.z = pk2(b.x, b.y); w1.w = pk2(b.z, b.w); }
                bf16* yp = YC + (size_t)row * 2048 + 1024 + hd * 128 + d0;
                *(GAS v4u*)yp = w0; *(GAS v4u*)(yp + 8) = w1; } }
    }
}

__device__ __forceinline__ void gmlp_phase(const Frame& F0, int o) {
    const ArgsP A = args_ptr();
    const Frame F = phase_frame(F0);
    constexpr int VP = 320, VBUF = 128 * VP;
    constexpr int MP = 272, MOFF = 2 * VBUF;
    const int tid = F.tid, lane = F.lane, w = F.wave, r32 = lane & 31, hi = lane >> 5;
    unsigned char* ws = A->ws;
    const bf16* U = (const bf16*)(ws + WS_U); const bf16* VR = (const bf16*)(ws + WS_VR); bf16* YC = (bf16*)(ws + WS_YC);
    const bf16* wsb = (const bf16*)(ws + WS_WSB);
    const pg8::ssq_t* ssqv = (const pg8::ssq_t*)((const float*)(ws + WS_CTL) + CW_SSQ) + (9 + o) * MT;
    const float* vnw = A->in[20] + o * 2048; const float* bs = A->in[22] + o * 16 * 128;
    const int tb = w & 3, chh = w >> 2, ch = tid & 15;
    LAS unsigned char* Mt = F.lds + MOFF;
    bf16x8 af[8]; float bsv[16]; f32x4 n0, n1; int gcur = -1;
    v4u rawA[4], urawA[4], rawB[4], urawB[4]; pg8::ssq_t rqA[4], rqB[4];
    auto prefetch = [&](int u, v4u (&raw)[4], v4u (&uraw)[4], pg8::ssq_t (&rq)[4]) __attribute__((always_inline)) {
        const bool smp = u >= 1024; const int g = u & 15;
        const int R0 = smp ? SEQ + 16 * ((u - 1024) >> 4) : 128 * (u >> 4), nrows = smp ? 16 : 128;
#pragma unroll
        for (int i = 0; i < 4; ++i) { const int row = (tid + 512 * i) >> 4;
            if (row < nrows) { const size_t grow = (size_t)(R0 + row); raw[i] = *(const GAS v4u*)(VR + grow * 2048 + 128 * g + ch * 8); uraw[i] = *(const GAS v4u*)(U + grow * 2048 + 128 * g + ch * 8); rq[i] = *(const GAS pg8::ssq_t*)(ssqv + grow); } }
    };
    auto unit = [&](int u, int k, v4u (&raw)[4], v4u (&uraw)[4], pg8::ssq_t (&rq)[4]) __attribute__((always_inline)) {
        const bool smp = u >= 1024; const int g = u & 15;
        const int R0 = smp ? SEQ + 16 * ((u - 1024) >> 4) : 128 * (u >> 4), nrows = smp ? 16 : 128;
        LAS unsigned char* Vt = F.lds + (k & 1) * VBUF;
        if (g != gcur) {
            gcur = g;
            const bf16* arow = wsb + ((size_t)(o * 16 + g) * 128 + 32 * tb + r32) * 128 + 8 * hi;
#pragma unroll
            for (int ks = 0; ks < 8; ++ks) af[ks] = *(const bf16x8*)(arow + 16 * ks);
#pragma unroll
            for (int r = 0; r < 16; ++r) bsv[r] = bs[g * 128 + 32 * tb + att::crow(r, hi)];
            n0 = *(const f32x4*)(vnw + 128 * g + ch * 8); n1 = *(const f32x4*)(vnw + 128 * g + ch * 8 + 4);
        }
#pragma unroll
        for (int i = 0; i < 4; ++i) { const int row = (tid + 512 * i) >> 4; v4u wv = {0u, 0u, 0u, 0u};
            if (row < nrows) { const size_t grow = (size_t)(R0 + row); const float rs = pg8::ssq_rstd(rq[i]);
                f32x4 a = {bf_lo(raw[i].x), bf_hi(raw[i].x), bf_lo(raw[i].y), bf_hi(raw[i].y)}, b = {bf_lo(raw[i].z), bf_hi(raw[i].z), bf_lo(raw[i].w), bf_hi(raw[i].w)};
                a = a * rs * n0; b = b * rs * n1;
                if (smp) { float* gv = A->out + O_SGV + ((size_t)o * NSMP + (grow - SEQ)) * 2048 + 128 * g + ch * 8; *(f32x4*)gv = a; *(f32x4*)(gv + 4) = b; }
                wv.x = pk2(a.x, a.y); wv.y = pk2(a.z, a.w); wv.z = pk2(b.x, b.y); wv.w = pk2(b.z, b.w); }
            *(LAS v4u*)(Vt + row * VP + ch * 16) = wv; }
        __syncthreads();
        if (!smp || tb == 0) {
            const LAS unsigned char* vb = Vt + (8 * hi + ((lane & 15) >> 2)) * VP + ((lane >> 4) & 1) * 32 + (lane & 3) * 8;
#pragma unroll
            for (int nn = 0; nn < 2; ++nn) { const int cb = chh * 2 + nn;
                bf16x8 bfr[8];
#pragma unroll
                for (int ks = 0; ks < 8; ++ks) { const att::v4i16_t lo = att::vtr(vb + (16 * ks) * VP + 64 * cb), hh = att::vtr(vb + (16 * ks + 4) * VP + 64 * cb);
                    bfr[ks] = (bf16x8){lo[0], lo[1], lo[2], lo[3], hh[0], hh[1], hh[2], hh[3]}; }
                f32x16 acc;
#pragma unroll
                for (int r = 0; r < 16; ++r) acc[r] = 0.f;
#pragma unroll
                for (int ks = 0; ks < 8; ++ks) acc = __builtin_amdgcn_mfma_f32_32x32x16_bf16(af[ks], bfr[ks], acc, 0, 0, 0);
#pragma unroll
                for (int r = 0; r < 16; ++r) { const int t = 32 * tb + att::crow(r, hi);
                    *(LAS unsigned short*)(Mt + t * MP + (32 * cb + r32) * 2) = (unsigned short)f2bf(acc[r] + bsv[r]); }
            }
        }
        __syncthreads();
#pragma unroll
        for (int i = 0; i < 4; ++i) { const int row = (tid + 512 * i) >> 4;
            if (row < nrows) { const size_t grow = (size_t)(R0 + row); const v4u mx = *(const LAS v4u*)(Mt + row * MP + ch * 16);
                v4u wv;
                wv.x = pk2(bf_lo(uraw[i].x) * bf_lo(mx.x), bf_hi(uraw[i].x) * bf_hi(mx.x)); wv.y = pk2(bf_lo(uraw[i].y) * bf_lo(mx.y), bf_hi(uraw[i].y) * bf_hi(mx.y));
                wv.z = pk2(bf_lo(uraw[i].z) * bf_lo(mx.z), bf_hi(uraw[i].z) * bf_hi(mx.z)); wv.w = pk2(bf_lo(uraw[i].w) * bf_lo(mx.w), bf_hi(uraw[i].w) * bf_hi(mx.w));
                *(v4u*)(YC + grow * 2048 + 128 * g + ch * 8) = wv; } }
            if (u + 2 * F.G < 1280) prefetch(u + 2 * F.G, raw, uraw, rq);
    };
    if (F.vcu < 1280) prefetch(F.vcu, rawA, urawA, rqA);
    if (F.vcu + F.G < 1280) prefetch(F.vcu + F.G, rawB, urawB, rqB);
    for (int u = F.vcu, k = 0; u < 1280; u += 2 * F.G, k += 2) {
        unit(u, k, rawA, urawA, rqA);
        if (u + F.G < 1280) unit(u + F.G, k + 1, rawB, urawB, rqB);
    }
    __syncthreads();
}

__device__ __forceinline__ void final_norm(const Frame& F0) {
    const ArgsP A = args_ptr();
    const Frame F = phase_frame(F0);
    const int gw = F.vcu * NWAVES + F.wave, NGW = F.G * NWAVES;
    const bf16* Xb = (const bf16*)(A->ws + WS_XB); const pg8::ssq_t* ssq = (const pg8::ssq_t*)((const float*)(A->ws + WS_CTL) + CW_SSQ) + 8 * MT;
    f32x4 wv[8];
#pragma unroll
    for (int j = 0; j < 4; ++j) { wv[2 * j] = ((const f32x4*)A->in[25])[2 * (F.lane + 64 * j)]; wv[2 * j + 1] = ((const f32x4*)A->in[25])[2 * (F.lane + 64 * j) + 1]; }
    for (int m = gw; m < SEQ; m += NGW) {
        const float rs = pg8::ssq_rstd(ssq[m]);
        float* dst = A->out + O_YP + (size_t)m * DM;
        v4u rr[4];
#pragma unroll
        for (int j = 0; j < 4; ++j) rr[j] = ((const GAS v4u*)(Xb + (size_t)m * DM))[F.lane + 64 * j];
#pragma unroll
        for (int j = 0; j < 4; ++j) { const v4u r = rr[j];
            const f32x4 a = {bf_lo(r.x), bf_hi(r.x), bf_lo(r.y), bf_hi(r.y)}, b = {bf_lo(r.z), bf_hi(r.z), bf_lo(r.w), bf_hi(r.w)};
            ((f32x4*)dst)[2 * (F.lane + 64 * j)] = a * rs * wv[2 * j]; ((f32x4*)dst)[2 * (F.lane + 64 * j) + 1] = b * rs * wv[2 * j + 1]; }
    }
}

__device__ __forceinline__ void resid_finalize(const Frame& F0, int nsplit, int ssq_idx) {
    const ArgsP A = args_ptr();
    const Frame F = phase_frame(F0);
    unsigned char* ws = A->ws;
    const float* slab = (const float*)(ws + WS_SLAB); bf16* Xb = (bf16*)(ws + WS_XB); pg8::ssq_t* ssq = (pg8::ssq_t*)((float*)(ws + WS_CTL) + CW_SSQ) + (size_t)ssq_idx * MT;
    LAS float* red = (LAS float*)F.lds;
    for (int r = F.vcu; r < NSMP; r += F.G) {
        const size_t grow = (size_t)(SEQ + r); const int c = F.tid * 4;
        const unsigned long long xr = *(const unsigned long long*)(Xb + grow * DM + c);
        f32x4 v = {bf_lo((unsigned)xr), bf_hi((unsigned)xr), bf_lo((unsigned)(xr >> 32)), bf_hi((unsigned)(xr >> 32))};
        for (int ks = 0; ks < nsplit; ks += 8) {
            f32x4 t[8];
#pragma unroll
            for (int j = 0; j < 8; ++j) t[j] = *(const GAS f32x4*)(slab + ((size_t)((ks + j) * 256 + r)) * DM + c);
#pragma unroll
            for (int j = 0; j < 8; ++j) v += t[j];
        }
        *(unsigned long long*)(Xb + grow * DM + c) = (unsigned long long)pk2(v.x, v.y) | ((unsigned long long)pk2(v.z, v.w) << 32);
        const float q = wave_sum((v.x * v.x + v.y * v.y) + (v.z * v.z + v.w * v.w));
        if (F.lane == 0) red[F.wave] = q;
        __syncthreads();
        if (F.tid == 0) { float t = 0.f;
#pragma unroll
            for (int i = 0; i < NWAVES; ++i) t += red[i];
            ssq[grow] = pg8::ssq_fx(t); }
        __syncthreads();
    }
}

__device__ __forceinline__ void final_sample(const Frame& F0) {
    const ArgsP A = args_ptr();
    const Frame F = phase_frame(F0);
    unsigned char* ws = A->ws;
    const float* slab = (const float*)(ws + WS_SLAB); const bf16* Xb = (const bf16*)(ws + WS_XB);
    LAS float* red = (LAS float*)F.lds;
    for (int r = F.vcu; r < NSMP; r += F.G) {
        const size_t grow = (size_t)(SEQ + r); const int c = F.tid * 4;
        const unsigned long long xr = *(const GAS unsigned long long*)(Xb + grow * DM + c);
        const f32x4 wv = *(const GAS f32x4*)(A->in[25] + c);
        f32x4 v = {bf_lo((unsigned)xr), bf_hi((unsigned)xr), bf_lo((unsigned)(xr >> 32)), bf_hi((unsigned)(xr >> 32))};
        for (int ks = 0; ks < 32; ks += 8) {
            f32x4 t[8];
#pragma unroll
            for (int j = 0; j < 8; ++j) t[j] = *(const GAS f32x4*)(slab + ((size_t)((ks + j) * 256 + r)) * DM + c);
#pragma unroll
            for (int j = 0; j < 8; ++j) v += t[j];
        }
        const float q = wave_sum((v.x * v.x + v.y * v.y) + (v.z * v.z + v.w * v.w));
        if (F.lane == 0) red[F.wave] = q;
        __syncthreads();
        float t = 0.f;
#pragma unroll
        for (int i = 0; i < NWAVES; ++i) t += red[i];
        const float rs = pg8::ssq_rstd(pg8::ssq_fx(t));
        const unsigned p0 = pk2(v.x, v.y), p1 = pk2(v.z, v.w);
        const f32x4 xb = {bf_lo(p0), bf_hi(p0), bf_lo(p1), bf_hi(p1)};
        *(GAS f32x4*)(A->out + O_YS + (size_t)r * DM + c) = xb * rs * wv;
        __syncthreads();
    }
}

__device__ __forceinline__ void resid_finalize_pub(const Frame& F0, int nsplit, int ssq_idx, int first, int stride) {
    const ArgsP A = args_ptr();
    const Frame F = phase_frame(F0);
    unsigned char* ws = A->ws;
    const float* slab = (const float*)(ws + WS_SLAB); bf16* Xb = (bf16*)(ws + WS_XB); pg8::ssq_t* ssq = (pg8::ssq_t*)((float*)(ws + WS_CTL) + CW_SSQ) + (size_t)ssq_idx * MT;
    unsigned* cnt = (unsigned*)(ws + WS_CTL) + CW_FIN + 64 * ssq_idx;
    LAS float* red = (LAS float*)F.lds;
    for (int r = first; r < NSMP; r += stride) {
        const size_t grow = (size_t)(SEQ + r); const int c = F.tid * 4;
        const unsigned long long xr = *(const GAS unsigned long long*)(Xb + grow * DM + c);
        f32x4 v = {bf_lo((unsigned)xr), bf_hi((unsigned)xr), bf_lo((unsigned)(xr >> 32)), bf_hi((unsigned)(xr >> 32))};
        for (int ks = 0; ks < nsplit; ks += 4) {
            f32x4 t[4];
#pragma unroll
            for (int j = 0; j < 4; ++j) t[j] = *(const GAS f32x4*)(slab + ((size_t)((ks + j) * 256 + r)) * DM + c);
#pragma unroll
            for (int j = 0; j < 4; ++j) v += t[j];
        }
        __hip_atomic_store((gu64*)(Xb + grow * DM + c), (unsigned long long)pk2(v.x, v.y) | ((unsigned long long)pk2(v.z, v.w) << 32), __ATOMIC_RELAXED, __HIP_MEMORY_SCOPE_AGENT);
        const float q = wave_sum((v.x * v.x + v.y * v.y) + (v.z * v.z + v.w * v.w));
        if (F.lane == 0) red[F.wave] = q;
        __syncthreads();
        if (F.tid == 0) { float t = 0.f;
#pragma unroll
            for (int i = 0; i < NWAVES; ++i) t += red[i];
            __hip_atomic_store((gu64*)(ssq + grow), pg8::ssq_fx(t), __ATOMIC_RELAXED, __HIP_MEMORY_SCOPE_AGENT); }
        asm volatile("s_waitcnt vmcnt(0)" ::: "memory");
        __syncthreads();
        if (F.tid == 0) __hip_atomic_fetch_add(cnt, 1u, __ATOMIC_RELAXED, __HIP_MEMORY_SCOPE_AGENT);
    }
}

__device__ __forceinline__ bool idle_last_round(int nwg, int G, int c) { const int last = (nwg - 1) / G; return c + last * G >= nwg; }
__device__ __forceinline__ int busy_last_round(int nwg, int G) { const int last = (nwg - 1) / G; return nwg - last * G; }
#define SAMPLE_DOWN_IN_NEXT(j_) do { \
    { pg8::Gemm g{(const bf16*)(ws + WS_H), (const bf16*)(ws + WS_WDN) + (size_t)(lq - 1) * 2048 * 8192, MT, 2048, 2048, 8192}; pg8::SplitOrder S{32, 8, 4, 32, (j_)}; \
      pg8::EpiSlab E{(float*)(ws + WS_SLAB), 2048}; \
      pg8::gemm_phase<pg8::EpiSlab, pg8::SplitOrder, true, true>(F.lds, g, S, E, F.wave); } \
    { unsigned* ca_ = (unsigned*)(ws + WS_CTL) + CW_FIN2 + 64 * (2 * lq); \
      __builtin_amdgcn_fence(__ATOMIC_RELEASE, "agent"); asm volatile("s_waitcnt vmcnt(0)" ::: "memory"); __syncthreads(); \
      if (F.wave == 0 && lane_id() == 0) { __hip_atomic_fetch_add(ca_, 1u, __ATOMIC_RELAXED, __HIP_MEMORY_SCOPE_AGENT); unsigned sp_ = 0u; \
          while (__hip_atomic_load(ca_, __ATOMIC_RELAXED, __HIP_MEMORY_SCOPE_AGENT) < 32u) { __builtin_amdgcn_s_sleep(4); if (++sp_ > (1u << 20)) break; } } \
      __syncthreads(); __builtin_amdgcn_fence(__ATOMIC_ACQUIRE, "agent"); asm volatile("s_waitcnt vmcnt(0)" ::: "memory"); } \
    resid_finalize_pub(F, 4, 2 * lq, (j_), 32); } while (0)

__global__ void __launch_bounds__(NWAVES * 64, 2) __attribute__((amdgpu_waves_per_eu(2, 2))) mk_fwd(Args Aval) {
    extern __shared__ __attribute__((aligned(16))) unsigned char lds[];
    Frame F;
    F.lds = (LAS unsigned char*)lds;
    volatile LAS unsigned* MISC = (volatile LAS unsigned*)(F.lds + MISC_OFF);
    F.tid = threadIdx.x; F.lane = F.tid & 63; F.wave = __builtin_amdgcn_readfirstlane(F.tid >> 6);
    F.G = gridDim.x; { const int bx = blockIdx.x; F.vcu = (F.G % 8 == 0) ? (bx % 8) * (F.G / 8) + bx / 8 : bx; }
    for (int u = F.tid; u < (LDS_BYTES - LDSCTL_OFF) / 4; u += NWAVES * 64) ((LAS unsigned*)(F.lds + LDSCTL_OFF))[u] = 0u;
    __syncthreads();
    (void)xcd_barrier_post((unsigned*)(Aval.ws + WS_CTL) + CW_BAR, MISC + 8);
#define GRID_BAR() do { XcdBarrier b_; b_.bar = (unsigned*)(args_ptr()->ws + WS_CTL) + CW_BAR; b_.x = xb_xcc_id(); b_.st = (volatile LAS unsigned*)(F.lds + MISC_OFF) + 8; xcd_barrier(b_); } while (0)
#define PHASE_PTRS() const ArgsP A = args_ptr(); unsigned char* ws = A->ws; pg8::ssq_t* SSQ = (pg8::ssq_t*)((float*)(ws + WS_CTL) + CW_SSQ); (void)SSQ; int bid = blockIdx.x, GG = F.G, lq = l; asm volatile("" : "+s"(bid), "+s"(GG), "+s"(lq))

    p0_prologue(F);
    GRID_BAR();

    for (int l = 0; l < 4; ++l) {
        for (int sub = 0; sub < 2; ++sub) {
            if (sub == 0) {
                if ((l & 1) == 0) {
                    const int e = l >> 1;
                    {
                        PHASE_PTRS();
                        const int GE = GG == 256 ? GE_E1 : GG;
                        if (lq > 0) { const int sj = GE == GG ? F.vcu : bid - GE; if (sj >= 0 && sj < 32) SAMPLE_DOWN_IN_NEXT(sj); }
                        if (bid < GE) {
                            pg8::Gemm g{(const bf16*)(ws + WS_XB), (const bf16*)(ws + WS_WEI) + (size_t)(lq >> 1) * 2048 * 5120, MT, 5120, 2048, 2048};
                            pg8::DepOrder S; S.init(MT, 5120, GE, bid); S.cnt = (unsigned*)(ws + WS_CTL) + CW_FIN + 64 * (2 * lq); S.need = lq > 0 ? NSMP : 0; S.dep_pm = 32; S.tmo = (unsigned*)(ws + WS_CTL) + CW_BAR + XB_TMO;
                            pg8::EpiEvenIn E{SSQ + (2 * lq) * MT, ws + WS_T, A->out, lq >> 1};
                            pg8::gemm_phase<pg8::EpiEvenIn, pg8::DepOrder, true, true>(F.lds, g, S, E, F.wave);
                        } else conv_phase(F, 0, lq, bid - GE, GG - GE);
                        if (GE == GG) conv_phase(F, 0, lq, F.vcu, F.G);
                    }
                    GRID_BAR();
                    {
                        lru_tasks<1>(F, e);
                        __syncthreads();
                        for (int u = F.vcu; u < 256; u += F.G) {
                            const int h = u >> 5, s = (u >> 4) & 1, p = u & 15;
                            const int ord = u % 3;
#pragma nounroll
                            for (int k = 0; k < 3; ++k) {
                                if (k == ord) att::attn_sweep<true>(F, e, s, h, p);
                                if (k < 2) att::attn_sweep<false>(F, e, s, h, k ? p : 31 - p);
                            }
                        }
                    }
                    GRID_BAR();
                    {
                        if (F.vcu & 1) { attn_combine(F, e); lru_tasks<2>(F, e); }
                        else { lru_tasks<2>(F, e); attn_combine(F, e); }
                    }
                } else {
                    const int o = l >> 1;
                    {
                        PHASE_PTRS();
                        const int GE = GG == 256 ? GE_O1 : GG;
                        { const int sj = GE == GG ? F.vcu : bid - GE; if (sj >= 0 && sj < 32) SAMPLE_DOWN_IN_NEXT(sj); }
                        if (bid < GE) {
                            pg8::Gemm g{(const bf16*)(ws + WS_XB), (const bf16*)(ws + WS_WOI) + (size_t)(lq >> 1) * 2048 * 4096, MT, 4096, 2048, 2048};
                            pg8::DepOrder S; S.init(MT, 4096, GE, bid); S.cnt = (unsigned*)(ws + WS_CTL) + CW_FIN + 64 * (2 * lq); S.need = NSMP; S.dep_pm = 32; S.tmo = (unsigned*)(ws + WS_CTL) + CW_BAR + XB_TMO;
                            pg8::EpiOddIn E{SSQ + (2 * lq) * MT, (bf16*)(ws + WS_U), (bf16*)(ws + WS_VR), SSQ + (9 + (lq >> 1)) * MT};
                            pg8::gemm_phase<pg8::EpiOddIn, pg8::DepOrder, true, true>(F.lds, g, S, E, F.wave);
                        } else conv_phase(F, 1, lq, bid - GE, GG - GE);
                        if (GE == GG) conv_phase(F, 1, lq, F.vcu, F.G);
                    }
                    GRID_BAR();
                    gmlp_phase(F, o);
                }
            } else {
              {
                PHASE_PTRS();
                const int GE = GG == 256 ? GE_F1 : GG;
                {
                    const int sj = GE == GG ? F.vcu : bid - GE;
                    if (sj >= 0 && sj < 8) {
                        const bf16* Wt = (lq & 1) == 0 ? (const bf16*)(ws + WS_WEO) + (size_t)(lq >> 1) * 2048 * 2048 : (const bf16*)(ws + WS_WOO) + (size_t)(lq >> 1) * 2048 * 2048;
                        pg8::Gemm g{(const bf16*)(ws + WS_YC), Wt, MT, 2048, 2048, 2048};
                        pg8::StaticOrder S; S.init(MT, 2048, 1 << 20, (25 + sj) * 8 + 7);
                        pg8::EpiResid E{(bf16*)(ws + WS_XB), SSQ + (2 * lq + 1) * MT};
                        pg8::gemm_phase<pg8::EpiResid, pg8::StaticOrder, true, true>(F.lds, g, S, E, F.wave);
                        __builtin_amdgcn_fence(__ATOMIC_RELEASE, "agent");
                        asm volatile("s_waitcnt vmcnt(0)" ::: "memory");
                        __syncthreads();
                        if (F.wave == 0 && lane_id() == 0) __hip_atomic_fetch_add((unsigned*)(ws + WS_CTL) + CW_FIN + 64 * (2 * lq + 1), 1u, __ATOMIC_RELAXED, __HIP_MEMORY_SCOPE_AGENT);
                    }
                }
              }
              {
                PHASE_PTRS();
                const int GE = GG == 256 ? GE_F1 : GG;
                if (bid < GE) {
                    pg8::Gemm g{(const bf16*)(ws + WS_XB), (const bf16*)(ws + WS_WUP) + (size_t)lq * 2048 * 8192, MT, 8192, 2048, 2048};
                    pg8::DepOrder S; S.init(MT, 8192, GE, bid); S.cnt = (unsigned*)(ws + WS_CTL) + CW_FIN + 64 * (2 * lq + 1); S.need = 8; S.dep_pm = 32; S.tmo = (unsigned*)(ws + WS_CTL) + CW_BAR + XB_TMO;
                    pg8::EpiUp E{SSQ + (2 * lq + 1) * MT, (bf16*)(ws + WS_H)};
                    pg8::gemm_phase<pg8::EpiUp, pg8::DepOrder, true, true>(F.lds, g, S, E, F.wave);
                } else if (lq < 3) conv_phase(F, 2, lq, bid - GE, GG - GE);
                if (GE == GG && lq < 3) conv_phase(F, 2, lq, F.vcu, F.G);
              }
            }
            GRID_BAR();
            {
                PHASE_PTRS();
                const bf16* Wt = sub == 0 ? ((lq & 1) == 0 ? (const bf16*)(ws + WS_WEO) + (size_t)(lq >> 1) * 2048 * 2048 : (const bf16*)(ws + WS_WOO) + (size_t)(lq >> 1) * 2048 * 2048)
                                          : (const bf16*)(ws + WS_WDN) + (size_t)lq * 2048 * 8192;
                const int Kf = sub == 0 ? 2048 : 8192;
                const bf16* Ap = sub == 0 ? (const bf16*)(ws + WS_YC) : (const bf16*)(ws + WS_H);
                {
                    pg8::Gemm g{Ap, Wt, SEQ, 2048, Kf, Kf}; pg8::StaticOrder S; S.init(SEQ, 2048, GG, bid);
                    pg8::EpiResid E{(bf16*)(ws + WS_XB), SSQ + (2 * lq + 1 + sub) * MT};
                    pg8::gemm_phase<pg8::EpiResid, pg8::StaticOrder, true, true>(F.lds, g, S, E, F.wave);
                }
                if (sub == 1 && lq == 3) {
                    pg8::Gemm g{Ap, Wt, MT, 2048, 256, Kf}; pg8::SplitOrder S{32, 8, Kf / 256, GG, bid};
                    pg8::EpiSlab E{(float*)(ws + WS_SLAB), 2048};
                    pg8::gemm_phase<pg8::EpiSlab, pg8::SplitOrder, true, true>(F.lds, g, S, E, F.wave);
                }
            }
            GRID_BAR();
        }
    }
    final_sample(F);
    final_norm(F);
}

extern "C" void kernel_launch(void* const* d_in, const int* in_sizes, int n_in, void* d_out, int out_size, void* d_ws, size_t ws_size, hipStream_t stream) {
    static int grid = 0;
    if (grid == 0) {
        if (n_in != 28 || (size_t)out_size != O_END || ws_size < WS_END) { fprintf(stderr, "kernel_launch: unexpected shapes (n_in %d out %d ws %zu)\n", n_in, out_size, ws_size); grid = -1; return; }
        int dev = 0, cus = 0, per_cu = 0;
        if (hipGetDevice(&dev) != hipSuccess || hipDeviceGetAttribute(&cus, hipDeviceAttributeMultiprocessorCount, dev) != hipSuccess) { grid = -1; return; }
        if (hipFuncSetAttribute((const void*)mk_fwd, hipFuncAttributeMaxDynamicSharedMemorySize, LDS_BYTES) != hipSuccess) { fprintf(stderr, "kernel_launch: hipFuncSetAttribute failed\n"); grid = -1; return; }
        if (hipOccupancyMaxActiveBlocksPerMultiprocessor(&per_cu, (const void*)mk_fwd, NWAVES * 64, LDS_BYTES) != hipSuccess || per_cu < 1) { fprintf(stderr, "kernel_launch: occupancy query says %d\n", per_cu); }
        (void)hipGetLastError();
        grid = cus;
    }
    if (grid < 0) return;
    if (hipMemsetAsync((char*)d_ws + WS_CTL, 0, CTL_ZERO_BYTES, stream) != hipSuccess) return;
    Args a{};
    for (int i = 0; i < 28; ++i) a.in[i] = (const float*)d_in[i];
    a.out = (float*)d_out; a.ws = (unsigned char*)d_ws;
    hipLaunchKernelGGL(mk_fwd, dim3(grid), dim3(NWAVES * 64), LDS_BYTES, stream, a);
}
```

```cpp
#include <hip/hip_runtime.h>
#include <cstdio>
#include <cstdint>
namespace pg8 {
#define PG8_LAS __attribute__((address_space(3)))
typedef unsigned short bf16_t;
typedef short bf16x8 __attribute__((ext_vector_type(8)));
typedef float f32x4 __attribute__((ext_vector_type(4)));
typedef unsigned u32x4 __attribute__((ext_vector_type(4)));
constexpr int BM = 256, BK = 64, HALF = 128, HTB = HALF * BK * 2  , STAGE_BYTES = 8 * HTB, NXCD = 8, WGM = 8;

__host__ __device__ __forceinline__ int lds_byte(int r, int c) { const int st = (r >> 4) * 2 + (c >> 5), rr = r & 15, cc = c & 31, ob = rr * 64 + cc * 2; return st * 1024 + (ob ^ (((ob >> 9) & 1) << 5)); }
__host__ __device__ __forceinline__ void stage_rc(int b, int& R, int& C) { const int st = b / 1024, sb = b % 1024, swz = sb ^ (((sb >> 9) & 1) << 5); R = (st >> 1) * 16 + swz / 64; C = (st & 1) * 32 + (swz % 64) / 2; }
__host__ __device__ __forceinline__ int perm32(int rho) { const int n = rho >> 4, i = rho & 15; return 8 * (i >> 2) + 4 * n + (i & 3); }

struct Unit { int pm, pn, ks; };
struct Gemm { const bf16_t* A; const bf16_t* Bt; int M, N, K, ld; };

struct StaticOrder {
    int nM, nN, nwg, G, c;
    __host__ __device__ void init(int M, int N, int G_, int c_) { nM = M / BM; nN = N / BM; nwg = nM * nN; G = G_; c = c_; }
    __host__ __device__ bool next(int i, Unit& u) const {
        const long L = (long)i * G + c; if (L >= nwg) return false;
        int wgid = (int)L; { const int q = nwg / NXCD, r = nwg % NXCD, xcd = wgid % NXCD, off = wgid / NXCD; wgid = (xcd < r ? xcd * (q + 1) : r * (q + 1) + (xcd - r) * q) + off; }
        const int nig = WGM * nN, gid = wgid / nig, fm = gid * WGM, gsz = (nM - fm) < WGM ? (nM - fm) : WGM;
        u.pm = fm + ((wgid % nig) % gsz); u.pn = (wgid % nig) / gsz; u.ks = 0; return true;
    }
    __device__ __forceinline__ void a_ready(const Unit&) const {}
    __device__ __forceinline__ void done(const Unit&) const {}
};

__device__ __forceinline__ unsigned cvt_pk_bf16(float lo, float hi) { unsigned r; asm volatile("v_cvt_pk_bf16_f32 %0, %1, %2" : "=v"(r) : "v"(lo), "v"(hi)); return r; }
struct SplitOrder {
    int pm, nN, nsplit, G, c;
    __host__ __device__ bool next(int i, Unit& u) const { const int L = i * G + c; if (L >= nN * nsplit) return false; u.pm = pm; u.pn = L % nN; u.ks = L / nN; return true; }
    __device__ __forceinline__ void a_ready(const Unit&) const {}
    __device__ __forceinline__ void done(const Unit&) const {}
};
struct DepOrder : StaticOrder {
    unsigned* cnt; unsigned need; int dep_pm; unsigned* tmo;
    __device__ __forceinline__ void a_ready(const Unit& u) const {
        if (need == 0u || u.pm != dep_pm) return;
        if (threadIdx.x < 64) {
            unsigned sp = 0u;
            while ((unsigned)__builtin_amdgcn_readfirstlane((int)__hip_atomic_load(cnt, __ATOMIC_RELAXED, __HIP_MEMORY_SCOPE_AGENT)) < need) {
                __builtin_amdgcn_s_sleep(2);
                if ((++sp & 255u) == 0u) { if (__hip_atomic_load(tmo, __ATOMIC_RELAXED, __HIP_MEMORY_SCOPE_AGENT)) break; if (sp > (1u << 18)) { __hip_atomic_fetch_add(tmo, 1u, __ATOMIC_RELAXED, __HIP_MEMORY_SCOPE_AGENT); break; } } }
            __builtin_amdgcn_fence(__ATOMIC_ACQUIRE, "agent");
            asm volatile("s_waitcnt vmcnt(0)" ::: "memory");
        }
        asm volatile("" ::: "memory"); __builtin_amdgcn_s_barrier(); asm volatile("" ::: "memory");
    }
};
typedef float f32x2 __attribute__((ext_vector_type(2)));
constexpr float RMS_EPS = 1e-6f;
constexpr float QSCALE = 0.125f * 1.4426950408889634f;
template <int O> __device__ __forceinline__ float xorl(float v) { return __builtin_bit_cast(float, __builtin_amdgcn_ds_swizzle(__builtin_bit_cast(int, v), (O << 10) | 0x1f)); }
__device__ __forceinline__ float sum_x32(float v) { auto rr = __builtin_amdgcn_permlane32_swap(__float_as_uint(v), __float_as_uint(v), false, false); const unsigned r0 = rr[0], r1 = rr[1]; return __uint_as_float(r0) + __uint_as_float(r1); }
__device__ __forceinline__ float max_x32(float v) { auto rr = __builtin_amdgcn_permlane32_swap(__float_as_uint(v), __float_as_uint(v), false, false); const unsigned r0 = rr[0], r1 = rr[1]; return fmaxf(__uint_as_float(r0), __uint_as_float(r1)); }
typedef unsigned long long ssq_t;
constexpr float SSQ_FX = 1048576.0f, SSQ_INV = 1.0f / 1048576.0f;
__device__ __forceinline__ ssq_t ssq_fx(float s) { return (ssq_t)(s * SSQ_FX + 0.5f); }
__device__ __forceinline__ float ssq_rstd(ssq_t q) { return __builtin_amdgcn_rsqf((float)q * (SSQ_INV / 2048.0f) + RMS_EPS); }
__device__ __forceinline__ void atomic_addq(ssq_t* p, float v) { __hip_atomic_fetch_add(p, ssq_fx(v), __ATOMIC_RELAXED, __HIP_MEMORY_SCOPE_AGENT); }
__device__ __forceinline__ void gelu8(f32x4& a, f32x4& b) {
    constexpr float C1 = -2.0f * 0.7978845608028654f * 1.4426950408889634f, C2 = C1 * 0.044715f;
    const f32x4 ya = a * (a * a * C2 + C1), yb = b * (b * b * C2 + C1);
    f32x4 ea, eb;
#pragma unroll
    for (int i = 0; i < 4; ++i) { ea[i] = __builtin_amdgcn_exp2f(ya[i]); eb[i] = __builtin_amdgcn_exp2f(yb[i]); }
    const f32x4 da = ea + 1.0f, db = eb + 1.0f;
    f32x4 ra, rb;
#pragma unroll
    for (int i = 0; i < 4; ++i) { ra[i] = __builtin_amdgcn_rcpf(da[i]); rb[i] = __builtin_amdgcn_rcpf(db[i]); }
    a = a * ra; b = b * rb;
}
__device__ __forceinline__ u32x4 pack8(const f32x4 a, const f32x4 b) { u32x4 w; w.x = cvt_pk_bf16(a[0], a[1]); w.y = cvt_pk_bf16(a[2], a[3]); w.z = cvt_pk_bf16(b[0], b[1]); w.w = cvt_pk_bf16(b[2], b[3]); return w; }
__device__ __forceinline__ float dot8(const f32x4 a, const f32x4 b) { return (a[0] * a[0] + a[1] * a[1]) + (a[2] * a[2] + a[3] * a[3]) + (b[0] * b[0] + b[1] * b[1]) + (b[2] * b[2] + b[3] * b[3]); }

struct EpiEvenIn {
    static constexpr bool PERM = true, AFTER_DRAIN = false;
    const ssq_t* ssq; unsigned char* tb  ; float* out; int e;
    __device__ __forceinline__ void operator()(const f32x4 (&acc)[2][2][4][2], const Unit& u, int wr, int wc, int fr, int fq) const {
        const int reg = u.pn >> 2;
        const int row0 = u.pm * BM + wr * 64 + fr, c0 = (u.pn & 3) * 256 + wc * 32 + 8 * fq;
        bf16_t* G = (bf16_t*)tb; float* XR = (float*)(tb + ((size_t)17 << 20)); bf16_t* Q = (bf16_t*)(tb + ((size_t)50 << 20));
        float rs[2][4];
#pragma unroll
        for (int ai = 0; ai < 2; ++ai)
#pragma unroll
            for (int m = 0; m < 4; ++m) rs[ai][m] = ssq_rstd(ssq[row0 + ai * HALF + m * 16]);
        if (reg == 0) {
#pragma unroll
            for (int ai = 0; ai < 2; ++ai)
#pragma unroll
                for (int m = 0; m < 4; ++m) { const size_t row = (size_t)(row0 + ai * HALF + m * 16); const float r = rs[ai][m];
#pragma unroll
                    for (int bj = 0; bj < 2; ++bj) { f32x4 v0 = acc[ai][bj][m][0] * r, v1 = acc[ai][bj][m][1] * r;
#pragma unroll
                        for (int i = 0; i < 1; ++i) gelu8(v0, v1);
                        *(u32x4*)(G + row * 1024 + c0 + bj * HALF) = pack8(v0, v1); } }
        } else if (reg == 1) {
#pragma unroll
            for (int ai = 0; ai < 2; ++ai)
#pragma unroll
                for (int m = 0; m < 4; ++m) { const size_t row = (size_t)(row0 + ai * HALF + m * 16); const float r = rs[ai][m];
#pragma unroll
                    for (int bj = 0; bj < 2; ++bj) { float* p = XR + row * 1024 + c0 + bj * HALF; *(f32x4*)p = acc[ai][bj][m][0] * r; *(f32x4*)(p + 4) = acc[ai][bj][m][1] * r; } }
        } else if (reg == 2) {
#pragma unroll
            for (int ai = 0; ai < 2; ++ai)
#pragma unroll
                for (int m = 0; m < 4; ++m) { const size_t row = (size_t)(row0 + ai * HALF + m * 16); const float r = rs[ai][m] * QSCALE;
#pragma unroll
                    for (int bj = 0; bj < 2; ++bj) *(u32x4*)(Q + row * 1024 + c0 + bj * HALF) = pack8(acc[ai][bj][m][0] * r, acc[ai][bj][m][1] * r); }
        } else {
            bf16_t* B = (bf16_t*)(tb + ((size_t)(reg == 3 ? 67 : 84) << 20));
            const size_t ooff = (u.pm < 32) ? (size_t)(reg == 3 ? 17309696 : 34086912) + (size_t)e * 8192 * 1024 : (size_t)(reg == 3 ? 50995200 : 51519488) + (size_t)e * 256 * 1024;
            float* O = out + ooff; const int orow0 = (u.pm < 32) ? row0 : row0 - 8192;
#pragma unroll
            for (int ai = 0; ai < 2; ++ai)
#pragma unroll
                for (int m = 0; m < 4; ++m) { const size_t row = (size_t)(row0 + ai * HALF + m * 16), orow = (size_t)(orow0 + ai * HALF + m * 16); const float r = rs[ai][m];
#pragma unroll
                    for (int bj = 0; bj < 2; ++bj) { const f32x4 v0 = acc[ai][bj][m][0] * r, v1 = acc[ai][bj][m][1] * r;
                        *(u32x4*)(B + row * 1024 + c0 + bj * HALF) = pack8(v0, v1);
                        float* p = O + orow * 1024 + c0 + bj * HALF; *(f32x4*)p = v0; *(f32x4*)(p + 4) = v1; } }
        }
    }
};
struct EpiResid {
    static constexpr bool PERM = true, AFTER_DRAIN = false;
    bf16_t* Xb; ssq_t* ssq_next;
    __device__ __forceinline__ void operator()(const f32x4 (&acc)[2][2][4][2], const Unit& u, int wr, int wc, int fr, int fq) const {
        const int row0 = u.pm * BM + wr * 64 + fr, c0 = u.pn * BM + wc * 32 + 8 * fq;
#pragma unroll
        for (int ai = 0; ai < 2; ++ai)
#pragma unroll
            for (int m = 0; m < 4; ++m) { const size_t row = (size_t)(row0 + ai * HALF + m * 16); float s = 0.f;
#pragma unroll
                for (int bj = 0; bj < 2; ++bj) { bf16_t* p = Xb + row * 2048 + c0 + bj * HALF; const u32x4 r = *(const u32x4*)p;
                    const f32x4 x0 = (f32x4){__uint_as_float(r.x << 16), __uint_as_float(r.x & 0xffff0000u), __uint_as_float(r.y << 16), __uint_as_float(r.y & 0xffff0000u)} + acc[ai][bj][m][0];
                    const f32x4 x1 = (f32x4){__uint_as_float(r.z << 16), __uint_as_float(r.z & 0xffff0000u), __uint_as_float(r.w << 16), __uint_as_float(r.w & 0xffff0000u)} + acc[ai][bj][m][1];
                    *(u32x4*)p = pack8(x0, x1); s += dot8(x0, x1); }
                s += xorl<16>(s); s = sum_x32(s);
                if (fq == 0) atomic_addq(ssq_next + row, s); }
    }
};
struct EpiUp {
    static constexpr bool PERM = true, AFTER_DRAIN = false;
    const ssq_t* ssq; bf16_t* H;
    __device__ __forceinline__ void operator()(const f32x4 (&acc)[2][2][4][2], const Unit& u, int wr, int wc, int fr, int fq) const {
        const int row0 = u.pm * BM + wr * 64 + fr, c0 = u.pn * BM + wc * 32 + 8 * fq;
#pragma unroll
        for (int ai = 0; ai < 2; ++ai)
#pragma unroll
            for (int m = 0; m < 4; ++m) { const size_t row = (size_t)(row0 + ai * HALF + m * 16); const float r = ssq_rstd(ssq[row]);
#pragma unroll
                for (int bj = 0; bj < 2; ++bj) { f32x4 v0 = acc[ai][bj][m][0] * r, v1 = acc[ai][bj][m][1] * r;
#pragma unroll
                    for (int i = 0; i < 4; ++i) { const float a = fmaxf(v0[i], 0.f), b = fmaxf(v1[i], 0.f); v0[i] = a * a; v1[i] = b * b; }
                    *(u32x4*)(H + row * 8192 + c0 + bj * HALF) = pack8(v0, v1); } }
    }
};
struct EpiOddIn {
    static constexpr bool PERM = true, AFTER_DRAIN = false;
    const ssq_t* ssq; bf16_t* U; bf16_t* VR; ssq_t* ssqv;
    __device__ __forceinline__ void operator()(const f32x4 (&acc)[2][2][4][2], const Unit& u, int wr, int wc, int fr, int fq) const {
        const int reg = u.pn >> 3;
        const int row0 = u.pm * BM + wr * 64 + fr, c0 = (u.pn & 7) * 256 + wc * 32 + 8 * fq;
        bf16_t* B = reg ? VR : U;
#pragma unroll
        for (int ai = 0; ai < 2; ++ai)
#pragma unroll
            for (int m = 0; m < 4; ++m) { const size_t row = (size_t)(row0 + ai * HALF + m * 16); const float r = ssq_rstd(ssq[row]); float s = 0.f;
#pragma unroll
                for (int bj = 0; bj < 2; ++bj) { f32x4 v0 = acc[ai][bj][m][0] * r, v1 = acc[ai][bj][m][1] * r;
#pragma unroll
                    for (int i = 0; i < 1; ++i) gelu8(v0, v1);
                    *(u32x4*)(B + row * 2048 + c0 + bj * HALF) = pack8(v0, v1); s += dot8(v0, v1); }
                if (reg) { s += xorl<16>(s); s = sum_x32(s); if (fq == 0) atomic_addq(ssqv + row, s); } }
    }
};
struct EpiSlab {
    static constexpr bool PERM = true, AFTER_DRAIN = false;
    float* slab; int N;
    __device__ __forceinline__ void operator()(const f32x4 (&acc)[2][2][4][2], const Unit& u, int wr, int wc, int fr, int fq) const {
        const int r0 = wr * 64 + fr, c0 = u.pn * BM + wc * 32 + 8 * fq;
#pragma unroll
        for (int ai = 0; ai < 2; ++ai)
#pragma unroll
            for (int m = 0; m < 4; ++m) { float* p = slab + ((size_t)(u.ks * 256 + r0 + ai * HALF + m * 16)) * N + c0;
#pragma unroll
                for (int bj = 0; bj < 2; ++bj) { *(f32x4*)(p + bj * HALF) = acc[ai][bj][m][0]; *(f32x4*)(p + bj * HALF + 4) = acc[ai][bj][m][1]; } }
    }
};
template <class Epi, class Sched, bool ALIGN_EPI = false, bool SP2 = false>
__device__ __forceinline__ void gemm_phase(PG8_LAS unsigned char* lds, const Gemm g, const Sched& S, const Epi& E, int wave0) {
    int wid_ = wave0; asm volatile("" : "+s"(wid_)); int lane_; asm volatile("v_mbcnt_lo_u32_b32 %0, -1, 0\n\tv_mbcnt_hi_u32_b32 %0, -1, %0" : "=v"(lane_));
    const int wid = wid_, lane = lane_, tid = wid * 64 + lane, wr = wid >> 2, wc = wid & 3, fr = lane & 15, fq = lane >> 4;
    const int K = g.K, nt = K / BK, ld = g.ld;
    unsigned voffA[2], voffB[2];
#pragma unroll
    for (int i = 0; i < 2; ++i) { int R, C; stage_rc(tid * 16 + i * 8192, R, C); const int Rb = Epi::PERM ? ((R & ~31) + perm32(R & 31)) : R;
        voffA[i] = (unsigned)(R * ld + C) * 2u; voffB[i] = (unsigned)(Rb * ld + C) * 2u; }
    const size_t kstep = (size_t)(BK * 2);
    const size_t hstep = (size_t)HALF * ld * 2; const size_t sstep = (size_t)K * 2  ;
    const size_t tstep = 2 * hstep;
    const unsigned ldsw = (unsigned)wid * 1024u;
    const int aoff = lds_byte(wr * 64 + fr, fq * 8), boff = lds_byte(wc * 32 + fr, fq * 8);
#define PG8_SA(b, h) (((b) * 2 + (h)) * HTB)
#define PG8_SB(b, h) ((4 + (b) * 2 + (h)) * HTB)
#define PG8_STAGE(bufoff, gbase, voff) do { _Pragma("unroll") for (int _i = 0; _i < 2; ++_i) \
        __builtin_amdgcn_global_load_lds((const unsigned*)((const char*)(gbase) + (voff)[_i]), (PG8_LAS unsigned*)(lds + (bufoff) + ldsw + _i * 8192), 16, 0, 0); } while (0)
#define PG8_LDA(dst, b, h) do { _Pragma("unroll") for (int m = 0; m < 4; ++m) _Pragma("unroll") for (int k = 0; k < 2; ++k) dst[m][k] = *(const PG8_LAS bf16x8*)(lds + PG8_SA(b, h) + aoff + m * 2048 + k * 1024); } while (0)
#define PG8_LDB(dst, b, h) do { _Pragma("unroll") for (int n = 0; n < 2; ++n) _Pragma("unroll") for (int k = 0; k < 2; ++k) dst[n][k] = *(const PG8_LAS bf16x8*)(lds + PG8_SB(b, h) + boff + n * 2048 + k * 1024); } while (0)
#define PG8_MMA(ai, bj, At, Bt) do { __builtin_amdgcn_s_setprio(1); _Pragma("unroll") for (int m = 0; m < 4; ++m) _Pragma("unroll") for (int n = 0; n < 2; ++n) _Pragma("unroll") for (int k = 0; k < 2; ++k) \
        acc[ai][bj][m][n] = __builtin_amdgcn_mfma_f32_16x16x32_bf16(Bt[n][k], At[m][k], acc[ai][bj][m][n], 0, 0, 0); __builtin_amdgcn_s_setprio(0); } while (0)
#define PG8_WAIT_V(n) asm volatile("s_waitcnt vmcnt(" #n ")" ::: "memory")
#define PG8_WAIT_L(n) asm volatile("s_waitcnt lgkmcnt(" #n ")" ::: "memory")
#define PG8_BAR __builtin_amdgcn_s_barrier()
#define PG8_SCHED __builtin_amdgcn_sched_barrier(0)
    Unit cur, nxt; int ui = 0;
    if (!S.next(0, cur)) return;
    f32x4 acc[2][2][4][2];
#pragma unroll
    for (int a = 0; a < 2; ++a)
#pragma unroll
        for (int b = 0; b < 2; ++b)
#pragma unroll
            for (int m = 0; m < 4; ++m)
#pragma unroll
                for (int n = 0; n < 2; ++n) acc[a][b][m][n] = (f32x4){0.f, 0.f, 0.f, 0.f};
    bf16x8 At[4][2], B0[2][2], B1[2][2];
    const char* cA = (const char*)g.A + (size_t)cur.pm * tstep + (size_t)cur.ks * sstep; const char* cB = (const char*)g.Bt + (size_t)cur.pn * tstep + (size_t)cur.ks * sstep;
    S.a_ready(cur);
    if constexpr (SP2) {
        PG8_STAGE(PG8_SB(0, 0), cB, voffB); PG8_STAGE(PG8_SB(0, 1), cB + hstep, voffB); PG8_STAGE(PG8_SA(0, 0), cA, voffA); PG8_STAGE(PG8_SA(0, 1), cA + hstep, voffA);
        if (wr == 1) PG8_BAR;
        PG8_WAIT_V(2); PG8_BAR;
        PG8_STAGE(PG8_SB(1, 0), cB + kstep, voffB); PG8_STAGE(PG8_SA(1, 0), cA + kstep, voffA); PG8_STAGE(PG8_SB(1, 1), cB + hstep + kstep, voffB);
        PG8_WAIT_V(6); PG8_BAR;
    } else {
        PG8_STAGE(PG8_SB(0, 0), cB, voffB); PG8_STAGE(PG8_SA(0, 0), cA, voffA); PG8_STAGE(PG8_SB(0, 1), cB + hstep, voffB); PG8_STAGE(PG8_SA(0, 1), cA + hstep, voffA);
        if (wr == 1) PG8_BAR;
        PG8_WAIT_V(4); PG8_BAR;
        PG8_STAGE(PG8_SB(1, 0), cB + kstep, voffB); PG8_STAGE(PG8_SA(1, 0), cA + kstep, voffA); PG8_STAGE(PG8_SB(1, 1), cB + hstep + kstep, voffB);
        PG8_WAIT_V(6); PG8_BAR;
    }
    for (;;) {
        const bool has_next = S.next(ui + 1, nxt);
        const char* nA = has_next ? (const char*)g.A + (size_t)nxt.pm * tstep + (size_t)nxt.ks * sstep : cA; const char* nB = has_next ? (const char*)g.Bt + (size_t)nxt.pn * tstep + (size_t)nxt.ks * sstep : cB;
        for (int t = 0; t < nt; t += 2) {
            const bool last = (t == nt - 2);
            const char* a1 = cA + (size_t)(t + 1) * kstep;
            const char* a2 = last ? nA : cA + (size_t)(t + 2) * kstep; const char* b2 = last ? nB : cB + (size_t)(t + 2) * kstep;
            const char* a3 = a2 + kstep; const char* b3 = b2 + kstep;
            if (last && has_next) S.a_ready(nxt);
            if constexpr (SP2) {
            PG8_LDB(B0, 0, 0); PG8_LDB(B1, 0, 1); PG8_SCHED; PG8_LDA(At, 0, 0); PG8_STAGE(PG8_SA(1, 1), a1 + hstep, voffA);
            PG8_WAIT_V(8); PG8_WAIT_L(0); PG8_BAR; PG8_MMA(0, 0, At, B0); PG8_MMA(0, 1, At, B1); PG8_BAR; PG8_SCHED;
            PG8_LDA(At, 0, 1); PG8_STAGE(PG8_SB(0, 0), b2, voffB); PG8_STAGE(PG8_SB(0, 1), b2 + hstep, voffB); PG8_STAGE(PG8_SA(0, 0), a2, voffA);
            PG8_WAIT_V(8); PG8_WAIT_L(0); PG8_BAR; PG8_MMA(1, 0, At, B0); PG8_MMA(1, 1, At, B1); PG8_BAR; PG8_SCHED;
            PG8_LDB(B0, 1, 0); PG8_LDB(B1, 1, 1); PG8_SCHED; PG8_LDA(At, 1, 0); PG8_STAGE(PG8_SA(0, 1), a2 + hstep, voffA);
            PG8_WAIT_V(8); PG8_WAIT_L(0); PG8_BAR; PG8_MMA(0, 0, At, B0); PG8_MMA(0, 1, At, B1); PG8_BAR; PG8_SCHED;
            PG8_LDA(At, 1, 1); PG8_STAGE(PG8_SB(1, 0), b3, voffB); PG8_STAGE(PG8_SB(1, 1), b3 + hstep, voffB); PG8_STAGE(PG8_SA(1, 0), a3, voffA);
            PG8_WAIT_V(8); PG8_WAIT_L(0); PG8_BAR; PG8_MMA(1, 0, At, B0); PG8_MMA(1, 1, At, B1); PG8_BAR; PG8_SCHED;
            } else {
            PG8_LDB(B0, 0, 0); PG8_SCHED; PG8_LDA(At, 0, 0); PG8_STAGE(PG8_SA(1, 1), a1 + hstep, voffA);
            PG8_WAIT_L(8); PG8_BAR; PG8_WAIT_L(0); PG8_MMA(0, 0, At, B0); PG8_BAR; PG8_SCHED;
            PG8_LDB(B1, 0, 1); PG8_STAGE(PG8_SB(0, 0), b2, voffB);
            PG8_BAR; PG8_WAIT_L(0); PG8_MMA(0, 1, At, B1); PG8_BAR;
            PG8_LDA(At, 0, 1); PG8_STAGE(PG8_SA(0, 0), a2, voffA);
            PG8_BAR; PG8_WAIT_L(0); PG8_MMA(1, 0, At, B0); PG8_BAR; PG8_SCHED;
            PG8_STAGE(PG8_SB(0, 1), b2 + hstep, voffB);
            PG8_WAIT_V(6); PG8_BAR; PG8_MMA(1, 1, At, B1); PG8_BAR;
            PG8_LDB(B0, 1, 0); PG8_SCHED; PG8_LDA(At, 1, 0); PG8_STAGE(PG8_SA(0, 1), a2 + hstep, voffA);
            PG8_WAIT_L(8); PG8_BAR; PG8_WAIT_L(0); PG8_MMA(0, 0, At, B0); PG8_BAR; PG8_SCHED;
            PG8_LDB(B1, 1, 1); PG8_STAGE(PG8_SB(1, 0), b3, voffB);
            PG8_BAR; PG8_WAIT_L(0); PG8_MMA(0, 1, At, B1); PG8_BAR;
            PG8_LDA(At, 1, 1); PG8_STAGE(PG8_SA(1, 0), a3, voffA);
            PG8_BAR; PG8_WAIT_L(0); PG8_MMA(1, 0, At, B0); PG8_BAR; PG8_SCHED;
            PG8_STAGE(PG8_SB(1, 1), b3 + hstep, voffB);
            PG8_WAIT_V(6); PG8_BAR; PG8_MMA(1, 1, At, B1); PG8_BAR;
            }
        }
        if constexpr (ALIGN_EPI) { if (wr == 0) PG8_BAR; }
        if constexpr (!Epi::AFTER_DRAIN) { E(acc, cur, wr, wc, fr, fq); S.done(cur); }
        if (!has_next) break;
#pragma unroll
        for (int a = 0; a < 2; ++a)
#pragma unroll
            for (int b = 0; b < 2; ++b)
#pragma unroll
                for (int m = 0; m < 4; ++m)
#pragma unroll
                    for (int n = 0; n < 2; ++n) acc[a][b][m][n] = (f32x4){0.f, 0.f, 0.f, 0.f};
        cur = nxt; cA = nA; cB = nB; ++ui;
        if constexpr (ALIGN_EPI) { if (wr == 1) PG8_BAR; }
    }
    PG8_WAIT_V(0);
    if constexpr (!ALIGN_EPI) { if (wr == 0) PG8_BAR; }
    PG8_BAR;
    if constexpr (Epi::AFTER_DRAIN) { E.fused(acc, cur, wr, wc, fr, fq, lds, wid, lane); S.done(cur); }
#undef PG8_SA
#undef PG8_SB
#undef PG8_STAGE
#undef PG8_LDA
#undef PG8_LDB
#undef PG8_MMA
#undef PG8_WAIT_V
#undef PG8_WAIT_L
#undef PG8_BAR
#undef PG8_SCHED
}
}

constexpr int DM = 2048, SEQ = 8192, NSMP = 256, MT = SEQ + NSMP  , DRNN = 1024, BW = 1024, DFF = 8192;
constexpr int NWAVES = 8;
constexpr float RMS_EPS = 1e-6f, LOG2E = 1.4426950408889634f;
constexpr size_t O_YP = 0, O_YS = O_YP + (size_t)SEQ * DM, O_PCONV = O_YS + (size_t)NSMP * DM, O_PLRU = O_PCONV + 2 * 3 * 1024, O_PK = O_PLRU + 2 * 1024, O_PV = O_PK + (size_t)2 * SEQ * 1024,
                 O_SCONV = O_PV + (size_t)2 * SEQ * 1024, O_SLRU = O_SCONV + 2 * 16 * 3 * 1024, O_SK = O_SLRU + 2 * 16 * 1024, O_SV = O_SK + (size_t)2 * NSMP * 1024, O_SGV = O_SV + (size_t)2 * NSMP * 1024,
                 O_END = O_SGV + (size_t)2 * NSMP * 2048;
constexpr size_t MiB = 1u << 20;
constexpr size_t WS_CTL = 0, CTL_ZERO_BYTES = 1 * MiB;
constexpr size_t WS_CS = 1 * MiB;
constexpr size_t WS_WAT = 2 * MiB, WS_WXT = WS_WAT + 256 * 1024, WS_WSB = 3 * MiB;
constexpr size_t WS_WEI = 4 * MiB, WS_WEO = 44 * MiB, WS_WOI = 60 * MiB, WS_WOO = 92 * MiB, WS_WUP = 108 * MiB, WS_WDN = 236 * MiB;
constexpr size_t WS_X = 364 * MiB, WS_XB = 430 * MiB, WS_YC = 463 * MiB;
constexpr size_t WS_T = 496 * MiB;
constexpr size_t WS_H = WS_T;
constexpr size_t WS_G = WS_T, WS_XR = WS_T + 17 * MiB, WS_Q = WS_T + 50 * MiB, WS_KB = WS_T + 67 * MiB, WS_VB = WS_T + 84 * MiB, WS_OS = WS_T + 101 * MiB;
constexpr size_t WS_U = WS_T, WS_VR = WS_T + 33 * MiB;
constexpr size_t WS_SLAB = WS_T + 168 * MiB;
constexpr size_t WS_END = WS_SLAB + 64 * MiB;
static_assert(WS_G == WS_T && WS_XR == WS_T + (17u << 20) && WS_Q == WS_T + (50u << 20) && WS_KB == WS_T + (67u << 20) && WS_VB == WS_T + (84u << 20), "EpiEvenIn offsets");
static_assert(O_PK == 17309696 && O_PV == 34086912 && O_SK == 50995200 && O_SV == 51519488, "EpiEvenIn output offsets");
constexpr int CW_TMO = 0, CW_CODE = 1, CW_BAR = 4096, CW_SSQ = 8192;
constexpr int CW_FIN2 = CW_SSQ + 2 * 11 * MT + 2560;
constexpr int CW_FIN = CW_SSQ + 2 * 11 * MT + 512;
static_assert((CW_FIN + 64 * 9) * 4 <= (int)CTL_ZERO_BYTES, "CTL");
constexpr int RING_BYTES = 131072, LDSCTL_OFF = RING_BYTES, MISC_OFF = LDSCTL_OFF + 320, LDS_BYTES = 147456;

#define GAS __attribute__((address_space(1)))
#define LAS __attribute__((address_space(3)))
typedef unsigned short bf16;
typedef unsigned v4u __attribute__((ext_vector_type(4)));
typedef float f32x4 __attribute__((ext_vector_type(4)));
typedef short bf16x8 __attribute__((ext_vector_type(8)));
typedef GAS unsigned gu32;
typedef GAS unsigned long long gu64;
#define RLX_AGENT __ATOMIC_RELAXED, __HIP_MEMORY_SCOPE_AGENT
#define LDS_WAIT() asm volatile("s_waitcnt lgkmcnt(0)" ::: "memory")
#define VM_WAIT() asm volatile("s_waitcnt vmcnt(0)" ::: "memory")
__device__ __forceinline__ unsigned long long rt() { return __builtin_amdgcn_s_memrealtime(); }
__device__ __forceinline__ unsigned f2bf(float f) { unsigned u = __builtin_bit_cast(unsigned, f); return (u + 0x7fffu + ((u >> 16) & 1u)) >> 16; }
typedef float f32x2_t __attribute__((ext_vector_type(2))); typedef __bf16 bf16x2_t __attribute__((ext_vector_type(2)));
__device__ __forceinline__ unsigned pk2(float lo, float hi) { f32x2_t v = {lo, hi}; bf16x2_t b = __builtin_convertvector(v, bf16x2_t); return __builtin_bit_cast(unsigned, b); }

#define XB_TMO      128
#define XB_XCNT(j)  (256  + 64 * (j))
#define XB_XSUB(j)  (1280 + 64 * (j))
#define XB_XGEN(j)  (2304 + 64 * (j))
#define XB_TOP      3328
#define XB_TOPGEN   3392
#define XCD_BAR_WORDS 3456
#define XB_SPIN_CAP (1u << 18)

__device__ __forceinline__ unsigned xb_ld(unsigned* p)              { return __hip_atomic_load(p, __ATOMIC_RELAXED, __HIP_MEMORY_SCOPE_AGENT); }
__device__ __forceinline__ unsigned xb_add(unsigned* p, unsigned v) { return __hip_atomic_fetch_add(p, v, __ATOMIC_RELAXED, __HIP_MEMORY_SCOPE_AGENT); }
__device__ __forceinline__ unsigned xb_xcc_id() { return (unsigned)__builtin_amdgcn_s_getreg((3 << 11) | 20) & 0xFu; }
#define XB_SPIN(cond, bar) do { unsigned _sp = 0; while (cond) { __builtin_amdgcn_s_sleep(1); \
    if ((++_sp & 255u) == 0u) { if (xb_ld(&(bar)[XB_TMO])) break; if (_sp > XB_SPIN_CAP) { atomicAdd(&(bar)[XB_TMO], 1u); break; } } } } while (0)

struct XcdBarrier {
    unsigned* bar; unsigned x;
    volatile LAS unsigned* st;
};

__device__ __forceinline__ XcdBarrier xcd_barrier_post(unsigned* bar, volatile LAS unsigned* st) {
    XcdBarrier b; b.bar = bar; b.x = xb_xcc_id(); b.st = st;
    if (threadIdx.x == 0) (void)xb_add(&bar[XB_XCNT(b.x)], 1u);
    return b;
}
__device__ __forceinline__ void xcd_barrier_complete(unsigned* bar, unsigned x, unsigned& nloc, unsigned& nx) {
    const unsigned G = gridDim.x * gridDim.y * gridDim.z;
    unsigned sum, cnt, mine, sp = 0u;
    for (;;) {
        sum = 0u; cnt = 0u; mine = 0u;
#pragma unroll
        for (unsigned j = 0; j < 16; ++j) { const unsigned c = xb_ld(&bar[XB_XCNT(j)]); sum += c; cnt += (c > 0u) ? 1u : 0u; mine = (j == x) ? c : mine; }
        if (sum == G) break;
        __builtin_amdgcn_s_sleep(1);
        if ((++sp & 255u) == 0u) { if (xb_ld(&bar[XB_TMO])) break; if (sp > XB_SPIN_CAP) { atomicAdd(&bar[XB_TMO], 1u); break; } }
    }
    nloc = mine > 0u ? mine : 1u; nx = cnt > 0u ? cnt : 1u;
}

__device__ __forceinline__ void xcd_barrier(const XcdBarrier& b) {
    asm volatile("s_waitcnt vmcnt(0)" ::: "memory");
    __syncthreads();
    if (threadIdx.x == 0) {
        unsigned* bar = b.bar;
        __builtin_amdgcn_s_waitcnt(0);
        unsigned nloc = b.st[0], nx = b.st[1];
        if (nloc == 0u) { xcd_barrier_complete(bar, b.x, nloc, nx); b.st[0] = nloc; b.st[1] = nx; }
        const unsigned old = xb_add(&bar[XB_XSUB(b.x)], 1u);
        const unsigned gen = old / nloc;
        if (old + 1u == (gen + 1u) * nloc) {
            __builtin_amdgcn_fence(__ATOMIC_RELEASE, "agent");
            asm volatile("s_waitcnt vmcnt(0)" ::: "memory");
            const unsigned og = xb_add(&bar[XB_TOP], 1u);
            const unsigned tg = og / nx;
            if (og + 1u == (tg + 1u) * nx) xb_add(&bar[XB_TOPGEN], 1u);
            else XB_SPIN(xb_ld(&bar[XB_TOPGEN]) == tg, bar);
            __builtin_amdgcn_fence(__ATOMIC_ACQUIRE, "agent");
            xb_add(&bar[XB_XGEN(b.x)], 1u);
            asm volatile("s_waitcnt vmcnt(0)" ::: "memory");
        } else {
            XB_SPIN(xb_ld(&bar[XB_XGEN(b.x)]) == gen, bar);
            __builtin_amdgcn_fence(__ATOMIC_ACQUIRE, "agent");
            asm volatile("s_waitcnt vmcnt(0)" ::: "memory");
        }
    }
    __syncthreads();
}


struct Args { const float* in[28]; float* out; unsigned char* ws; };
typedef const __attribute__((address_space(4))) Args* ArgsP;
__device__ __forceinline__ ArgsP args_ptr() { ArgsP p = (ArgsP)__builtin_amdgcn_kernarg_segment_ptr(); asm volatile("" : "+s"(p)); return p; }
struct Frame { LAS unsigned char* lds; int tid, lane, wave, vcu, G; };
__device__ __forceinline__ int lane_id() { int l; asm volatile("v_mbcnt_lo_u32_b32 %0, -1, 0\n\tv_mbcnt_hi_u32_b32 %0, -1, %0" : "=v"(l)); return l; }
__device__ __forceinline__ Frame phase_frame(const Frame& F0) { Frame F = F0; int w = F0.wave, v = F0.vcu; asm volatile("" : "+s"(w), "+s"(v)); int ln = lane_id(); F.wave = w; F.vcu = v; F.lane = ln; F.tid = w * 64 + ln; return F; }

__device__ __forceinline__ float wave_sum(float v) { v += pg8::xorl<1>(v); v += pg8::xorl<2>(v); v += pg8::xorl<4>(v); v += pg8::xorl<8>(v); v += pg8::xorl<16>(v); return pg8::sum_x32(v); }
__device__ __forceinline__ float bperm(int srclane, float v) { return __builtin_bit_cast(float, __builtin_amdgcn_ds_bpermute(srclane << 2, __builtin_bit_cast(int, v))); }
__device__ __forceinline__ float bf_lo(unsigned w) { return __uint_as_float(w << 16); }
__device__ __forceinline__ float bf_hi(unsigned w) { return __uint_as_float(w & 0xffff0000u); }
__device__ __forceinline__ float sigmoidf_(float x) { return __builtin_amdgcn_rcpf(1.0f + __builtin_amdgcn_exp2f(-LOG2E * x)); }

struct P0Item { const float* W; const float* sc; bf16* WT; int K, N, k0, n0; };
__host__ __device__ constexpr int p0_layer_items(int l) { return (l & 1) ? 32 * 128 + 32 * 64 + 32 * 256 + 128 * 64 : 32 * 160 + 32 * 64 + 32 * 256 + 128 * 64; }
__device__ __forceinline__ P0Item p0_decode(const ArgsP A, unsigned char* ws, int l, int r) {
    constexpr int I_EO = 32 * 64, I_UP = 32 * 256;
    const int hl = l >> 1, I_IN = (l & 1) ? 32 * 128 : 32 * 160; P0Item P;
    if (r < I_IN) {
        if (l & 1) { P.K = 2048; P.N = 4096; P.W = A->in[18] + (size_t)hl * 2048 * 4096; P.WT = (bf16*)(ws + WS_WOI) + (size_t)hl * 2048 * 4096; }
        else { P.K = 2048; P.N = 5120; P.W = A->in[6] + (size_t)hl * 2048 * 5120; P.WT = (bf16*)(ws + WS_WEI) + (size_t)hl * 2048 * 5120; }
        P.sc = A->in[23] + l * 2048; }
    else if ((r -= I_IN) < I_EO) { P.K = 2048; P.N = 2048; P.W = ((l & 1) ? A->in[19] : A->in[7]) + (size_t)hl * 2048 * 2048; P.WT = (bf16*)(ws + ((l & 1) ? WS_WOO : WS_WEO)) + (size_t)hl * 2048 * 2048; P.sc = nullptr; }
    else if ((r -= I_EO) < I_UP) { P.K = 2048; P.N = 8192; P.W = A->in[26] + (size_t)l * 2048 * 8192; P.WT = (bf16*)(ws + WS_WUP) + (size_t)l * 2048 * 8192; P.sc = A->in[24] + l * 2048; }
    else { r -= I_UP; P.K = 8192; P.N = 2048; P.W = A->in[27] + (size_t)l * 8192 * 2048; P.WT = (bf16*)(ws + WS_WDN) + (size_t)l * 8192 * 2048; P.sc = nullptr; }
    const int nblk = P.N / 32; P.k0 = 64 * (r / nblk); P.n0 = 32 * (r % nblk);
    return P;
}
__device__ __forceinline__ void p0_load(const P0Item& P, f32x4 (&v)[8], int lane) {
    const int kr = lane >> 3, c4 = (lane & 7) * 4;
#pragma unroll
    for (int i = 0; i < 8; ++i) v[i] = __builtin_nontemporal_load((const GAS f32x4*)(P.W + (size_t)(P.k0 + 8 * i + kr) * P.N + P.n0 + c4));
}
__device__ __forceinline__ void p0_finish(const P0Item& P, const f32x4 (&v)[8], LAS float* scr, int lane) {
    const int kr = lane >> 3, c4 = (lane & 7) * 4;
#pragma unroll
    for (int i = 0; i < 8; ++i) { const int kk = 8 * i + kr; const float s = P.sc ? P.sc[P.k0 + kk] : 1.0f; LAS float* d = scr + kk * 33 + c4; d[0] = v[i].x * s; d[1] = v[i].y * s; d[2] = v[i].z * s; d[3] = v[i].w * s; }
    LDS_WAIT(); asm volatile("" ::: "memory");
    const int c = lane & 7;
#pragma unroll
    for (int j = 0; j < 4; ++j) { const int n = (lane >> 3) + 8 * j; const LAS float* s = scr + (8 * c) * 33 + n;
        v4u o; o.x = pk2(s[0 * 33], s[1 * 33]); o.y = pk2(s[2 * 33], s[3 * 33]); o.z = pk2(s[4 * 33], s[5 * 33]); o.w = pk2(s[6 * 33], s[7 * 33]);
        __builtin_nontemporal_store(o, (GAS v4u*)(P.WT + (size_t)(P.n0 + n) * P.K + P.k0 + 8 * c)); }
    LDS_WAIT(); asm volatile("" ::: "memory");
}
__device__ __forceinline__ void p0_prologue(const Frame& F0) {
    const ArgsP A = args_ptr();
    const Frame F = phase_frame(F0);
    LAS float* scr = (LAS float*)(F.lds + F.wave * 16384);
    const int gw = F.vcu * NWAVES + F.wave, NGW = F.G * NWAVES;
    unsigned char* ws = A->ws;
    constexpr int NIT = 32 * 160 + 32 * 64;
    {
        f32x4 va[8], vb[8]; P0Item Pa, Pb;
        int it = gw;
        if (it < NIT) { Pa = p0_decode(A, ws, 0, it); p0_load(Pa, va, F.lane); }
        for (; it < NIT; it += 2 * NGW) {
            const bool hb = it + NGW < NIT;
            if (hb) { Pb = p0_decode(A, ws, 0, it + NGW); p0_load(Pb, vb, F.lane); }
            p0_finish(Pa, va, scr, F.lane);
            if (it + 2 * NGW < NIT) { Pa = p0_decode(A, ws, 0, it + 2 * NGW); p0_load(Pa, va, F.lane); }
            if (hb) p0_finish(Pb, vb, scr, F.lane);
        }
    }
    bf16* Xb = (bf16*)(ws + WS_XB); pg8::ssq_t* ssq0 = (pg8::ssq_t*)((float*)(ws + WS_CTL) + CW_SSQ);
    for (int m = gw; m < MT; m += NGW) {
        const float* src = m < SEQ ? A->in[0] + (size_t)m * DM : A->in[1] + (size_t)(m - SEQ) * DM;
        f32x4 v[8]; float s = 0.f;
#pragma unroll
        for (int j = 0; j < 8; ++j) { v[j] = ((const GAS f32x4*)src)[F.lane + 64 * j]; s += (v[j].x * v[j].x + v[j].y * v[j].y) + (v[j].z * v[j].z + v[j].w * v[j].w); }
        s = wave_sum(s);
#pragma unroll
        for (int j = 0; j < 8; ++j)
            ((GAS unsigned long long*)(Xb + (size_t)m * DM))[F.lane + 64 * j] = (unsigned long long)pk2(v[j].x, v[j].y) | ((unsigned long long)pk2(v[j].z, v[j].w) << 32);
        if (F.lane == 0) ssq0[m] = pg8::ssq_fx(s);
    }
    const int gt = gw * 64 + F.lane, NGT = NGW * 64;
    bf16* waT = (bf16*)(ws + WS_WAT); bf16* wxT = (bf16*)(ws + WS_WXT); bf16* wsb = (bf16*)(ws + WS_WSB);
    for (int idx = gt; idx < 2 * 16 * 64 * 64; idx += NGT) { const int eg = idx >> 12, j = (idx >> 6) & 63, i = idx & 63; const int src = (eg * 64 + i) * 64 + j;
        waT[idx] = (bf16)f2bf(A->in[10][src]); wxT[idx] = (bf16)f2bf(A->in[12][src]); }
    for (int idx = gt; idx < 2 * 16 * 128 * 128; idx += NGT) { const int t = (idx >> 7) & 127, s = idx & 127; wsb[idx] = s <= t ? (bf16)f2bf(A->in[21][idx]) : (bf16)0; }
}

__device__ __forceinline__ void weight_items(const Frame& F0, int l, int first, int n, int cui, int ncu) {
    const ArgsP A = args_ptr();
    const Frame F = phase_frame(F0);
    LAS float* scr = (LAS float*)(F.lds + F.wave * 16384);
    unsigned char* ws = A->ws;
    const int end = first + n, stride = ncu * NWAVES;
    f32x4 va[8], vb[8]; P0Item Pa, Pb;
    int it = first + cui * NWAVES + F.wave;
    if (it < end) { Pa = p0_decode(A, ws, l, it); p0_load(Pa, va, F.lane); }
    for (; it < end; it += 2 * stride) {
        const bool hb = it + stride < end;
        if (hb) { Pb = p0_decode(A, ws, l, it + stride); p0_load(Pb, vb, F.lane); }
        p0_finish(Pa, va, scr, F.lane);
        if (it + 2 * stride < end) { Pa = p0_decode(A, ws, l, it + 2 * stride); p0_load(Pa, va, F.lane); }
        if (hb) p0_finish(Pb, vb, scr, F.lane);
    }
}
constexpr int GE_E1 = 224, GE_O1 = 176, GE_F1 = 216;
__device__ __forceinline__ void conv_phase(const Frame& F, int kind  , int l, int cui, int ncu) {
    constexpr int IE = 32 * 160, IO = 32 * 128, IX = 32 * 64, IU = 32 * 256, ID = 128 * 64;
    int la, fa, na, nb;
    if (kind == 0) { la = l; fa = IE + IX; na = IU; nb = 0; }
    else if (kind == 1) { la = l; fa = IO; na = IX + IU + ID; nb = 0; }
    else if (!(l & 1)) { la = l; fa = IE + IX + IU; na = ID; nb = IO; }
    else { la = l; fa = 0; na = 0; nb = l < 3 ? IE + IX : 0; }
    if (na) weight_items(F, la, fa, na, cui, ncu);
    if (nb) weight_items(F, l + 1, 0, nb, cui, ncu);
}

typedef short bf16x8 __attribute__((ext_vector_type(8)));
typedef float f32x16 __attribute__((ext_vector_type(16)));
template <int PASS>
__device__ __forceinline__ void lru_tasks(const Frame& F0, int e) {
    const ArgsP A = args_ptr();
    const Frame F = phase_frame(F0);
    LAS unsigned char* wl = F.lds + F.wave * 10752;
    LAS unsigned short* xcT = (LAS unsigned short*)wl;
    LAS float* GR = (LAS float*)(wl + 2304);
    LAS float* GI = GR + 1024;
    const int lane = F.lane, j16 = lane & 15, q4 = lane >> 4;
    const int gw = F.vcu * NWAVES + F.wave, NGW = F.G * NWAVES;
    unsigned char* ws = A->ws;
    const float* XR = (const float*)(ws + WS_XR); const bf16* G = (const bf16*)(ws + WS_G); bf16* YC = (bf16*)(ws + WS_YC);
    float* CSA = (float*)(ws + WS_CS); float* CSB = CSA + 128 * 1024;
    const bf16* waT = (const bf16*)(ws + WS_WAT); const bf16* wxT = (const bf16*)(ws + WS_WXT);
    constexpr int NTASK = PASS == 1 ? 2048 : 2304;
    for (int task = gw; task < NTASK; task += NGW) {
        const bool smp = task >= 2048;
        const int g = task & 15, ci = smp ? ((task - 2048) >> 4) : (task >> 4);
        const int R0 = smp ? SEQ + 16 * ci : 64 * ci, ntile = smp ? 1 : 4, chb = 64 * g, c = chb + lane;
        const float cw0 = A->in[8][(e * 4 + 0) * 1024 + c], cw1 = A->in[8][(e * 4 + 1) * 1024 + c], cw2 = A->in[8][(e * 4 + 2) * 1024 + c], cw3 = A->in[8][(e * 4 + 3) * 1024 + c];
        const float cb = A->in[9][e * 1024 + c], ba = A->in[11][e * 1024 + c], bx = A->in[13][e * 1024 + c];
        const float nl8 = -8.0f * LOG2E * log1pf(__expf(-A->in[14][e * 1024 + c]));
        float h = 0.f;
        if (PASS == 2) {
            if (smp) h = A->in[3][(e * 16 + ci) * 1024 + c];
            else {
                const int len = (ci + 3) >> 2;
                float As[4], Bs[4]; float one_ = 1.f, zero_ = 0.f; asm volatile("" : "+v"(one_), "+v"(zero_));
#pragma unroll
                for (int q = 0; q < 4; ++q) { As[q] = one_; Bs[q] = zero_; }
                for (int j0 = 0; j0 < len; j0 += 4) {
                    float av[4][4], bv[4][4];
#pragma unroll
                    for (int dj = 0; dj < 4; ++dj)
#pragma unroll
                        for (int q = 0; q < 4; ++q) { const int jj = q * len + j0 + dj; const bool ok = j0 + dj < len && jj < ci; const int jc = ok ? jj : 0;
                            const float a = ((const GAS float*)CSA)[jc * 1024 + c], bq = ((const GAS float*)CSB)[jc * 1024 + c]; av[dj][q] = ok ? a : one_; bv[dj][q] = ok ? bq : zero_; }
#pragma unroll
                    for (int dj = 0; dj < 4; ++dj)
#pragma unroll
                        for (int q = 0; q < 4; ++q) { Bs[q] = av[dj][q] * Bs[q] + bv[dj][q]; As[q] = av[dj][q] * As[q]; }
                }
#pragma unroll
                for (int q = 0; q < 4; ++q) h = As[q] * h + Bs[q];
            }
        }
        bf16x8 waB[4][2], wxB[4][2];
#pragma unroll
        for (int n = 0; n < 4; ++n)
#pragma unroll
            for (int ks = 0; ks < 2; ++ks) { const size_t off = ((size_t)((e * 16 + g) * 64 + 16 * n + j16)) * 64 + 32 * ks + 8 * q4;
                waB[n][ks] = *(const bf16x8*)(waT + off); wxB[n][ks] = *(const bf16x8*)(wxT + off); }
        float Ac = 1.f, Bc = 0.f;
        float xv[19];
#pragma unroll
        for (int rr = 0; rr < 3; ++rr) {
            if (!smp) { const int row = R0 - 3 + rr; xv[rr] = row >= 0 ? XR[(size_t)row * 1024 + c] : 0.f; }
            else xv[rr] = A->in[2][((e * 16 + ci) * 3 + rr) * 1024 + c];
        }
#pragma unroll
        for (int rr = 0; rr < 16; ++rr) xv[3 + rr] = XR[(size_t)(R0 + rr) * 1024 + c];
        for (int ti = 0; ti < ntile; ++ti) {
            const int t0 = R0 + 16 * ti;
            float xn[16]; unsigned short gv[16];
            if (ti + 1 < ntile) {
#pragma unroll
                for (int rr = 0; rr < 16; ++rr) xn[rr] = XR[(size_t)(t0 + 16 + rr) * 1024 + c];
            }
            if (PASS == 2) {
#pragma unroll
                for (int rr = 0; rr < 16; ++rr) gv[rr] = G[(size_t)(t0 + rr) * 1024 + c];
            }
            float xc[16];
#pragma unroll
            for (int t = 0; t < 16; ++t) { xc[t] = cb + cw0 * xv[t] + cw1 * xv[t + 1] + cw2 * xv[t + 2] + cw3 * xv[t + 3]; xcT[t * 72 + lane] = (unsigned short)f2bf(xc[t]); }
            bf16x8 xa[2];
#pragma unroll
            for (int ks = 0; ks < 2; ++ks) xa[ks] = *(const LAS bf16x8*)((const LAS unsigned char*)xcT + j16 * 144 + (32 * ks + 8 * q4) * 2);
#pragma unroll
            for (int n = 0; n < 4; ++n) { const f32x4 z = {0.f, 0.f, 0.f, 0.f};
                f32x4 ra = __builtin_amdgcn_mfma_f32_16x16x32_bf16(xa[0], waB[n][0], z, 0, 0, 0); ra = __builtin_amdgcn_mfma_f32_16x16x32_bf16(xa[1], waB[n][1], ra, 0, 0, 0);
                f32x4 ia = __builtin_amdgcn_mfma_f32_16x16x32_bf16(xa[0], wxB[n][0], z, 0, 0, 0); ia = __builtin_amdgcn_mfma_f32_16x16x32_bf16(xa[1], wxB[n][1], ia, 0, 0, 0);
#pragma unroll
                for (int v = 0; v < 4; ++v) { GR[(4 * q4 + v) * 64 + 16 * n + j16] = ra[v]; GI[(4 * q4 + v) * 64 + 16 * n + j16] = ia[v]; } }
            f32x4 av[4], uv[4];
#pragma unroll
            for (int q = 0; q < 4; ++q) {
                f32x4 gr, gi, xq;
#pragma unroll
                for (int v = 0; v < 4; ++v) { gr[v] = GR[(4 * q + v) * 64 + lane]; gi[v] = GI[(4 * q + v) * 64 + lane]; xq[v] = xc[4 * q + v]; }
                gr = (gr + ba) * (-LOG2E); gi = (gi + bx) * (-LOG2E);
                f32x4 er, ei;
#pragma unroll
                for (int v = 0; v < 4; ++v) { er[v] = __builtin_amdgcn_exp2f(gr[v]); ei[v] = __builtin_amdgcn_exp2f(gi[v]); }
                er = er + 1.0f; ei = ei + 1.0f;
                f32x4 rr, ig;
#pragma unroll
                for (int v = 0; v < 4; ++v) { rr[v] = __builtin_amdgcn_rcpf(er[v]); ig[v] = __builtin_amdgcn_rcpf(ei[v]); }
                rr = rr * nl8;
                f32x4 a4;
#pragma unroll
                for (int v = 0; v < 4; ++v) a4[v] = __builtin_amdgcn_exp2f(rr[v]);
                f32x4 om = 1.0f - a4 * a4;
#pragma unroll
                for (int v = 0; v < 4; ++v) om[v] = __builtin_amdgcn_sqrtf(fmaxf(om[v], 0.f));
                av[q] = a4; uv[q] = om * ig * xq;
            }
#pragma unroll
            for (int t = 0; t < 16; ++t) {
                const float a = av[t >> 2][t & 3], uu = uv[t >> 2][t & 3];
                if (PASS == 1) { Bc = a * Bc + uu; Ac = a * Ac; }
                else { h = a * h + uu; YC[(size_t)(t0 + t) * 2048 + c] = (bf16)f2bf(__uint_as_float((unsigned)gv[t] << 16) * h); }
            }
#pragma unroll
            for (int rr = 0; rr < 3; ++rr) xv[rr] = xv[16 + rr];
            if (ti + 1 < ntile) {
#pragma unroll
                for (int rr = 0; rr < 16; ++rr) xv[3 + rr] = xn[rr];
            }
        }
        if (PASS == 1) { CSA[ci * 1024 + c] = Ac; CSB[ci * 1024 + c] = Bc; }
        else {
            if (smp) { A->out[O_SLRU + (size_t)(e * 16 + ci) * 1024 + c] = h;
#pragma unroll
                for (int rr = 0; rr < 3; ++rr) A->out[O_SCONV + (size_t)((e * 16 + ci) * 3 + rr) * 1024 + c] = xv[rr]; }
            else if (ci == 127) { A->out[O_PLRU + (size_t)e * 1024 + c] = h;
#pragma unroll
                for (int rr = 0; rr < 3; ++rr) A->out[O_PCONV + (size_t)(e * 3 + rr) * 1024 + c] = xv[rr]; }
        }
    }
}

namespace att {
constexpr int PKT = 8192, PBUF = PKT + 16384;
constexpr int KP = 144, VP = 320, KT = 64 * KP, VT = 64 * VP, BUFB = KT + VT, NBUF = 4  , LUT_OFF = NBUF * BUFB, LUT_N = 832, LUT_Z = 767;
constexpr float NEG = -1e30f;
__device__ __forceinline__ int crow(int r, int hi) { return (r & 3) + 8 * (r >> 2) + 4 * hi; }
__device__ __forceinline__ int rel_bucket(int rel) {
    const int n = rel < 0 ? -rel : rel;
    const int b = n < 8 ? n : (n < 14 ? 8 : n < 23 ? 9 : n < 39 ? 10 : n < 64 ? 11 : n < 108 ? 12 : n < 182 ? 13 : n < 305 ? 14 : 15);
    return (rel > 0 ? 16 : 0) + b;
}
typedef short v4i16_t __attribute__((ext_vector_type(4)));
__device__ __forceinline__ float max3f(float a, float b, float c) { return __builtin_fmaxf(__builtin_fmaxf(a, b), c); }
__device__ __forceinline__ v4i16_t vtr(const LAS unsigned char* p) { return __builtin_amdgcn_ds_read_tr16_b64_v4i16((LAS v4i16_t*)p); }
#define ATT_BAR() do { asm volatile("s_waitcnt lgkmcnt(0)" ::: "memory"); __builtin_amdgcn_s_barrier(); asm volatile("" ::: "memory"); } while (0)

template <bool SAMPLE>
__device__ __forceinline__ void attn_sweep(const Frame& F0, int e, int s, int h, int qi  ) {
    const ArgsP A = args_ptr();
    const Frame F = phase_frame(F0);
    LAS unsigned char* lds = F.lds;
    LAS float* lut = (LAS float*)(lds + LUT_OFF);
    const int tid = F.tid, lane = F.lane, w = F.wave, r32 = lane & 31, hi = lane >> 5;
    unsigned char* ws = A->ws;
    const bf16* Qb = (const bf16*)(ws + WS_Q); const bf16* Kb = (const bf16*)(ws + WS_KB); const bf16* Vb = (const bf16*)(ws + WS_VB);
    bf16* OS = (bf16*)(ws + WS_OS) + (size_t)s * MT * 1024;
    const float* ck = A->in[4] + (size_t)(e * 16 + qi) * 1024 * 1024; const float* cv = A->in[5] + (size_t)(e * 16 + qi) * 1024 * 1024;
    const int NT = SAMPLE ? 17 : 4 * qi + 4;
    const int tfar = SAMPLE ? 10 : (4 * qi - 6 > 0 ? 4 * qi - 6 : 0);
    const int tmax = SAMPLE ? (w == 0 ? 16 : -1) : 4 * qi + (w >> 1);
    const int grow = SAMPLE ? SEQ + 16 * qi + (r32 & 15) : 256 * qi + 32 * w + r32;
    const int qpos = SAMPLE ? 1024 + (r32 & 15) : grow;
    for (int i = tid; i < LUT_N; i += 512) lut[i] = LOG2E * A->in[17][rel_bucket(i - LUT_Z) * 8 + h];
    const float c15 = LOG2E * A->in[17][15 * 8 + h];
    bf16x8 qf[4];
#pragma unroll
    for (int d0 = 0; d0 < 4; ++d0) qf[d0] = *(const bf16x8*)(Qb + (size_t)grow * 1024 + h * 128 + s * 64 + d0 * 16 + hi * 8);
    const int kr = tid >> 3, kc = tid & 7, vr = tid >> 4, vc = tid & 15;
    struct TileRegs { v4u k, v0, v1; };
    TileRegs RA, RB;
    auto load_tile = [&](int t, TileRegs& R) __attribute__((always_inline)) {
        if (!SAMPLE) {
            R.k = *(const v4u*)(Kb + (size_t)(64 * t + kr) * 1024 + h * 128 + s * 64 + kc * 8);
            R.v0 = *(const v4u*)(Vb + (size_t)(64 * t + vr) * 1024 + h * 128 + vc * 8);
            R.v1 = *(const v4u*)(Vb + (size_t)(64 * t + vr + 32) * 1024 + h * 128 + vc * 8);
        } else if (t < 16) {
            { const float* p = ck + (size_t)(64 * t + kr) * 1024 + h * 128 + s * 64 + kc * 8; const f32x4 a = *(const f32x4*)p, b = *(const f32x4*)(p + 4);
              R.k.x = pk2(a.x, a.y); R.k.y = pk2(a.z, a.w); R.k.z = pk2(b.x, b.y); R.k.w = pk2(b.z, b.w); }
            { const float* p = cv + (size_t)(64 * t + vr) * 1024 + h * 128 + vc * 8; const f32x4 a = *(const f32x4*)p, b = *(const f32x4*)(p + 4);
              R.v0.x = pk2(a.x, a.y); R.v0.y = pk2(a.z, a.w); R.v0.z = pk2(b.x, b.y); R.v0.w = pk2(b.z, b.w); }
            { const float* p = cv + (size_t)(64 * t + vr + 32) * 1024 + h * 128 + vc * 8; const f32x4 a = *(const f32x4*)p, b = *(const f32x4*)(p + 4);
              R.v1.x = pk2(a.x, a.y); R.v1.y = pk2(a.z, a.w); R.v1.z = pk2(b.x, b.y); R.v1.w = pk2(b.z, b.w); }
        } else {
            const v4u z = {0u, 0u, 0u, 0u};
            R.k = kr < 16 ? *(const v4u*)(Kb + (size_t)(SEQ + 16 * qi + kr) * 1024 + h * 128 + s * 64 + kc * 8) : z;
            R.v0 = vr < 16 ? *(const v4u*)(Vb + (size_t)(SEQ + 16 * qi + vr) * 1024 + h * 128 + vc * 8) : z;
            R.v1 = z;
        }
    };
    auto store_tile = [&](int boff, const TileRegs& R) __attribute__((always_inline)) {
        LAS unsigned char* Kt = lds + boff; LAS unsigned char* Vt = Kt + KT;
        *(LAS v4u*)(Kt + kr * KP + kc * 16) = R.k;
        *(LAS v4u*)(Vt + vr * VP + vc * 16) = R.v0;
        *(LAS v4u*)(Vt + (vr + 32) * VP + vc * 16) = R.v1;
    };
    constexpr float THR = 8.0f;
    float m = 0.f, l = 0.f, alpha = 1.f; bool resc = false, first = true;
    bf16x8 pb[4];
    f32x16 o[4];
#pragma unroll
    for (int c = 0; c < 4; ++c)
#pragma unroll
        for (int r = 0; r < 16; ++r) o[c][r] = 0.f;
    f32x16 pA0, pA1, pB0, pB1;
    bf16x8 ka[4]; int kboff = 0;
    auto KRD = [&](int boff) __attribute__((always_inline)) {
        const LAS unsigned char* Kt = lds + boff; kboff = boff;
#pragma unroll
        for (int d0 = 0; d0 < 4; ++d0) ka[d0] = *(const LAS bf16x8*)(SAMPLE ? Kt + r32 * KP + d0 * 32 + hi * 16 : Kt + d0 * 2048 + hi * 1024 + r32 * 16);
        __builtin_amdgcn_sched_barrier(0);
    };
    auto QKM = [&](f32x16& d0_, f32x16& d1_, bool nearb) __attribute__((always_inline)) {
        const LAS unsigned char* Kt = lds + kboff;
        bf16x8 kb[4];
#pragma unroll
        for (int d0 = 0; d0 < 4; ++d0) kb[d0] = *(const LAS bf16x8*)(SAMPLE ? Kt + (32 + r32) * KP + d0 * 32 + hi * 16 : Kt + d0 * 2048 + hi * 1024 + 512 + r32 * 16);
        const float ci = (nearb ? 0.f : c15) - m;
#pragma unroll
        for (int r = 0; r < 16; ++r) { d0_[r] = ci; d1_[r] = ci; }
        __builtin_amdgcn_sched_barrier(0);
#pragma unroll
        for (int d0 = 0; d0 < 4; ++d0) d0_ = __builtin_amdgcn_mfma_f32_32x32x16_bf16(ka[d0], qf[d0], d0_, 0, 0, 0);
        __builtin_amdgcn_sched_barrier(0);
#pragma unroll
        for (int d0 = 0; d0 < 4; ++d0) d1_ = __builtin_amdgcn_mfma_f32_32x32x16_bf16(kb[d0], qf[d0], d1_, 0, 0, 0);
        __builtin_amdgcn_sched_barrier(0);
    };
    auto SMA = [&](f32x16& p0, f32x16& p1, int t, bool nearb) __attribute__((always_inline)) {
        if (nearb) {
            const LAS float* lp = lut + (64 * t - qpos + LUT_Z + 4 * hi);
#pragma unroll
            for (int r = 0; r < 16; ++r) { p0[r] += lp[(r & 3) + 8 * (r >> 2)]; p1[r] += lp[32 + (r & 3) + 8 * (r >> 2)]; }
            if (SAMPLE && t == 16) {
#pragma unroll
                for (int r = 0; r < 16; ++r) { if (r >= 8) p0[r] = NEG; p1[r] = NEG; }
            }
        }
        float mx = max3f(p0[0], p0[1], p1[0]), mx2 = max3f(p0[2], p0[3], p1[1]);
#pragma unroll
        for (int r = 2; r < 8; ++r) { mx = max3f(mx, p0[2 * r], p0[2 * r + 1]); mx2 = max3f(mx2, p1[2 * r], p1[2 * r + 1]); }
        mx = max3f(mx, p1[2], p1[3]); mx = fmaxf(mx, mx2);
        mx = pg8::max_x32(mx);
        const bool upd = first || (mx > THR);
        const float delta = upd ? mx : 0.f;
        m += delta; alpha = (upd && !first) ? __builtin_amdgcn_exp2f(-delta) : 1.f;
        first = false;
        resc = __any(upd);
        if (resc) {
#pragma unroll
            for (int r = 0; r < 16; ++r) { p0[r] -= delta; p1[r] -= delta; }
        }
        __builtin_amdgcn_sched_barrier(0);
    };
    auto SMB = [&](f32x16& p0, f32x16& p1) __attribute__((always_inline)) {
        float rsum = 0.f;
#pragma unroll
        for (int r = 0; r < 16; ++r) { p0[r] = __builtin_amdgcn_exp2f(p0[r]); p1[r] = __builtin_amdgcn_exp2f(p1[r]); rsum += p0[r] + p1[r]; }
        rsum = pg8::sum_x32(rsum);
        l = l * alpha + rsum;
        v4u w0, w1, w2, w3;
        w0.x = pk2(p0[0], p0[1]); w0.y = pk2(p0[2], p0[3]); w0.z = pk2(p0[4], p0[5]); w0.w = pk2(p0[6], p0[7]);
        w1.x = pk2(p0[8], p0[9]); w1.y = pk2(p0[10], p0[11]); w1.z = pk2(p0[12], p0[13]); w1.w = pk2(p0[14], p0[15]);
        w2.x = pk2(p1[0], p1[1]); w2.y = pk2(p1[2], p1[3]); w2.z = pk2(p1[4], p1[5]); w2.w = pk2(p1[6], p1[7]);
        w3.x = pk2(p1[8], p1[9]); w3.y = pk2(p1[10], p1[11]); w3.z = pk2(p1[12], p1[13]); w3.w = pk2(p1[14], p1[15]);
        pb[0] = __builtin_bit_cast(bf16x8, w0); pb[1] = __builtin_bit_cast(bf16x8, w1); pb[2] = __builtin_bit_cast(bf16x8, w2); pb[3] = __builtin_bit_cast(bf16x8, w3);
    };
    auto PV = [&](int boff) __attribute__((always_inline)) {
        const LAS unsigned char* Vt = lds + boff + (SAMPLE ? KT : PKT);
        if (resc) {
#pragma unroll
            for (int c = 0; c < 4; ++c)
#pragma unroll
                for (int r = 0; r < 16; ++r) o[c][r] *= alpha;
        }
        const LAS unsigned char* vb = Vt + (4 * hi + ((lane & 15) >> 2)) * (SAMPLE ? VP : 64) + ((lane >> 4) & 1) * 32 + (lane & 3) * 8;
        bf16x8 vfa[4], vfb[4];
#define ATT_RDV(dst, s4) do { _Pragma("unroll") for (int c = 0; c < 4; ++c) { const v4i16_t lo = vtr(SAMPLE ? vb + (16 * (s4)) * VP + 64 * c : vb + (s4) * 1024 + c * 4096), hh = vtr(SAMPLE ? vb + (16 * (s4) + 8) * VP + 64 * c : vb + (s4) * 1024 + 512 + c * 4096); \
            dst[c] = (bf16x8){lo[0], lo[1], lo[2], lo[3], hh[0], hh[1], hh[2], hh[3]}; } } while (0)
#define ATT_PV(src, s4) do { _Pragma("unroll") for (int c = 0; c < 4; ++c) o[c] = __builtin_amdgcn_mfma_f32_32x32x16_bf16(src[c], pb[s4], o[c], 0, 0, 0); } while (0)
        ATT_RDV(vfa, 0); ATT_RDV(vfb, 1); __builtin_amdgcn_sched_barrier(0);
        ATT_PV(vfa, 0); __builtin_amdgcn_sched_barrier(0);
        ATT_RDV(vfa, 2); __builtin_amdgcn_sched_barrier(0);
        ATT_PV(vfb, 1); __builtin_amdgcn_sched_barrier(0);
        ATT_RDV(vfb, 3); __builtin_amdgcn_sched_barrier(0);
        ATT_PV(vfa, 2); __builtin_amdgcn_sched_barrier(0);
        ATT_PV(vfb, 3); __builtin_amdgcn_sched_barrier(0);
#undef ATT_RDV
#undef ATT_PV
    };
    if (!SAMPLE) {
        const unsigned offK = (unsigned)(lane * 2048 + (h * 128 + s * 64 + w * 8) * 2);
        const unsigned offV = (unsigned)((16 * (w & 3) + (lane >> 2)) * 2048 + (h * 128 + (w >> 2) * 32 + (lane & 3) * 8) * 2);
        const unsigned offV2 = offV + 128u;
        const unsigned lds0 = (unsigned)(uintptr_t)lds;
        const unsigned dK = (unsigned)__builtin_amdgcn_readfirstlane((int)(lds0 + (unsigned)(w * 1024))), dV = (unsigned)__builtin_amdgcn_readfirstlane((int)(lds0 + (unsigned)(PKT + w * 1024)));
        auto dma_tile = [&](int t, int boff) __attribute__((always_inline)) {
            unsigned keep; const char* kb_ = (const char*)Kb + (size_t)t * 131072; const char* vb_ = (const char*)Vb + (size_t)t * 131072;
            asm volatile("s_mov_b32 %0, m0\n\t"
                         "s_mov_b32 m0, %3\n\ts_nop 0\n\tglobal_load_lds_dwordx4 %1, %6\n\t"
                         "s_mov_b32 m0, %4\n\ts_nop 0\n\tglobal_load_lds_dwordx4 %2, %7\n\t"
                         "s_mov_b32 m0, %5\n\ts_nop 0\n\tglobal_load_lds_dwordx4 %8, %7\n\t"
                         "s_mov_b32 m0, %0"
                         : "=&s"(keep) : "v"(offK), "v"(offV), "s"(dK + (unsigned)boff), "s"(dV + (unsigned)boff), "s"(dV + (unsigned)boff + 8192u), "s"(kb_), "s"(vb_), "v"(offV2) : "memory");
        };
        dma_tile(0, 0); dma_tile(1, PBUF); dma_tile(2, 2 * PBUF);
        asm volatile("s_waitcnt vmcnt(3)" ::: "memory");
        ATT_BAR();
        int bcur = 0, bnx = PBUF, bdma = 3 * PBUF;
#define ATT_DMA(t) do { if ((t) + 3 < NT) dma_tile((t) + 3, bdma); } while (0)
#define ATT_END(t) do { if ((t) + 3 < NT) asm volatile("s_waitcnt vmcnt(3)" ::: "memory"); else asm volatile("s_waitcnt vmcnt(0)" ::: "memory"); \
        ATT_BAR(); bcur = bnx; bnx = bnx == 3 * PBUF ? 0 : bnx + PBUF; bdma = bdma == 3 * PBUF ? 0 : bdma + PBUF; } while (0)
        auto NEARADD = [&](f32x16& p0, f32x16& p1, int t) __attribute__((always_inline)) {
            const LAS float* lp = lut + (64 * t - qpos + LUT_Z + 4 * hi);
#pragma unroll
            for (int r = 0; r < 16; ++r) { p0[r] += lp[(r & 3) + 8 * (r >> 2)]; p1[r] += lp[32 + (r & 3) + 8 * (r >> 2)]; }
            __builtin_amdgcn_sched_barrier(0);
        };
        auto ROWMAX = [&](const f32x16& p0, const f32x16& p1) __attribute__((always_inline)) -> float {
            float mx = max3f(p0[0], p0[1], p1[0]), mx2 = max3f(p0[2], p0[3], p1[1]);
#pragma unroll
            for (int r = 2; r < 8; ++r) { mx = max3f(mx, p0[2 * r], p0[2 * r + 1]); mx2 = max3f(mx2, p1[2 * r], p1[2 * r + 1]); }
            mx = max3f(mx, p1[2], p1[3]); return fmaxf(mx, mx2);
        };
        auto REFUPD = [&](f32x16& p0, f32x16& p1, float mx) __attribute__((always_inline)) {
            mx = pg8::max_x32(mx);
            const bool upd = first || (mx > THR);
            const float delta = upd ? mx : 0.f;
            m += delta; alpha = (upd && !first) ? __builtin_amdgcn_exp2f(-delta) : 1.f;
            first = false;
            if (__any(upd)) {
#pragma unroll
                for (int r = 0; r < 16; ++r) { p0[r] -= delta; p1[r] -= delta; }
#pragma unroll
                for (int c = 0; c < 4; ++c)
#pragma unroll
                    for (int r = 0; r < 16; ++r) o[c][r] *= alpha;
            }
            __builtin_amdgcn_sched_barrier(0);
        };
        auto B1 = [&](f32x16& n0, f32x16& n1, bool nearn, f32x16& c0, f32x16& c1) __attribute__((always_inline)) {
            const LAS unsigned char* Kt = lds + kboff;
            bf16x8 kb[4];
#pragma unroll
            for (int d0 = 0; d0 < 4; ++d0) kb[d0] = *(const LAS bf16x8*)(SAMPLE ? Kt + (32 + r32) * KP + d0 * 32 + hi * 16 : Kt + d0 * 2048 + hi * 1024 + 512 + r32 * 16);
            const float ci = (nearn ? 0.f : c15) - m;
#pragma unroll
            for (int r = 0; r < 16; ++r) { n0[r] = ci; n1[r] = ci; }
            __builtin_amdgcn_sched_barrier(0);
            float rs0 = 0.f, rs1 = 0.f; unsigned wq[16];
#define ATT_CH(i, MF) do { MF; \
            c0[2 * (i)] = __builtin_amdgcn_exp2f(c0[2 * (i)]); c0[2 * (i) + 1] = __builtin_amdgcn_exp2f(c0[2 * (i) + 1]); c1[2 * (i)] = __builtin_amdgcn_exp2f(c1[2 * (i)]); c1[2 * (i) + 1] = __builtin_amdgcn_exp2f(c1[2 * (i) + 1]); \
            rs0 += c0[2 * (i)] + c0[2 * (i) + 1]; rs1 += c1[2 * (i)] + c1[2 * (i) + 1]; \
            wq[(i)] = pk2(c0[2 * (i)], c0[2 * (i) + 1]); wq[8 + (i)] = pk2(c1[2 * (i)], c1[2 * (i) + 1]); \
            __builtin_amdgcn_sched_barrier(0); } while (0)
            ATT_CH(0, n0 = __builtin_amdgcn_mfma_f32_32x32x16_bf16(ka[0], qf[0], n0, 0, 0, 0));
            ATT_CH(1, n0 = __builtin_amdgcn_mfma_f32_32x32x16_bf16(ka[1], qf[1], n0, 0, 0, 0));
            ATT_CH(2, n0 = __builtin_amdgcn_mfma_f32_32x32x16_bf16(ka[2], qf[2], n0, 0, 0, 0));
            ATT_CH(3, n0 = __builtin_amdgcn_mfma_f32_32x32x16_bf16(ka[3], qf[3], n0, 0, 0, 0));
            ATT_CH(4, n1 = __builtin_amdgcn_mfma_f32_32x32x16_bf16(kb[0], qf[0], n1, 0, 0, 0));
            ATT_CH(5, n1 = __builtin_amdgcn_mfma_f32_32x32x16_bf16(kb[1], qf[1], n1, 0, 0, 0));
            ATT_CH(6, n1 = __builtin_amdgcn_mfma_f32_32x32x16_bf16(kb[2], qf[2], n1, 0, 0, 0));
            ATT_CH(7, n1 = __builtin_amdgcn_mfma_f32_32x32x16_bf16(kb[3], qf[3], n1, 0, 0, 0));
#undef ATT_CH
            const float rsum = pg8::sum_x32(rs0 + rs1);
            l = l * alpha + rsum;
            { const v4u w0 = {wq[0], wq[1], wq[2], wq[3]}, w1 = {wq[4], wq[5], wq[6], wq[7]}, w2 = {wq[8], wq[9], wq[10], wq[11]}, w3 = {wq[12], wq[13], wq[14], wq[15]};
              pb[0] = __builtin_bit_cast(bf16x8, w0); pb[1] = __builtin_bit_cast(bf16x8, w1); pb[2] = __builtin_bit_cast(bf16x8, w2); pb[3] = __builtin_bit_cast(bf16x8, w3); }
            __builtin_amdgcn_sched_barrier(0);
        };
        auto B2 = [&](int boff, const f32x16& n0, const f32x16& n1) __attribute__((always_inline)) -> float {
            const LAS unsigned char* vb = lds + boff + PKT + (4 * hi + ((lane & 15) >> 2)) * 64 + ((lane >> 4) & 1) * 32 + (lane & 3) * 8;
            bf16x8 vfa[4], vfb[4];
#define ATT_RDV(dst, s4) do { _Pragma("unroll") for (int c = 0; c < 4; ++c) { const v4i16_t lo = vtr(vb + (s4) * 1024 + c * 4096), hh = vtr(vb + (s4) * 1024 + 512 + c * 4096); \
            dst[c] = (bf16x8){lo[0], lo[1], lo[2], lo[3], hh[0], hh[1], hh[2], hh[3]}; } } while (0)
#define ATT_PV(src, s4) do { _Pragma("unroll") for (int c = 0; c < 4; ++c) o[c] = __builtin_amdgcn_mfma_f32_32x32x16_bf16(src[c], pb[s4], o[c], 0, 0, 0); } while (0)
            ATT_RDV(vfa, 0); ATT_RDV(vfb, 1);
            ATT_PV(vfa, 0); ATT_RDV(vfa, 2); ATT_PV(vfb, 1); ATT_RDV(vfb, 3); ATT_PV(vfa, 2); ATT_PV(vfb, 3);
            const float mx = ROWMAX(n0, n1);
            __builtin_amdgcn_sched_group_barrier(0x100, 16, 0);
#pragma unroll
            for (int i = 0; i < 8; ++i) { __builtin_amdgcn_sched_group_barrier(0x008, 1, 0); __builtin_amdgcn_sched_group_barrier(0x100, 2, 0); __builtin_amdgcn_sched_group_barrier(0x002, 2, 0); }
#pragma unroll
            for (int i = 0; i < 8; ++i) { __builtin_amdgcn_sched_group_barrier(0x008, 1, 0); __builtin_amdgcn_sched_group_barrier(0x002, 2, 0); }
            __builtin_amdgcn_sched_barrier(0);
#undef ATT_RDV
#undef ATT_PV
            return mx;
        };
#define ATT_STEP(t, C0, C1, N0, N1) do { ATT_DMA(t); KRD(bnx); \
        B1(N0, N1, (t) + 1 >= tfar, C0, C1); \
        if ((t) + 1 >= tfar) NEARADD(N0, N1, (t) + 1); \
        { const float mx_ = B2(bcur, N0, N1); REFUPD(N0, N1, mx_); } \
        ATT_END(t); } while (0)
        KRD(0); QKM(pA0, pA1, tfar == 0);
        if (0 >= tfar) NEARADD(pA0, pA1, 0);
        { const float mx_ = ROWMAX(pA0, pA1); REFUPD(pA0, pA1, mx_); }
        int t = 0;
#define ATT_STEPC(t, C0, C1, N0, N1, BC, BN, BD) do { dma_tile((t) + 3, BD); KRD(BN); \
        B1(N0, N1, (t) + 1 >= tfar, C0, C1); \
        if ((t) + 1 >= tfar) NEARADD(N0, N1, (t) + 1); \
        { const float mx_ = B2(BC, N0, N1); REFUPD(N0, N1, mx_); } \
        asm volatile("s_waitcnt vmcnt(3)" ::: "memory"); ATT_BAR(); } while (0)
        for (; t + 6 < NT && t + 3 < tmax; t += 4) {
            ATT_STEPC(t, pA0, pA1, pB0, pB1, 0, PBUF, 3 * PBUF); ATT_STEPC(t + 1, pB0, pB1, pA0, pA1, PBUF, 2 * PBUF, 0);
            ATT_STEPC(t + 2, pA0, pA1, pB0, pB1, 2 * PBUF, 3 * PBUF, PBUF); ATT_STEPC(t + 3, pB0, pB1, pA0, pA1, 3 * PBUF, 0, 2 * PBUF);
        }
#undef ATT_STEPC
        for (; t + 1 < tmax; t += 2) { ATT_STEP(t, pA0, pA1, pB0, pB1); ATT_STEP(t + 1, pB0, pB1, pA0, pA1); }
        if (t < tmax) { ATT_STEP(t, pA0, pA1, pB0, pB1); ATT_DMA(tmax); SMB(pB0, pB1); PV(bcur); ATT_END(tmax); }
        else { ATT_DMA(tmax); SMB(pA0, pA1); PV(bcur); ATT_END(tmax); }
        for (int ti = tmax + 1; ti < NT; ++ti) { asm volatile("s_waitcnt vmcnt(0)" ::: "memory"); ATT_BAR(); }
#undef ATT_STEP
#undef ATT_DMA
#undef ATT_END
    } else if (w == 0) {
        ATT_BAR();
        int bcur = 0, bnx = BUFB, bst = 2 * BUFB;
        KRD(0); QKM(pA0, pA1, false);
#define ATT_SIT(t, C0, C1, N0, N1) do { const bool on_ = (t) < 17, onn_ = (t) + 1 < 17; \
        if (onn_) KRD(bnx); \
        if (on_) SMA(C0, C1, (t), (t) >= tfar); \
        if (onn_) QKM(N0, N1, (t) + 1 >= tfar); \
        if (on_) { SMB(C0, C1); PV(bcur); } \
        ATT_BAR(); { const int x_ = bcur; bcur = bnx; bnx = bst; bst = x_; } } while (0)
        for (int t = 0; t < 18; t += 2) { ATT_SIT(t, pA0, pA1, pB0, pB1); ATT_SIT(t + 1, pB0, pB1, pA0, pA1); }
#undef ATT_SIT
    } else {
        const int lt = tid - 64;
        struct Chunk { f32x4 a, b; };
        Chunk S0[4], S1[4], S2[4];
        auto ldt = [&](int t, Chunk (&S)[4]) __attribute__((always_inline)) {
#pragma unroll
            for (int i = 0; i < 4; ++i) { const int c = lt + 448 * i;
                if (c < 1536) {
                    const bool isk = c < 512; const int cc = isk ? c : c - 512, row = isk ? cc >> 3 : cc >> 4, col = isk ? s * 64 + (cc & 7) * 8 : (cc & 15) * 8;
                    if (t < 16) { const float* p = (isk ? ck : cv) + (size_t)(64 * t + row) * 1024 + h * 128 + col; S[i].a = *(const f32x4*)p; S[i].b = *(const f32x4*)(p + 4); }
                    else {
                        const v4u z = {0u, 0u, 0u, 0u};
                        const v4u r = row < 16 ? *(const v4u*)((isk ? Kb : Vb) + (size_t)(SEQ + 16 * qi + row) * 1024 + h * 128 + col) : z;
                        S[i].a = (f32x4){bf_lo(r.x), bf_hi(r.x), bf_lo(r.y), bf_hi(r.y)}; S[i].b = (f32x4){bf_lo(r.z), bf_hi(r.z), bf_lo(r.w), bf_hi(r.w)}; }
                } }
        };
        auto stt = [&](int boff, const Chunk (&S)[4]) __attribute__((always_inline)) {
#pragma unroll
            for (int i = 0; i < 4; ++i) { const int c = lt + 448 * i;
                if (c < 1536) {
                    const bool isk = c < 512; const int cc = isk ? c : c - 512;
                    v4u wv; wv.x = pk2(S[i].a.x, S[i].a.y); wv.y = pk2(S[i].a.z, S[i].a.w); wv.z = pk2(S[i].b.x, S[i].b.y); wv.w = pk2(S[i].b.z, S[i].b.w);
                    LAS unsigned char* dst = isk ? lds + boff + (cc >> 3) * KP + (cc & 7) * 16 : lds + boff + KT + (cc >> 4) * VP + (cc & 15) * 16;
                    *(LAS v4u*)dst = wv; } }
        };
        ldt(0, S0); ldt(1, S1); ldt(2, S2);
        stt(0, S0); ldt(3, S0);
        stt(BUFB, S1); ldt(4, S1);
        ATT_BAR();
        int bst = 2 * BUFB;
#define ATT_LIT(t, S) do { if ((t) + 2 < 17) { stt(bst, S); if ((t) + 5 < 17) ldt((t) + 5, S); } ATT_BAR(); bst = bst == 2 * BUFB ? 0 : bst + BUFB; } while (0)
        for (int t = 0; t < 18; t += 3) { ATT_LIT(t, S2); ATT_LIT(t + 1, S0); ATT_LIT(t + 2, S1); }
#undef ATT_LIT
    }
    if (tmax >= 0) {
        const float inv = 1.0f / l;
        LAS float* ot = (LAS float*)(lds + w * 8704);
        const int rowbase = SAMPLE ? SEQ + 16 * qi : 256 * qi + 32 * w;
#pragma unroll
        for (int half = 0; half < 2; ++half) {
#pragma unroll
            for (int cc = 0; cc < 2; ++cc)
#pragma unroll
                for (int r = 0; r < 16; ++r) ot[r32 * 68 + 32 * cc + crow(r, hi)] = o[2 * half + cc][r] * inv;
#pragma unroll
            for (int j = 0; j < 4; ++j) { const int id = lane + 64 * j, row = id >> 3, chn = id & 7;
                const f32x4 va = *(const LAS f32x4*)(ot + row * 68 + chn * 8), vb2 = *(const LAS f32x4*)(ot + row * 68 + chn * 8 + 4);
                v4u wv; wv.x = pk2(va.x, va.y); wv.y = pk2(va.z, va.w); wv.z = pk2(vb2.x, vb2.y); wv.w = pk2(vb2.z, vb2.w);
                if (!SAMPLE || row < 16) *(v4u*)(OS + (size_t)(rowbase + row) * 1024 + h * 128 + half * 64 + chn * 8) = wv; }
        }
    }
    ATT_BAR();
}
#undef ATT_BAR
}

__device__ __forceinline__ void attn_combine(const Frame& F0, int e0) {
    const ArgsP A = args_ptr();
    int e = e0; asm volatile("" : "+s"(e));
    const float lam_init = e == 0 ? 0.2f : 0.47071302f;
    const Frame F = phase_frame(F0);
    const int lane = F.lane, gw = F.vcu * NWAVES + F.wave, NGW = F.G * NWAVES;
    const float* lv = A->in[15] + e * 256;
    const float s1 = wave_sum(lv[lane] * lv[64 + lane]), s2 = wave_sum(lv[128 + lane] * lv[192 + lane]);
    const float lam = __expf(s1) - __expf(s2) + lam_init;
    const bf16* OS0 = (const bf16*)(A->ws + WS_OS); const bf16* OS1 = OS0 + (size_t)MT * 1024; bf16* YC = (bf16*)(A->ws + WS_YC);
    const int hd = lane >> 3, d0 = (lane & 7) * 16;
    f32x4 sw[4];
#pragma unroll
    for (int j = 0; j < 4; ++j) sw[j] = *(const f32x4*)(A->in[16] + e * 128 + d0 + 4 * j);
    for (int row0 = gw; row0 < MT; row0 += 5 * NGW) {
        v4u ra[5][2], rb[5][2];
#pragma unroll
        for (int k = 0; k < 5; ++k) { const int row = row0 + k * NGW;
            if (row < MT) { const size_t off = (size_t)row * 1024 + hd * 128 + d0;
#pragma unroll
                for (int j = 0; j < 2; ++j) { ra[k][j] = *(const GAS v4u*)(OS0 + off + 8 * j); rb[k][j] = *(const GAS v4u*)(OS1 + off + 8 * j); } } }
#pragma unroll
        for (int k = 0; k < 5; ++k) { const int row = row0 + k * NGW;
            if (row < MT) {
                f32x4 d[4]; float q = 0.f;
#pragma unroll
                for (int j = 0; j < 2; ++j) { const v4u xa = ra[k][j], xb = rb[k][j];
                    const f32x4 a0 = {bf_lo(xa.x), bf_hi(xa.x), bf_lo(xa.y), bf_hi(xa.y)}, a1 = {bf_lo(xa.z), bf_hi(xa.z), bf_lo(xa.w), bf_hi(xa.w)};
                    const f32x4 b0 = {bf_lo(xb.x), bf_hi(xb.x), bf_lo(xb.y), bf_hi(xb.y)}, b1 = {bf_lo(xb.z), bf_hi(xb.z), bf_lo(xb.w), bf_hi(xb.w)};
                    d[2 * j] = a0 - lam * b0; d[2 * j + 1] = a1 - lam * b1; }
#pragma unroll
                for (int j = 0; j < 4; ++j) q += (d[j].x * d[j].x + d[j].y * d[j].y) + (d[j].z * d[j].z + d[j].w * d[j].w);
                q += pg8::xorl<1>(q); q += pg8::xorl<2>(q); q += pg8::xorl<4>(q);
                const float sc = __builtin_amdgcn_rsqf(q * (1.0f / 128.0f) + RMS_EPS) * (1.0f - lam_init);
                v4u w0, w1;
                { const f32x4 a = d[0] * sw[0] * sc, b = d[1] * sw[1] * sc; w0.x = pk2(a.x, a.y); w0.y = pk2(a.z, a.w); w0.z = pk2(b.x, b.y); w0.w = pk2(b.z, b.w); }
                { const f32x4 a = d[2] * sw[2] * sc, b = d[3] * sw[3] * sc; w1.x = pk2(a.x, a.y); w1.y = pk2(a.z, a.w); w1.z = pk2(b.x, b.y); w1.w = pk2(b.z, b.w); }
                bf16* yp = YC + (size_t)row * 2048 + 1024 + hd * 128 + d0;
                *(GAS v4u*)yp = w0; *(GAS v4u*)(yp + 8) = w1; } }
    }
}

__device__ __forceinline__ void gmlp_phase(const Frame& F0, int o) {
    const ArgsP A = args_ptr();
    const Frame F = phase_frame(F0);
    constexpr int VP = 320, VBUF = 128 * VP;
    constexpr int MP = 272, MOFF = 2 * VBUF;
    const int tid = F.tid, lane = F.lane, w = F.wave, r32 = lane & 31, hi = lane >> 5;
    unsigned char* ws = A->ws;
    const bf16* U = (const bf16*)(ws + WS_U); const bf16* VR = (const bf16*)(ws + WS_VR); bf16* YC = (bf16*)(ws + WS_YC);
    const bf16* wsb = (const bf16*)(ws + WS_WSB);
    const pg8::ssq_t* ssqv = (const pg8::ssq_t*)((const float*)(ws + WS_CTL) + CW_SSQ) + (9 + o) * MT;
    const float* vnw = A->in[20] + o * 2048; const float* bs = A->in[22] + o * 16 * 128;
    const int tb = w & 3, chh = w >> 2, ch = tid & 15;
    LAS unsigned char* Mt = F.lds + MOFF;
    bf16x8 af[8]; float bsv[16]; f32x4 n0, n1; int gcur = -1;
    v4u rawA[4], urawA[4], rawB[4], urawB[4]; pg8::ssq_t rqA[4], rqB[4];
    auto prefetch = [&](int u, v4u (&raw)[4], v4u (&uraw)[4], pg8::ssq_t (&rq)[4]) __attribute__((always_inline)) {
        const bool smp = u >= 1024; const int g = u & 15;
        const int R0 = smp ? SEQ + 16 * ((u - 1024) >> 4) : 128 * (u >> 4), nrows = smp ? 16 : 128;
#pragma unroll
        for (int i = 0; i < 4; ++i) { const int row = (tid + 512 * i) >> 4;
            if (row < nrows) { const size_t grow = (size_t)(R0 + row); raw[i] = *(const GAS v4u*)(VR + grow * 2048 + 128 * g + ch * 8); uraw[i] = *(const GAS v4u*)(U + grow * 2048 + 128 * g + ch * 8); rq[i] = *(const GAS pg8::ssq_t*)(ssqv + grow); } }
    };
    auto unit = [&](int u, int k, v4u (&raw)[4], v4u (&uraw)[4], pg8::ssq_t (&rq)[4]) __attribute__((always_inline)) {
        const bool smp = u >= 1024; const int g = u & 15;
        const int R0 = smp ? SEQ + 16 * ((u - 1024) >> 4) : 128 * (u >> 4), nrows = smp ? 16 : 128;
        LAS unsigned char* Vt = F.lds + (k & 1) * VBUF;
        if (g != gcur) {
            gcur = g;
            const bf16* arow = wsb + ((size_t)(o * 16 + g) * 128 + 32 * tb + r32) * 128 + 8 * hi;
#pragma unroll
            for (int ks = 0; ks < 8; ++ks) af[ks] = *(const bf16x8*)(arow + 16 * ks);
#pragma unroll
            for (int r = 0; r < 16; ++r) bsv[r] = bs[g * 128 + 32 * tb + att::crow(r, hi)];
            n0 = *(const f32x4*)(vnw + 128 * g + ch * 8); n1 = *(const f32x4*)(vnw + 128 * g + ch * 8 + 4);
        }
#pragma unroll
        for (int i = 0; i < 4; ++i) { const int row = (tid + 512 * i) >> 4; v4u wv = {0u, 0u, 0u, 0u};
            if (row < nrows) { const size_t grow = (size_t)(R0 + row); const float rs = pg8::ssq_rstd(rq[i]);
                f32x4 a = {bf_lo(raw[i].x), bf_hi(raw[i].x), bf_lo(raw[i].y), bf_hi(raw[i].y)}, b = {bf_lo(raw[i].z), bf_hi(raw[i].z), bf_lo(raw[i].w), bf_hi(raw[i].w)};
                a = a * rs * n0; b = b * rs * n1;
                if (smp) { float* gv = A->out + O_SGV + ((size_t)o * NSMP + (grow - SEQ)) * 2048 + 128 * g + ch * 8; *(f32x4*)gv = a; *(f32x4*)(gv + 4) = b; }
                wv.x = pk2(a.x, a.y); wv.y = pk2(a.z, a.w); wv.z = pk2(b.x, b.y); wv.w = pk2(b.z, b.w); }
            *(LAS v4u*)(Vt + row * VP + ch * 16) = wv; }
        __syncthreads();
        if (!smp || tb == 0) {
            const LAS unsigned char* vb = Vt + (8 * hi + ((lane & 15) >> 2)) * VP + ((lane >> 4) & 1) * 32 + (lane & 3) * 8;
#pragma unroll
            for (int nn = 0; nn < 2; ++nn) { const int cb = chh * 2 + nn;
                bf16x8 bfr[8];
#pragma unroll
                for (int ks = 0; ks < 8; ++ks) { const att::v4i16_t lo = att::vtr(vb + (16 * ks) * VP + 64 * cb), hh = att::vtr(vb + (16 * ks + 4) * VP + 64 * cb);
                    bfr[ks] = (bf16x8){lo[0], lo[1], lo[2], lo[3], hh[0], hh[1], hh[2], hh[3]}; }
                f32x16 acc;
#pragma unroll
                for (int r = 0; r < 16; ++r) acc[r] = 0.f;
#pragma unroll
                for (int ks = 0; ks < 8; ++ks) acc = __builtin_amdgcn_mfma_f32_32x32x16_bf16(af[ks], bfr[ks], acc, 0, 0, 0);
#pragma unroll
                for (int r = 0; r < 16; ++r) { const int t = 32 * tb + att::crow(r, hi);
                    *(LAS unsigned short*)(Mt + t * MP + (32 * cb + r32) * 2) = (unsigned short)f2bf(acc[r] + bsv[r]); }
            }
        }
        __syncthreads();
#pragma unroll
        for (int i = 0; i < 4; ++i) { const int row = (tid + 512 * i) >> 4;
            if (row < nrows) { const size_t grow = (size_t)(R0 + row); const v4u mx = *(const LAS v4u*)(Mt + row * MP + ch * 16);
                v4u wv;
                wv.x = pk2(bf_lo(uraw[i].x) * bf_lo(mx.x), bf_hi(uraw[i].x) * bf_hi(mx.x)); wv.y = pk2(bf_lo(uraw[i].y) * bf_lo(mx.y), bf_hi(uraw[i].y) * bf_hi(mx.y));
                wv.z = pk2(bf_lo(uraw[i].z) * bf_lo(mx.z), bf_hi(uraw[i].z) * bf_hi(mx.z)); wv.w = pk2(bf_lo(uraw[i].w) * bf_lo(mx.w), bf_hi(uraw[i].w) * bf_hi(mx.w));
                *(v4u*)(YC + grow * 2048 + 128 * g + ch * 8) = wv; } }
            if (u + 2 * F.G < 1280) prefetch(u + 2 * F.G, raw, uraw, rq);
    };
    if (F.vcu < 1280) prefetch(F.vcu, rawA, urawA, rqA);
    if (F.vcu + F.G < 1280) prefetch(F.vcu + F.G, rawB, urawB, rqB);
    for (int u = F.vcu, k = 0; u < 1280; u += 2 * F.G, k += 2) {
        unit(u, k, rawA, urawA, rqA);
        if (u + F.G < 1280) unit(u + F.G, k + 1, rawB, urawB, rqB);
    }
    __syncthreads();
}

__device__ __forceinline__ void final_norm(const Frame& F0) {
    const ArgsP A = args_ptr();
    const Frame F = phase_frame(F0);
    const int gw = F.vcu * NWAVES + F.wave, NGW = F.G * NWAVES;
    const bf16* Xb = (const bf16*)(A->ws + WS_XB); const pg8::ssq_t* ssq = (const pg8::ssq_t*)((const float*)(A->ws + WS_CTL) + CW_SSQ) + 8 * MT;
    f32x4 wv[8];
#pragma unroll
    for (int j = 0; j < 4; ++j) { wv[2 * j] = ((const f32x4*)A->in[25])[2 * (F.lane + 64 * j)]; wv[2 * j + 1] = ((const f32x4*)A->in[25])[2 * (F.lane + 64 * j) + 1]; }
    for (int m = gw; m < SEQ; m += NGW) {
        const float rs = pg8::ssq_rstd(ssq[m]);
        float* dst = A->out + O_YP + (size_t)m * DM;
        v4u rr[4];
#pragma unroll
        for (int j = 0; j < 4; ++j) rr[j] = ((const GAS v4u*)(Xb + (size_t)m * DM))[F.lane + 64 * j];
#pragma unroll
        for (int j = 0; j < 4; ++j) { const v4u r = rr[j];
            const f32x4 a = {bf_lo(r.x), bf_hi(r.x), bf_lo(r.y), bf_hi(r.y)}, b = {bf_lo(r.z), bf_hi(r.z), bf_lo(r.w), bf_hi(r.w)};
            ((f32x4*)dst)[2 * (F.lane + 64 * j)] = a * rs * wv[2 * j]; ((f32x4*)dst)[2 * (F.lane + 64 * j) + 1] = b * rs * wv[2 * j + 1]; }
    }
}

__device__ __forceinline__ void resid_finalize(const Frame& F0, int nsplit, int ssq_idx) {
    const ArgsP A = args_ptr();
    const Frame F = phase_frame(F0);
    unsigned char* ws = A->ws;
    const float* slab = (const float*)(ws + WS_SLAB); bf16* Xb = (bf16*)(ws + WS_XB); pg8::ssq_t* ssq = (pg8::ssq_t*)((float*)(ws + WS_CTL) + CW_SSQ) + (size_t)ssq_idx * MT;
    LAS float* red = (LAS float*)F.lds;
    for (int r = F.vcu; r < NSMP; r += F.G) {
        const size_t grow = (size_t)(SEQ + r); const int c = F.tid * 4;
        const unsigned long long xr = *(const unsigned long long*)(Xb + grow * DM + c);
        f32x4 v = {bf_lo((unsigned)xr), bf_hi((unsigned)xr), bf_lo((unsigned)(xr >> 32)), bf_hi((unsigned)(xr >> 32))};
        for (int ks = 0; ks < nsplit; ks += 8) {
            f32x4 t[8];
#pragma unroll
            for (int j = 0; j < 8; ++j) t[j] = *(const GAS f32x4*)(slab + ((size_t)((ks + j) * 256 + r)) * DM + c);
#pragma unroll
            for (int j = 0; j < 8; ++j) v += t[j];
        }
        *(unsigned long long*)(Xb + grow * DM + c) = (unsigned long long)pk2(v.x, v.y) | ((unsigned long long)pk2(v.z, v.w) << 32);
        const float q = wave_sum((v.x * v.x + v.y * v.y) + (v.z * v.z + v.w * v.w));
        if (F.lane == 0) red[F.wave] = q;
        __syncthreads();
        if (F.tid == 0) { float t = 0.f;
#pragma unroll
            for (int i = 0; i < NWAVES; ++i) t += red[i];
            ssq[grow] = pg8::ssq_fx(t); }
        __syncthreads();
    }
}

__device__ __forceinline__ void final_sample(const Frame& F0) {
    const ArgsP A = args_ptr();
    const Frame F = phase_frame(F0);
    unsigned char* ws = A->ws;
    const float* slab = (const float*)(ws + WS_SLAB); const bf16* Xb = (const bf16*)(ws + WS_XB);
    LAS float* red = (LAS float*)F.lds;
    for (int r = F.vcu; r < NSMP; r += F.G) {
        const size_t grow = (size_t)(SEQ + r); const int c = F.tid * 4;
        const unsigned long long xr = *(const GAS unsigned long long*)(Xb + grow * DM + c);
        const f32x4 wv = *(const GAS f32x4*)(A->in[25] + c);
        f32x4 v = {bf_lo((unsigned)xr), bf_hi((unsigned)xr), bf_lo((unsigned)(xr >> 32)), bf_hi((unsigned)(xr >> 32))};
        for (int ks = 0; ks < 32; ks += 8) {
            f32x4 t[8];
#pragma unroll
            for (int j = 0; j < 8; ++j) t[j] = *(const GAS f32x4*)(slab + ((size_t)((ks + j) * 256 + r)) * DM + c);
#pragma unroll
            for (int j = 0; j < 8; ++j) v += t[j];
        }
        const float q = wave_sum((v.x * v.x + v.y * v.y) + (v.z * v.z + v.w * v.w));
        if (F.lane == 0) red[F.wave] = q;
        __syncthreads();
        float t = 0.f;
#pragma unroll
        for (int i = 0; i < NWAVES; ++i) t += red[i];
        const float rs = pg8::ssq_rstd(pg8::ssq_fx(t));
        const unsigned p0 = pk2(v.x, v.y), p1 = pk2(v.z, v.w);
        const f32x4 xb = {bf_lo(p0), bf_hi(p0), bf_lo(p1), bf_hi(p1)};
        *(GAS f32x4*)(A->out + O_YS + (size_t)r * DM + c) = xb * rs * wv;
        __syncthreads();
    }
}

__device__ __forceinline__ void resid_finalize_pub(const Frame& F0, int nsplit, int ssq_idx, int first, int stride) {
    const ArgsP A = args_ptr();
    const Frame F = phase_frame(F0);
    unsigned char* ws = A->ws;
    const float* slab = (const float*)(ws + WS_SLAB); bf16* Xb = (bf16*)(ws + WS_XB); pg8::ssq_t* ssq = (pg8::ssq_t*)((float*)(ws + WS_CTL) + CW_SSQ) + (size_t)ssq_idx * MT;
    unsigned* cnt = (unsigned*)(ws + WS_CTL) + CW_FIN + 64 * ssq_idx;
    LAS float* red = (LAS float*)F.lds;
    for (int r = first; r < NSMP; r += stride) {
        const size_t grow = (size_t)(SEQ + r); const int c = F.tid * 4;
        const unsigned long long xr = *(const GAS unsigned long long*)(Xb + grow * DM + c);
        f32x4 v = {bf_lo((unsigned)xr), bf_hi((unsigned)xr), bf_lo((unsigned)(xr >> 32)), bf_hi((unsigned)(xr >> 32))};
        for (int ks = 0; ks < nsplit; ks += 4) {
            f32x4 t[4];
#pragma unroll
            for (int j = 0; j < 4; ++j) t[j] = *(const GAS f32x4*)(slab + ((size_t)((ks + j) * 256 + r)) * DM + c);
#pragma unroll
            for (int j = 0; j < 4; ++j) v += t[j];
        }
        __hip_atomic_store((gu64*)(Xb + grow * DM + c), (unsigned long long)pk2(v.x, v.y) | ((unsigned long long)pk2(v.z, v.w) << 32), __ATOMIC_RELAXED, __HIP_MEMORY_SCOPE_AGENT);
        const float q = wave_sum((v.x * v.x + v.y * v.y) + (v.z * v.z + v.w * v.w));
        if (F.lane == 0) red[F.wave] = q;
        __syncthreads();
        if (F.tid == 0) { float t = 0.f;
#pragma unroll
            for (int i = 0; i < NWAVES; ++i) t += red[i];
            __hip_atomic_store((gu64*)(ssq + grow), pg8::ssq_fx(t), __ATOMIC_RELAXED, __HIP_MEMORY_SCOPE_AGENT); }
        asm volatile("s_waitcnt vmcnt(0)" ::: "memory");
        __syncthreads();
        if (F.tid == 0) __hip_atomic_fetch_add(cnt, 1u, __ATOMIC_RELAXED, __HIP_MEMORY_SCOPE_AGENT);
    }
}

__device__ __forceinline__ bool idle_last_round(int nwg, int G, int c) { const int last = (nwg - 1) / G; return c + last * G >= nwg; }
__device__ __forceinline__ int busy_last_round(int nwg, int G) { const int last = (nwg - 1) / G; return nwg - last * G; }
#define SAMPLE_DOWN_IN_NEXT(j_) do { \
    { pg8::Gemm g{(const bf16*)(ws + WS_H), (const bf16*)(ws + WS_WDN) + (size_t)(lq - 1) * 2048 * 8192, MT, 2048, 2048, 8192}; pg8::SplitOrder S{32, 8, 4, 32, (j_)}; \
      pg8::EpiSlab E{(float*)(ws + WS_SLAB), 2048}; \
      pg8::gemm_phase<pg8::EpiSlab, pg8::SplitOrder, true, true>(F.lds, g, S, E, F.wave); } \
    { unsigned* ca_ = (unsigned*)(ws + WS_CTL) + CW_FIN2 + 64 * (2 * lq); \
      __builtin_amdgcn_fence(__ATOMIC_RELEASE, "agent"); asm volatile("s_waitcnt vmcnt(0)" ::: "memory"); __syncthreads(); \
      if (F.wave == 0 && lane_id() == 0) { __hip_atomic_fetch_add(ca_, 1u, __ATOMIC_RELAXED, __HIP_MEMORY_SCOPE_AGENT); unsigned sp_ = 0u; \
          while (__hip_atomic_load(ca_, __ATOMIC_RELAXED, __HIP_MEMORY_SCOPE_AGENT) < 32u) { __builtin_amdgcn_s_sleep(4); if (++sp_ > (1u << 20)) break; } } \
      __syncthreads(); __builtin_amdgcn_fence(__ATOMIC_ACQUIRE, "agent"); asm volatile("s_waitcnt vmcnt(0)" ::: "memory"); } \
    resid_finalize_pub(F, 4, 2 * lq, (j_), 32); } while (0)

__global__ void __launch_bounds__(NWAVES * 64, 2) __attribute__((amdgpu_waves_per_eu(2, 2))) mk_fwd(Args Aval) {
    extern __shared__ __attribute__((aligned(16))) unsigned char lds[];
    Frame F;
    F.lds = (LAS unsigned char*)lds;
    volatile LAS unsigned* MISC = (volatile LAS unsigned*)(F.lds + MISC_OFF);
    F.tid = threadIdx.x; F.lane = F.tid & 63; F.wave = __builtin_amdgcn_readfirstlane(F.tid >> 6);
    F.G = gridDim.x; { const int bx = blockIdx.x; F.vcu = (F.G % 8 == 0) ? (bx % 8) * (F.G / 8) + bx / 8 : bx; }
    for (int u = F.tid; u < (LDS_BYTES - LDSCTL_OFF) / 4; u += NWAVES * 64) ((LAS unsigned*)(F.lds + LDSCTL_OFF))[u] = 0u;
    __syncthreads();
    (void)xcd_barrier_post((unsigned*)(Aval.ws + WS_CTL) + CW_BAR, MISC + 8);
#define GRID_BAR() do { XcdBarrier b_; b_.bar = (unsigned*)(args_ptr()->ws + WS_CTL) + CW_BAR; b_.x = xb_xcc_id(); b_.st = (volatile LAS unsigned*)(F.lds + MISC_OFF) + 8; xcd_barrier(b_); } while (0)
#define PHASE_PTRS() const ArgsP A = args_ptr(); unsigned char* ws = A->ws; pg8::ssq_t* SSQ = (pg8::ssq_t*)((float*)(ws + WS_CTL) + CW_SSQ); (void)SSQ; int bid = blockIdx.x, GG = F.G, lq = l; asm volatile("" : "+s"(bid), "+s"(GG), "+s"(lq))

    p0_prologue(F);
    GRID_BAR();

    for (int l = 0; l < 4; ++l) {
        for (int sub = 0; sub < 2; ++sub) {
            if (sub == 0) {
                if ((l & 1) == 0) {
                    const int e = l >> 1;
                    {
                        PHASE_PTRS();
                        const int GE = GG == 256 ? GE_E1 : GG;
                        if (lq > 0) { const int sj = GE == GG ? F.vcu : bid - GE; if (sj >= 0 && sj < 32) SAMPLE_DOWN_IN_NEXT(sj); }
                        if (bid < GE) {
                            pg8::Gemm g{(const bf16*)(ws + WS_XB), (const bf16*)(ws + WS_WEI) + (size_t)(lq >> 1) * 2048 * 5120, MT, 5120, 2048, 2048};
                            pg8::DepOrder S; S.init(MT, 5120, GE, bid); S.cnt = (unsigned*)(ws + WS_CTL) + CW_FIN + 64 * (2 * lq); S.need = lq > 0 ? NSMP : 0; S.dep_pm = 32; S.tmo = (unsigned*)(ws + WS_CTL) + CW_BAR + XB_TMO;
                            pg8::EpiEvenIn E{SSQ + (2 * lq) * MT, ws + WS_T, A->out, lq >> 1};
                            pg8::gemm_phase<pg8::EpiEvenIn, pg8::DepOrder, true, true>(F.lds, g, S, E, F.wave);
                        } else conv_phase(F, 0, lq, bid - GE, GG - GE);
                        if (GE == GG) conv_phase(F, 0, lq, F.vcu, F.G);
                    }
                    GRID_BAR();
                    {
                        lru_tasks<1>(F, e);
                        __syncthreads();
                        for (int u = F.vcu; u < 256; u += F.G) {
                            const int h = u >> 5, s = (u >> 4) & 1, p = u & 15;
                            const int ord = u % 3;
#pragma nounroll
                            for (int k = 0; k < 3; ++k) {
                                if (k == ord) att::attn_sweep<true>(F, e, s, h, p);
                                if (k < 2) att::attn_sweep<false>(F, e, s, h, k ? p : 31 - p);
                            }
                        }
                    }
                    GRID_BAR();
                    {
                        if (F.vcu & 1) { attn_combine(F, e); lru_tasks<2>(F, e); }
                        else { lru_tasks<2>(F, e); attn_combine(F, e); }
                    }
                } else {
                    const int o = l >> 1;
                    {
                        PHASE_PTRS();
                        const int GE = GG == 256 ? GE_O1 : GG;
                        { const int sj = GE == GG ? F.vcu : bid - GE; if (sj >= 0 && sj < 32) SAMPLE_DOWN_IN_NEXT(sj); }
                        if (bid < GE) {
                            pg8::Gemm g{(const bf16*)(ws + WS_XB), (const bf16*)(ws + WS_WOI) + (size_t)(lq >> 1) * 2048 * 4096, MT, 4096, 2048, 2048};
                            pg8::DepOrder S; S.init(MT, 4096, GE, bid); S.cnt = (unsigned*)(ws + WS_CTL) + CW_FIN + 64 * (2 * lq); S.need = NSMP; S.dep_pm = 32; S.tmo = (unsigned*)(ws + WS_CTL) + CW_BAR + XB_TMO;
                            pg8::EpiOddIn E{SSQ + (2 * lq) * MT, (bf16*)(ws + WS_U), (bf16*)(ws + WS_VR), SSQ + (9 + (lq >> 1)) * MT};
                            pg8::gemm_phase<pg8::EpiOddIn, pg8::DepOrder, true, true>(F.lds, g, S, E, F.wave);
                        } else conv_phase(F, 1, lq, bid - GE, GG - GE);
                        if (GE == GG) conv_phase(F, 1, lq, F.vcu, F.G);
                    }
                    GRID_BAR();
                    gmlp_phase(F, o);
                }
            } else {
              {
                PHASE_PTRS();
                const int GE = GG == 256 ? GE_F1 : GG;
                {
                    const int sj = GE == GG ? F.vcu : bid - GE;
                    if (sj >= 0 && sj < 8) {
                        const bf16* Wt = (lq & 1) == 0 ? (const bf16*)(ws + WS_WEO) + (size_t)(lq >> 1) * 2048 * 2048 : (const bf16*)(ws + WS_WOO) + (size_t)(lq >> 1) * 2048 * 2048;
                        pg8::Gemm g{(const bf16*)(ws + WS_YC), Wt, MT, 2048, 2048, 2048};
                        pg8::StaticOrder S; S.init(MT, 2048, 1 << 20, (25 + sj) * 8 + 7);
                        pg8::EpiResid E{(bf16*)(ws + WS_XB), SSQ + (2 * lq + 1) * MT};
                        pg8::gemm_phase<pg8::EpiResid, pg8::StaticOrder, true, true>(F.lds, g, S, E, F.wave);
                        __builtin_amdgcn_fence(__ATOMIC_RELEASE, "agent");
                        asm volatile("s_waitcnt vmcnt(0)" ::: "memory");
                        __syncthreads();
                        if (F.wave == 0 && lane_id() == 0) __hip_atomic_fetch_add((unsigned*)(ws + WS_CTL) + CW_FIN + 64 * (2 * lq + 1), 1u, __ATOMIC_RELAXED, __HIP_MEMORY_SCOPE_AGENT);
                    }
                }
              }
              {
                PHASE_PTRS();
                const int GE = GG == 256 ? GE_F1 : GG;
                if (bid < GE) {
                    pg8::Gemm g{(const bf16*)(ws + WS_XB), (const bf16*)(ws + WS_WUP) + (size_t)lq * 2048 * 8192, MT, 8192, 2048, 2048};
                    pg8::DepOrder S; S.init(MT, 8192, GE, bid); S.cnt = (unsigned*)(ws + WS_CTL) + CW_FIN + 64 * (2 * lq + 1); S.need = 8; S.dep_pm = 32; S.tmo = (unsigned*)(ws + WS_CTL) + CW_BAR + XB_TMO;
                    pg8::EpiUp E{SSQ + (2 * lq + 1) * MT, (bf16*)(ws + WS_H)};
                    pg8::gemm_phase<pg8::EpiUp, pg8::DepOrder, true, true>(F.lds, g, S, E, F.wave);
                } else if (lq < 3) conv_phase(F, 2, lq, bid - GE, GG - GE);
                if (GE == GG && lq < 3) conv_phase(F, 2, lq, F.vcu, F.G);
              }
            }
            GRID_BAR();
            {
                PHASE_PTRS();
                const bf16* Wt = sub == 0 ? ((lq & 1) == 0 ? (const bf16*)(ws + WS_WEO) + (size_t)(lq >> 1) * 2048 * 2048 : (const bf16*)(ws + WS_WOO) + (size_t)(lq >> 1) * 2048 * 2048)
                                          : (const bf16*)(ws + WS_WDN) + (size_t)lq * 2048 * 8192;
                const int Kf = sub == 0 ? 2048 : 8192;
                const bf16* Ap = sub == 0 ? (const bf16*)(ws + WS_YC) : (const bf16*)(ws + WS_H);
                {
                    pg8::Gemm g{Ap, Wt, SEQ, 2048, Kf, Kf}; pg8::StaticOrder S; S.init(SEQ, 2048, GG, bid);
                    pg8::EpiResid E{(bf16*)(ws + WS_XB), SSQ + (2 * lq + 1 + sub) * MT};
                    pg8::gemm_phase<pg8::EpiResid, pg8::StaticOrder, true, true>(F.lds, g, S, E, F.wave);
                }
                if (sub == 1 && lq == 3) {
                    pg8::Gemm g{Ap, Wt, MT, 2048, 256, Kf}; pg8::SplitOrder S{32, 8, Kf / 256, GG, bid};
                    pg8::EpiSlab E{(float*)(ws + WS_SLAB), 2048};
                    pg8::gemm_phase<pg8::EpiSlab, pg8::SplitOrder, true, true>(F.lds, g, S, E, F.wave);
                }
            }
            GRID_BAR();
        }
    }
    final_sample(F);
    final_norm(F);
}

extern "C" void kernel_launch(void* const* d_in, const int* in_sizes, int n_in, void* d_out, int out_size, void* d_ws, size_t ws_size, hipStream_t stream) {
    static int grid = 0;
    if (grid == 0) {
        if (n_in != 28 || (size_t)out_size != O_END || ws_size < WS_END) { fprintf(stderr, "kernel_launch: unexpected shapes (n_in %d out %d ws %zu)\n", n_in, out_size, ws_size); grid = -1; return; }
        int dev = 0, cus = 0, per_cu = 0;
        if (hipGetDevice(&dev) != hipSuccess || hipDeviceGetAttribute(&cus, hipDeviceAttributeMultiprocessorCount, dev) != hipSuccess) { grid = -1; return; }
        if (hipFuncSetAttribute((const void*)mk_fwd, hipFuncAttributeMaxDynamicSharedMemorySize, LDS_BYTES) != hipSuccess) { fprintf(stderr, "kernel_launch: hipFuncSetAttribute failed\n"); grid = -1; return; }
        if (hipOccupancyMaxActiveBlocksPerMultiprocessor(&per_cu, (const void*)mk_fwd, NWAVES * 64, LDS_BYTES) != hipSuccess || per_cu < 1) { fprintf(stderr, "kernel_launch: occupancy query says %d\n", per_cu); }
        (void)hipGetLastError();
        grid = cus;
    }
    if (grid < 0) return;
    if (hipMemsetAsync((char*)d_ws + WS_CTL, 0, CTL_ZERO_BYTES, stream) != hipSuccess) return;
    Args a{};
    for (int i = 0; i < 28; ++i) a.in[i] = (const float*)d_in[i];
    a.out = (float*)d_out; a.ws = (unsigned char*)d_ws;
    hipLaunchKernelGGL(mk_fwd, dim3(grid), dim3(NWAVES * 64), LDS_BYTES, stream, a);
}
```

```cpp
#include <hip/hip_runtime.h>
#include <cstdio>
#include <cstdint>
namespace pg8 {
#define PG8_LAS __attribute__((address_space(3)))
typedef unsigned short bf16_t;
typedef short bf16x8 __attribute__((ext_vector_type(8)));
typedef float f32x4 __attribute__((ext_vector_type(4)));
typedef unsigned u32x4 __attribute__((ext_vector_type(4)));
constexpr int BM = 256, BK = 64, HALF = 128, HTB = HALF * BK * 2  , STAGE_BYTES = 8 * HTB, NXCD = 8, WGM = 8;

__host__ __device__ __forceinline__ int lds_byte(int r, int c) { const int st = (r >> 4) * 2 + (c >> 5), rr = r & 15, cc = c & 31, ob = rr * 64 + cc * 2; return st * 1024 + (ob ^ (((ob >> 9) & 1) << 5)); }
__host__ __device__ __forceinline__ void stage_rc(int b, int& R, int& C) { const int st = b / 1024, sb = b % 1024, swz = sb ^ (((sb >> 9) & 1) << 5); R = (st >> 1) * 16 + swz / 64; C = (st & 1) * 32 + (swz % 64) / 2; }
__host__ __device__ __forceinline__ int perm32(int rho) { const int n = rho >> 4, i = rho & 15; return 8 * (i >> 2) + 4 * n + (i & 3); }

struct Unit { int pm, pn, ks; };
struct Gemm { const bf16_t* A; const bf16_t* Bt; int M, N, K, ld; };

struct StaticOrder {
    int nM, nN, nwg, G, c;
    __host__ __device__ void init(int M, int N, int G_, int c_) { nM = M / BM; nN = N / BM; nwg = nM * nN; G = G_; c = c_; }
    __host__ __device__ bool next(int i, Unit& u) const {
        const long L = (long)i * G + c; if (L >= nwg) return false;
        int wgid = (int)L; { const int q = nwg / NXCD, r = nwg % NXCD, xcd = wgid % NXCD, off = wgid / NXCD; wgid = (xcd < r ? xcd * (q + 1) : r * (q + 1) + (xcd - r) * q) + off; }
        const int nig = WGM * nN, gid = wgid / nig, fm = gid * WGM, gsz = (nM - fm) < WGM ? (nM - fm) : WGM;
        u.pm = fm + ((wgid % nig) % gsz); u.pn = (wgid % nig) / gsz; u.ks = 0; return true;
    }
    __device__ __forceinline__ void a_ready(const Unit&) const {}
    __device__ __forceinline__ void done(const Unit&) const {}
};

__device__ __forceinline__ unsigned cvt_pk_bf16(float lo, float hi) { unsigned r; asm volatile("v_cvt_pk_bf16_f32 %0, %1, %2" : "=v"(r) : "v"(lo), "v"(hi)); return r; }
struct SplitOrder {
    int pm, nN, nsplit, G, c;
    __host__ __device__ bool next(int i, Unit& u) const { const int L = i * G + c; if (L >= nN * nsplit) return false; u.pm = pm; u.pn = L % nN; u.ks = L / nN; return true; }
    __device__ __forceinline__ void a_ready(const Unit&) const {}
    __device__ __forceinline__ void done(const Unit&) const {}
};
struct DepOrder : StaticOrder {
    unsigned* cnt; unsigned need; int dep_pm; unsigned* tmo;
    __device__ __forceinline__ void a_ready(const Unit& u) const {
        if (need == 0u || u.pm != dep_pm) return;
        if (threadIdx.x < 64) {
            unsigned sp = 0u;
            while ((unsigned)__builtin_amdgcn_readfirstlane((int)__hip_atomic_load(cnt, __ATOMIC_RELAXED, __HIP_MEMORY_SCOPE_AGENT)) < need) {
                __builtin_amdgcn_s_sleep(2);
                if ((++sp & 255u) == 0u) { if (__hip_atomic_load(tmo, __ATOMIC_RELAXED, __HIP_MEMORY_SCOPE_AGENT)) break; if (sp > (1u << 18)) { __hip_atomic_fetch_add(tmo, 1u, __ATOMIC_RELAXED, __HIP_MEMORY_SCOPE_AGENT); break; } } }
            __builtin_amdgcn_fence(__ATOMIC_ACQUIRE, "agent");
            asm volatile("s_waitcnt vmcnt(0)" ::: "memory");
        }
        asm volatile("" ::: "memory"); __builtin_amdgcn_s_barrier(); asm volatile("" ::: "memory");
    }
};
typedef float f32x2 __attribute__((ext_vector_type(2)));
constexpr float RMS_EPS = 1e-6f;
constexpr float QSCALE = 0.125f * 1.4426950408889634f;
template <int O> __device__ __forceinline__ float xorl(float v) { return __builtin_bit_cast(float, __builtin_amdgcn_ds_swizzle(__builtin_bit_cast(int, v), (O << 10) | 0x1f)); }
__device__ __forceinline__ float sum_x32(float v) { auto rr = __builtin_amdgcn_permlane32_swap(__float_as_uint(v), __float_as_uint(v), false, false); const unsigned r0 = rr[0], r1 = rr[1]; return __uint_as_float(r0) + __uint_as_float(r1); }
__device__ __forceinline__ float max_x32(float v) { auto rr = __builtin_amdgcn_permlane32_swap(__float_as_uint(v), __float_as_uint(v), false, false); const unsigned r0 = rr[0], r1 = rr[1]; return fmaxf(__uint_as_float(r0), __uint_as_float(r1)); }
typedef unsigned long long ssq_t;
constexpr float SSQ_FX = 1048576.0f, SSQ_INV = 1.0f / 1048576.0f;
__device__ __forceinline__ ssq_t ssq_fx(float s) { return (ssq_t)(s * SSQ_FX + 0.5f); }
__device__ __forceinline__ float ssq_rstd(ssq_t q) { return __builtin_amdgcn_rsqf((float)q * (SSQ_INV / 2048.0f) + RMS_EPS); }
__device__ __forceinline__ void atomic_addq(ssq_t* p, float v) { __hip_atomic_fetch_add(p, ssq_fx(v), __ATOMIC_RELAXED, __HIP_MEMORY_SCOPE_AGENT); }
__device__ __forceinline__ void gelu8(f32x4& a, f32x4& b) {
    constexpr float C1 = -2.0f * 0.7978845608028654f * 1.4426950408889634f, C2 = C1 * 0.044715f;
    const f32x4 ya = a * (a * a * C2 + C1), yb = b * (b * b * C2 + C1);
    f32x4 ea, eb;
#pragma unroll
    for (int i = 0; i < 4; ++i) { ea[i] = __builtin_amdgcn_exp2f(ya[i]); eb[i] = __builtin_amdgcn_exp2f(yb[i]); }
    const f32x4 da = ea + 1.0f, db = eb + 1.0f;
    f32x4 ra, rb;
#pragma unroll
    for (int i = 0; i < 4; ++i) { ra[i] = __builtin_amdgcn_rcpf(da[i]); rb[i] = __builtin_amdgcn_rcpf(db[i]); }
    a = a * ra; b = b * rb;
}
__device__ __forceinline__ u32x4 pack8(const f32x4 a, const f32x4 b) { u32x4 w; w.x = cvt_pk_bf16(a[0], a[1]); w.y = cvt_pk_bf16(a[2], a[3]); w.z = cvt_pk_bf16(b[0], b[1]); w.w = cvt_pk_bf16(b[2], b[3]); return w; }
__device__ __forceinline__ float dot8(const f32x4 a, const f32x4 b) { return (a[0] * a[0] + a[1] * a[1]) + (a[2] * a[2] + a[3] * a[3]) + (b[0] * b[0] + b[1] * b[1]) + (b[2] * b[2] + b[3] * b[3]); }

struct EpiEvenIn {
    static constexpr bool PERM = true, AFTER_DRAIN = false;
    const ssq_t* ssq; unsigned char* tb  ; float* out; int e;
    __device__ __forceinline__ void operator()(const f32x4 (&acc)[2][2][4][2], const Unit& u, int wr, int wc, int fr, int fq) const {
        const int reg = u.pn >> 2;
        const int row0 = u.pm * BM + wr * 64 + fr, c0 = (u.pn & 3) * 256 + wc * 32 + 8 * fq;
        bf16_t* G = (bf16_t*)tb; float* XR = (float*)(tb + ((size_t)17 << 20)); bf16_t* Q = (bf16_t*)(tb + ((size_t)50 << 20));
        float rs[2][4];
#pragma unroll
        for (int ai = 0; ai < 2; ++ai)
#pragma unroll
            for (int m = 0; m < 4; ++m) rs[ai][m] = ssq_rstd(ssq[row0 + ai * HALF + m * 16]);
        if (reg == 0) {
#pragma unroll
            for (int ai = 0; ai < 2; ++ai)
#pragma unroll
                for (int m = 0; m < 4; ++m) { const size_t row = (size_t)(row0 + ai * HALF + m * 16); const float r = rs[ai][m];
#pragma unroll
                    for (int bj = 0; bj < 2; ++bj) { f32x4 v0 = acc[ai][bj][m][0] * r, v1 = acc[ai][bj][m][1] * r;
#pragma unroll
                        for (int i = 0; i < 1; ++i) gelu8(v0, v1);
                        *(u32x4*)(G + row * 1024 + c0 + bj * HALF) = pack8(v0, v1); } }
        } else if (reg == 1) {
#pragma unroll
            for (int ai = 0; ai < 2; ++ai)
#pragma unroll
                for (int m = 0; m < 4; ++m) { const size_t row = (size_t)(row0 + ai * HALF + m * 16); const float r = rs[ai][m];
#pragma unroll
                    for (int bj = 0; bj < 2; ++bj) { float* p = XR + row * 1024 + c0 + bj * HALF; *(f32x4*)p = acc[ai][bj][m][0] * r; *(f32x4*)(p + 4) = acc[ai][bj][m][1] * r; } }
        } else if (reg == 2) {
#pragma unroll
            for (int ai = 0; ai < 2; ++ai)
#pragma unroll
                for (int m = 0; m < 4; ++m) { const size_t row = (size_t)(row0 + ai * HALF + m * 16); const float r = rs[ai][m] * QSCALE;
#pragma unroll
                    for (int bj = 0; bj < 2; ++bj) *(u32x4*)(Q + row * 1024 + c0 + bj * HALF) = pack8(acc[ai][bj][m][0] * r, acc[ai][bj][m][1] * r); }
        } else {
            bf16_t* B = (bf16_t*)(tb + ((size_t)(reg == 3 ? 67 : 84) << 20));
            const size_t ooff = (u.pm < 32) ? (size_t)(reg == 3 ? 17309696 : 34086912) + (size_t)e * 8192 * 1024 : (size_t)(reg == 3 ? 50995200 : 51519488) + (size_t)e * 256 * 1024;
            float* O = out + ooff; const int orow0 = (u.pm < 32) ? row0 : row0 - 8192;
#pragma unroll
            for (int ai = 0; ai < 2; ++ai)
#pragma unroll
                for (int m = 0; m < 4; ++m) { const size_t row = (size_t)(row0 + ai * HALF + m * 16), orow = (size_t)(orow0 + ai * HALF + m * 16); const float r = rs[ai][m];
#pragma unroll
                    for (int bj = 0; bj < 2; ++bj) { const f32x4 v0 = acc[ai][bj][m][0] * r, v1 = acc[ai][bj][m][1] * r;
                        *(u32x4*)(B + row * 1024 + c0 + bj * HALF) = pack8(v0, v1);
                        float* p = O + orow * 1024 + c0 + bj * HALF; *(f32x4*)p = v0; *(f32x4*)(p + 4) = v1; } }
        }
    }
};
struct EpiResid {
    static constexpr bool PERM = true, AFTER_DRAIN = false;
    bf16_t* Xb; ssq_t* ssq_next;
    __device__ __forceinline__ void operator()(const f32x4 (&acc)[2][2][4][2], const Unit& u, int wr, int wc, int fr, int fq) const {
        const int row0 = u.pm * BM + wr * 64 + fr, c0 = u.pn * BM + wc * 32 + 8 * fq;
#pragma unroll
        for (int ai = 0; ai < 2; ++ai)
#pragma unroll
            for (int m = 0; m < 4; ++m) { const size_t row = (size_t)(row0 + ai * HALF + m * 16); float s = 0.f;
#pragma unroll
                for (int bj = 0; bj < 2; ++bj) { bf16_t* p = Xb + row * 2048 + c0 + bj * HALF; const u32x4 r = *(const u32x4*)p;
                    const f32x4 x0 = (f32x4){__uint_as_float(r.x << 16), __uint_as_float(r.x & 0xffff0000u), __uint_as_float(r.y << 16), __uint_as_float(r.y & 0xffff0000u)} + acc[ai][bj][m][0];
                    const f32x4 x1 = (f32x4){__uint_as_float(r.z << 16), __uint_as_float(r.z & 0xffff0000u), __uint_as_float(r.w << 16), __uint_as_float(r.w & 0xffff0000u)} + acc[ai][bj][m][1];
                    *(u32x4*)p = pack8(x0, x1); s += dot8(x0, x1); }
                s += xorl<16>(s); s = sum_x32(s);
                if (fq == 0) atomic_addq(ssq_next + row, s); }
    }
};
struct EpiUp {
    static constexpr bool PERM = true, AFTER_DRAIN = false;
    const ssq_t* ssq; bf16_t* H;
    __device__ __forceinline__ void operator()(const f32x4 (&acc)[2][2][4][2], const Unit& u, int wr, int wc, int fr, int fq) const {
        const int row0 = u.pm * BM + wr * 64 + fr, c0 = u.pn * BM + wc * 32 + 8 * fq;
#pragma unroll
        for (int ai = 0; ai < 2; ++ai)
#pragma unroll
            for (int m = 0; m < 4; ++m) { const size_t row = (size_t)(row0 + ai * HALF + m * 16); const float r = ssq_rstd(ssq[row]);
#pragma unroll
                for (int bj = 0; bj < 2; ++bj) { f32x4 v0 = acc[ai][bj][m][0] * r, v1 = acc[ai][bj][m][1] * r;
#pragma unroll
                    for (int i = 0; i < 4; ++i) { const float a = fmaxf(v0[i], 0.f), b = fmaxf(v1[i], 0.f); v0[i] = a * a; v1[i] = b * b; }
                    *(u32x4*)(H + row * 8192 + c0 + bj * HALF) = pack8(v0, v1); } }
    }
};
struct EpiOddIn {
    static constexpr bool PERM = true, AFTER_DRAIN = false;
    const ssq_t* ssq; bf16_t* U; bf16_t* VR; ssq_t* ssqv;
    __device__ __forceinline__ void operator()(const f32x4 (&acc)[2][2][4][2], const Unit& u, int wr, int wc, int fr, int fq) const {
        const int reg = u.pn >> 3;
        const int row0 = u.pm * BM + wr * 64 + fr, c0 = (u.pn & 7) * 256 + wc * 32 + 8 * fq;
        bf16_t* B = reg ? VR : U;
#pragma unroll
        for (int ai = 0; ai < 2; ++ai)
#pragma unroll
            for (int m = 0; m < 4; ++m) { const size_t row = (size_t)(row0 + ai * HALF + m * 16); const float r = ssq_rstd(ssq[row]); float s = 0.f;
#pragma unroll
                for (int bj = 0; bj < 2; ++bj) { f32x4 v0 = acc[ai][bj][m][0] * r, v1 = acc[ai][bj][m][1] * r;
#pragma unroll
                    for (int i = 0; i < 1; ++i) gelu8(v0, v1);
                    *(u32x4*)(B + row * 2048 + c0 + bj * HALF) = pack8(v0, v1); s += dot8(v0, v1); }
                if (reg) { s += xorl<16>(s); s = sum_x32(s); if (fq == 0) atomic_addq(ssqv + row, s); } }
    }
};
struct EpiSlab {
    static constexpr bool PERM = true, AFTER_DRAIN = false;
    float* slab; int N;
    __device__ __forceinline__ void operator()(const f32x4 (&acc)[2][2][4][2], const Unit& u, int wr, int wc, int fr, int fq) const {
        const int r0 = wr * 64 + fr, c0 = u.pn * BM + wc * 32 + 8 * fq;
#pragma unroll
        for (int ai = 0; ai < 2; ++ai)
#pragma unroll
            for (int m = 0; m < 4; ++m) { float* p = slab + ((size_t)(u.ks * 256 + r0 + ai * HALF + m * 16)) * N + c0;
#pragma unroll
                for (int bj = 0; bj < 2; ++bj) { *(f32x4*)(p + bj * HALF) = acc[ai][bj][m][0]; *(f32x4*)(p + bj * HALF + 4) = acc[ai][bj][m][1]; } }
    }
};
template <class Epi, class Sched, bool ALIGN_EPI = false, bool SP2 = false>
__device__ __forceinline__ void gemm_phase(PG8_LAS unsigned char* lds, const Gemm g, const Sched& S, const Epi& E, int wave0) {
    int wid_ = wave0; asm volatile("" : "+s"(wid_)); int lane_; asm volatile("v_mbcnt_lo_u32_b32 %0, -1, 0\n\tv_mbcnt_hi_u32_b32 %0, -1, %0" : "=v"(lane_));
    const int wid = wid_, lane = lane_, tid = wid * 64 + lane, wr = wid >> 2, wc = wid & 3, fr = lane & 15, fq = lane >> 4;
    const int K = g.K, nt = K / BK, ld = g.ld;
    unsigned voffA[2], voffB[2];
#pragma unroll
    for (int i = 0; i < 2; ++i) { int R, C; stage_rc(tid * 16 + i * 8192, R, C); const int Rb = Epi::PERM ? ((R & ~31) + perm32(R & 31)) : R;
        voffA[i] = (unsigned)(R * ld + C) * 2u; voffB[i] = (unsigned)(Rb * ld + C) * 2u; }
    const size_t kstep = (size_t)(BK * 2);
    const size_t hstep = (size_t)HALF * ld * 2; const size_t sstep = (size_t)K * 2  ;
    const size_t tstep = 2 * hstep;
    const unsigned ldsw = (unsigned)wid * 1024u;
    const int aoff = lds_byte(wr * 64 + fr, fq * 8), boff = lds_byte(wc * 32 + fr, fq * 8);
#define PG8_SA(b, h) (((b) * 2 + (h)) * HTB)
#define PG8_SB(b, h) ((4 + (b) * 2 + (h)) * HTB)
#define PG8_STAGE(bufoff, gbase, voff) do { _Pragma("unroll") for (int _i = 0; _i < 2; ++_i) \
        __builtin_amdgcn_global_load_lds((const unsigned*)((const char*)(gbase) + (voff)[_i]), (PG8_LAS unsigned*)(lds + (bufoff) + ldsw + _i * 8192), 16, 0, 0); } while (0)
#define PG8_LDA(dst, b, h) do { _Pragma("unroll") for (int m = 0; m < 4; ++m) _Pragma("unroll") for (int k = 0; k < 2; ++k) dst[m][k] = *(const PG8_LAS bf16x8*)(lds + PG8_SA(b, h) + aoff + m * 2048 + k * 1024); } while (0)
#define PG8_LDB(dst, b, h) do { _Pragma("unroll") for (int n = 0; n < 2; ++n) _Pragma("unroll") for (int k = 0; k < 2; ++k) dst[n][k] = *(const PG8_LAS bf16x8*)(lds + PG8_SB(b, h) + boff + n * 2048 + k * 1024); } while (0)
#define PG8_MMA(ai, bj, At, Bt) do { __builtin_amdgcn_s_setprio(1); _Pragma("unroll") for (int m = 0; m < 4; ++m) _Pragma("unroll") for (int n = 0; n < 2; ++n) _Pragma("unroll") for (int k = 0; k < 2; ++k) \
        acc[ai][bj][m][n] = __builtin_amdgcn_mfma_f32_16x16x32_bf16(Bt[n][k], At[m][k], acc[ai][bj][m][n], 0, 0, 0); __builtin_amdgcn_s_setprio(0); } while (0)
#define PG8_WAIT_V(n) asm volatile("s_waitcnt vmcnt(" #n ")" ::: "memory")
#define PG8_WAIT_L(n) asm volatile("s_waitcnt lgkmcnt(" #n ")" ::: "memory")
#define PG8_BAR __builtin_amdgcn_s_barrier()
#define PG8_SCHED __builtin_amdgcn_sched_barrier(0)
    Unit cur, nxt; int ui = 0;
    if (!S.next(0, cur)) return;
    f32x4 acc[2][2][4][2];
#pragma unroll
    for (int a = 0; a < 2; ++a)
#pragma unroll
        for (int b = 0; b < 2; ++b)
#pragma unroll
            for (int m = 0; m < 4; ++m)
#pragma unroll
                for (int n = 0; n < 2; ++n) acc[a][b][m][n] = (f32x4){0.f, 0.f, 0.f, 0.f};
    bf16x8 At[4][2], B0[2][2], B1[2][2];
    const char* cA = (const char*)g.A + (size_t)cur.pm * tstep + (size_t)cur.ks * sstep; const char* cB = (const char*)g.Bt + (size_t)cur.pn * tstep + (size_t)cur.ks * sstep;
    S.a_ready(cur);
    if constexpr (SP2) {
        PG8_STAGE(PG8_SB(0, 0), cB, voffB); PG8_STAGE(PG8_SB(0, 1), cB + hstep, voffB); PG8_STAGE(PG8_SA(0, 0), cA, voffA); PG8_STAGE(PG8_SA(0, 1), cA + hstep, voffA);
        if (wr == 1) PG8_BAR;
        PG8_WAIT_V(2); PG8_BAR;
        PG8_STAGE(PG8_SB(1, 0), cB + kstep, voffB); PG8_STAGE(PG8_SA(1, 0), cA + kstep, voffA); PG8_STAGE(PG8_SB(1, 1), cB + hstep + kstep, voffB);
        PG8_WAIT_V(6); PG8_BAR;
    } else {
        PG8_STAGE(PG8_SB(0, 0), cB, voffB); PG8_STAGE(PG8_SA(0, 0), cA, voffA); PG8_STAGE(PG8_SB(0, 1), cB + hstep, voffB); PG8_STAGE(PG8_SA(0, 1), cA + hstep, voffA);
        if (wr == 1) PG8_BAR;
        PG8_WAIT_V(4); PG8_BAR;
        PG8_STAGE(PG8_SB(1, 0), cB + kstep, voffB); PG8_STAGE(PG8_SA(1, 0), cA + kstep, voffA); PG8_STAGE(PG8_SB(1, 1), cB + hstep + kstep, voffB);
        PG8_WAIT_V(6); PG8_BAR;
    }
    for (;;) {
        const bool has_next = S.next(ui + 1, nxt);
        const char* nA = has_next ? (const char*)g.A + (size_t)nxt.pm * tstep + (size_t)nxt.ks * sstep : cA; const char* nB = has_next ? (const char*)g.Bt + (size_t)nxt.pn * tstep + (size_t)nxt.ks * sstep : cB;
        for (int t = 0; t < nt; t += 2) {
            const bool last = (t == nt - 2);
            const char* a1 = cA + (size_t)(t + 1) * kstep;
            const char* a2 = last ? nA : cA + (size_t)(t + 2) * kstep; const char* b2 = last ? nB : cB + (size_t)(t + 2) * kstep;
            const char* a3 = a2 + kstep; const char* b3 = b2 + kstep;
            if (last && has_next) S.a_ready(nxt);
            if constexpr (SP2) {
            PG8_LDB(B0, 0, 0); PG8_LDB(B1, 0, 1); PG8_SCHED; PG8_LDA(At, 0, 0); PG8_STAGE(PG8_SA(1, 1), a1 + hstep, voffA);
            PG8_WAIT_V(8); PG8_WAIT_L(0); PG8_BAR; PG8_MMA(0, 0, At, B0); PG8_MMA(0, 1, At, B1); PG8_BAR; PG8_SCHED;
            PG8_LDA(At, 0, 1); PG8_STAGE(PG8_SB(0, 0), b2, voffB); PG8_STAGE(PG8_SB(0, 1), b2 + hstep, voffB); PG8_STAGE(PG8_SA(0, 0), a2, voffA);
            PG8_WAIT_V(8); PG8_WAIT_L(0); PG8_BAR; PG8_MMA(1, 0, At, B0); PG8_MMA(1, 1, At, B1); PG8_BAR; PG8_SCHED;
            PG8_LDB(B0, 1, 0); PG8_LDB(B1, 1, 1); PG8_SCHED; PG8_LDA(At, 1, 0); PG8_STAGE(PG8_SA(0, 1), a2 + hstep, voffA);
            PG8_WAIT_V(8); PG8_WAIT_L(0); PG8_BAR; PG8_MMA(0, 0, At, B0); PG8_MMA(0, 1, At, B1); PG8_BAR; PG8_SCHED;
            PG8_LDA(At, 1, 1); PG8_STAGE(PG8_SB(1, 0), b3, voffB); PG8_STAGE(PG8_SB(1, 1), b3 + hstep, voffB); PG8_STAGE(PG8_SA(1, 0), a3, voffA);
            PG8_WAIT_V(8); PG8_WAIT_L(0); PG8_BAR; PG8_MMA(1, 0, At, B0); PG8_MMA(1, 1, At, B1); PG8_BAR; PG8_SCHED;
            } else {
            PG8_LDB(B0, 0, 0); PG8_SCHED; PG8_LDA(At, 0, 0); PG8_STAGE(PG8_SA(1, 1), a1 + hstep, voffA);
            PG8_WAIT_L(8); PG8_BAR; PG8_WAIT_L(0); PG8_MMA(0, 0, At, B0); PG8_BAR; PG8_SCHED;
            PG8_LDB(B1, 0, 1); PG8_STAGE(PG8_SB(0, 0), b2, voffB);
            PG8_BAR; PG8_WAIT_L(0); PG8_MMA(0, 1, At, B1); PG8_BAR;
            PG8_LDA(At, 0, 1); PG8_STAGE(PG8_SA(0, 0), a2, voffA);
            PG8_BAR; PG8_WAIT_L(0); PG8_MMA(1, 0, At, B0); PG8_BAR; PG8_SCHED;
            PG8_STAGE(PG8_SB(0, 1), b2 + hstep, voffB);
            PG8_WAIT_V(6); PG8_BAR; PG8_MMA(1, 1, At, B1); PG8_BAR;
            PG8_LDB(B0, 1, 0); PG8_SCHED; PG8_LDA(At, 1, 0); PG8_STAGE(PG8_SA(0, 1), a2 + hstep, voffA);
            PG8_WAIT_L(8); PG8_BAR; PG8_WAIT_L(0); PG8_MMA(0, 0, At, B0); PG8_BAR; PG8_SCHED;
            PG8_LDB(B1, 1, 1); PG8_STAGE(PG8_SB(1, 0), b3, voffB);
            PG8_BAR; PG8_WAIT_L(0); PG8_MMA(0, 1, At, B1); PG8_BAR;
            PG8_LDA(At, 1, 1); PG8_STAGE(PG8_SA(1, 0), a3, voffA);
            PG8_BAR; PG8_WAIT_L(0); PG8_MMA(1, 0, At, B0); PG8_BAR; PG8_SCHED;
            PG8_STAGE(PG8_SB(1, 1), b3 + hstep, voffB);
            PG8_WAIT_V(6); PG8_BAR; PG8_MMA(1, 1, At, B1); PG8_BAR;
            }
        }
        if constexpr (ALIGN_EPI) { if (wr == 0) PG8_BAR; }
        if constexpr (!Epi::AFTER_DRAIN) { E(acc, cur, wr, wc, fr, fq); S.done(cur); }
        if (!has_next) break;
#pragma unroll
        for (int a = 0; a < 2; ++a)
#pragma unroll
            for (int b = 0; b < 2; ++b)
#pragma unroll
                for (int m = 0; m < 4; ++m)
#pragma unroll
                    for (int n = 0; n < 2; ++n) acc[a][b][m][n] = (f32x4){0.f, 0.f, 0.f, 0.f};
        cur = nxt; cA = nA; cB = nB; ++ui;
        if constexpr (ALIGN_EPI) { if (wr == 1) PG8_BAR; }
    }
    PG8_WAIT_V(0);
    if constexpr (!ALIGN_EPI) { if (wr == 0) PG8_BAR; }
    PG8_BAR;
    if constexpr (Epi::AFTER_DRAIN) { E.fused(acc, cur, wr, wc, fr, fq, lds, wid, lane); S.done(cur); }
#undef PG8_SA
#undef PG8_SB
#undef PG8_STAGE
#undef PG8_LDA
#undef PG8_LDB
#undef PG8_MMA
#undef PG8_WAIT_V
#undef PG8_WAIT_L
#undef PG8_BAR
#undef PG8_SCHED
}
}

constexpr int DM = 2048, SEQ = 8192, NSMP = 256, MT = SEQ + NSMP  , DRNN = 1024, BW = 1024, DFF = 8192;
constexpr int NWAVES = 8;
constexpr float RMS_EPS = 1e-6f, LOG2E = 1.4426950408889634f;
constexpr size_t O_YP = 0, O_YS = O_YP + (size_t)SEQ * DM, O_PCONV = O_YS + (size_t)NSMP * DM, O_PLRU = O_PCONV + 2 * 3 * 1024, O_PK = O_PLRU + 2 * 1024, O_PV = O_PK + (size_t)2 * SEQ * 1024,
                 O_SCONV = O_PV + (size_t)2 * SEQ * 1024, O_SLRU = O_SCONV + 2 * 16 * 3 * 1024, O_SK = O_SLRU + 2 * 16 * 1024, O_SV = O_SK + (size_t)2 * NSMP * 1024, O_SGV = O_SV + (size_t)2 * NSMP * 1024,
                 O_END = O_SGV + (size_t)2 * NSMP * 2048;
constexpr size_t MiB = 1u << 20;
constexpr size_t WS_CTL = 0, CTL_ZERO_BYTES = 1 * MiB;
constexpr size_t WS_CS = 1 * MiB;
constexpr size_t WS_WAT = 2 * MiB, WS_WXT = WS_WAT + 256 * 1024, WS_WSB = 3 * MiB;
constexpr size_t WS_WEI = 4 * MiB, WS_WEO = 44 * MiB, WS_WOI = 60 * MiB, WS_WOO = 92 * MiB, WS_WUP = 108 * MiB, WS_WDN = 236 * MiB;
constexpr size_t WS_X = 364 * MiB, WS_XB = 430 * MiB, WS_YC = 463 * MiB;
constexpr size_t WS_T = 496 * MiB;
constexpr size_t WS_H = WS_T;
constexpr size_t WS_G = WS_T, WS_XR = WS_T + 17 * MiB, WS_Q = WS_T + 50 * MiB, WS_KB = WS_T + 67 * MiB, WS_VB = WS_T + 84 * MiB, WS_OS = WS_T + 101 * MiB;
constexpr size_t WS_U = WS_T, WS_VR = WS_T + 33 * MiB;
constexpr size_t WS_SLAB = WS_T + 168 * MiB;
constexpr size_t WS_END = WS_SLAB + 64 * MiB;
static_assert(WS_G == WS_T && WS_XR == WS_T + (17u << 20) && WS_Q == WS_T + (50u << 20) && WS_KB == WS_T + (67u << 20) && WS_VB == WS_T + (84u << 20), "EpiEvenIn offsets");
static_assert(O_PK == 17309696 && O_PV == 34086912 && O_SK == 50995200 && O_SV == 51519488, "EpiEvenIn output offsets");
constexpr int CW_TMO = 0, CW_CODE = 1, CW_BAR = 4096, CW_SSQ = 8192;
constexpr int CW_FIN2 = CW_SSQ + 2 * 11 * MT + 2560;
constexpr int CW_FIN = CW_SSQ + 2 * 11 * MT + 512;
static_assert((CW_FIN + 64 * 9) * 4 <= (int)CTL_ZERO_BYTES, "CTL");
constexpr int RING_BYTES = 131072, LDSCTL_OFF = RING_BYTES, MISC_OFF = LDSCTL_OFF + 320, LDS_BYTES = 147456;

#define GAS __attribute__((address_space(1)))
#define LAS __attribute__((address_space(3)))
typedef unsigned short bf16;
typedef unsigned v4u __attribute__((ext_vector_type(4)));
typedef float f32x4 __attribute__((ext_vector_type(4)));
typedef short bf16x8 __attribute__((ext_vector_type(8)));
typedef GAS unsigned gu32;
typedef GAS unsigned long long gu64;
#define RLX_AGENT __ATOMIC_RELAXED, __HIP_MEMORY_SCOPE_AGENT
#define LDS_WAIT() asm volatile("s_waitcnt lgkmcnt(0)" ::: "memory")
#define VM_WAIT() asm volatile("s_waitcnt vmcnt(0)" ::: "memory")
__device__ __forceinline__ unsigned long long rt() { return __builtin_amdgcn_s_memrealtime(); }
__device__ __forceinline__ unsigned f2bf(float f) { unsigned u = __builtin_bit_cast(unsigned, f); return (u + 0x7fffu + ((u >> 16) & 1u)) >> 16; }
typedef float f32x2_t __attribute__((ext_vector_type(2))); typedef __bf16 bf16x2_t __attribute__((ext_vector_type(2)));
__device__ __forceinline__ unsigned pk2(float lo, float hi) { f32x2_t v = {lo, hi}; bf16x2_t b = __builtin_convertvector(v, bf16x2_t); return __builtin_bit_cast(unsigned, b); }

#define XB_TMO      128
#define XB_XCNT(j)  (256  + 64 * (j))
#define XB_XSUB(j)  (1280 + 64 * (j))
#define XB_XGEN(j)  (2304 + 64 * (j))
#define XB_TOP      3328
#define XB_TOPGEN   3392
#define XCD_BAR_WORDS 3456
#define XB_SPIN_CAP (1u << 18)

__device__ __forceinline__ unsigned xb_ld(unsigned* p)              { return __hip_atomic_load(p, __ATOMIC_RELAXED, __HIP_MEMORY_SCOPE_AGENT); }
__device__ __forceinline__ unsigned xb_add(unsigned* p, unsigned v) { return __hip_atomic_fetch_add(p, v, __ATOMIC_RELAXED, __HIP_MEMORY_SCOPE_AGENT); }
__device__ __forceinline__ unsigned xb_xcc_id() { return (unsigned)__builtin_amdgcn_s_getreg((3 << 11) | 20) & 0xFu; }
#define XB_SPIN(cond, bar) do { unsigned _sp = 0; while (cond) { __builtin_amdgcn_s_sleep(1); \
    if ((++_sp & 255u) == 0u) { if (xb_ld(&(bar)[XB_TMO])) break; if (_sp > XB_SPIN_CAP) { atomicAdd(&(bar)[XB_TMO], 1u); break; } } } } while (0)

struct XcdBarrier {
    unsigned* bar; unsigned x;
    volatile LAS unsigned* st;
};

__device__ __forceinline__ XcdBarrier xcd_barrier_post(unsigned* bar, volatile LAS unsigned* st) {
    XcdBarrier b; b.bar = bar; b.x = xb_xcc_id(); b.st = st;
    if (threadIdx.x == 0) (void)xb_add(&bar[XB_XCNT(b.x)], 1u);
    return b;
}
__device__ __forceinline__ void xcd_barrier_complete(unsigned* bar, unsigned x, unsigned& nloc, unsigned& nx) {
    const unsigned G = gridDim.x * gridDim.y * gridDim.z;
    unsigned sum, cnt, mine, sp = 0u;
    for (;;) {
        sum = 0u; cnt = 0u; mine = 0u;
#pragma unroll
        for (unsigned j = 0; j < 16; ++j) { const unsigned c = xb_ld(&bar[XB_XCNT(j)]); sum += c; cnt += (c > 0u) ? 1u : 0u; mine = (j == x) ? c : mine; }
        if (sum == G) break;
        __builtin_amdgcn_s_sleep(1);
        if ((++sp & 255u) == 0u) { if (xb_ld(&bar[XB_TMO])) break; if (sp > XB_SPIN_CAP) { atomicAdd(&bar[XB_TMO], 1u); break; } }
    }
    nloc = mine > 0u ? mine : 1u; nx = cnt > 0u ? cnt : 1u;
}

__device__ __forceinline__ void xcd_barrier(const XcdBarrier& b) {
    asm volatile("s_waitcnt vmcnt(0)" ::: "memory");
    __syncthreads();
    if (threadIdx.x == 0) {
        unsigned* bar = b.bar;
        __builtin_amdgcn_s_waitcnt(0);
        unsigned nloc = b.st[0], nx = b.st[1];
        if (nloc == 0u) { xcd_barrier_complete(bar, b.x, nloc, nx); b.st[0] = nloc; b.st[1] = nx; }
        const unsigned old = xb_add(&bar[XB_XSUB(b.x)], 1u);
        const unsigned gen = old / nloc;
        if (old + 1u == (gen + 1u) * nloc) {
            __builtin_amdgcn_fence(__ATOMIC_RELEASE, "agent");
            asm volatile("s_waitcnt vmcnt(0)" ::: "memory");
            const unsigned og = xb_add(&bar[XB_TOP], 1u);
            const unsigned tg = og / nx;
            if (og + 1u == (tg + 1u) * nx) xb_add(&bar[XB_TOPGEN], 1u);
            else XB_SPIN(xb_ld(&bar[XB_TOPGEN]) == tg, bar);
            __builtin_amdgcn_fence(__ATOMIC_ACQUIRE, "agent");
            xb_add(&bar[XB_XGEN(b.x)], 1u);
            asm volatile("s_waitcnt vmcnt(0)" ::: "memory");
        } else {
            XB_SPIN(xb_ld(&bar[XB_XGEN(b.x)]) == gen, bar);
            __builtin_amdgcn_fence(__ATOMIC_ACQUIRE, "agent");
            asm volatile("s_waitcnt vmcnt(0)" ::: "memory");
        }
    }
    __syncthreads();
}


struct Args { const float* in[28]; float* out; unsigned char* ws; };
typedef const __attribute__((address_space(4))) Args* ArgsP;
__device__ __forceinline__ ArgsP args_ptr() { ArgsP p = (ArgsP)__builtin_amdgcn_kernarg_segment_ptr(); asm volatile("" : "+s"(p)); return p; }
struct Frame { LAS unsigned char* lds; int tid, lane, wave, vcu, G; };
__device__ __forceinline__ int lane_id() { int l; asm volatile("v_mbcnt_lo_u32_b32 %0, -1, 0\n\tv_mbcnt_hi_u32_b32 %0, -1, %0" : "=v"(l)); return l; }
__device__ __forceinline__ Frame phase_frame(const Frame& F0) { Frame F = F0; int w = F0.wave, v = F0.vcu; asm volatile("" : "+s"(w), "+s"(v)); int ln = lane_id(); F.wave = w; F.vcu = v; F.lane = ln; F.tid = w * 64 + ln; return F; }

__device__ __forceinline__ float wave_sum(float v) { v += pg8::xorl<1>(v); v += pg8::xorl<2>(v); v += pg8::xorl<4>(v); v += pg8::xorl<8>(v); v += pg8::xorl<16>(v); return pg8::sum_x32(v); }
__device__ __forceinline__ float bperm(int srclane, float v) { return __builtin_bit_cast(float, __builtin_amdgcn_ds_bpermute(srclane << 2, __builtin_bit_cast(int, v))); }
__device__ __forceinline__ float bf_lo(unsigned w) { return __uint_as_float(w << 16); }
__device__ __forceinline__ float bf_hi(unsigned w) { return __uint_as_float(w & 0xffff0000u); }
__device__ __forceinline__ float sigmoidf_(float x) { return __builtin_amdgcn_rcpf(1.0f + __builtin_amdgcn_exp2f(-LOG2E * x)); }

struct P0Item { const float* W; const float* sc; bf16* WT; int K, N, k0, n0; };
__host__ __device__ constexpr int p0_layer_items(int l) { return (l & 1) ? 32 * 128 + 32 * 64 + 32 * 256 + 128 * 64 : 32 * 160 + 32 * 64 + 32 * 256 + 128 * 64; }
__device__ __forceinline__ P0Item p0_decode(const ArgsP A, unsigned char* ws, int l, int r) {
    constexpr int I_EO = 32 * 64, I_UP = 32 * 256;
    const int hl = l >> 1, I_IN = (l & 1) ? 32 * 128 : 32 * 160; P0Item P;
    if (r < I_IN) {
        if (l & 1) { P.K = 2048; P.N = 4096; P.W = A->in[18] + (size_t)hl * 2048 * 4096; P.WT = (bf16*)(ws + WS_WOI) + (size_t)hl * 2048 * 4096; }
        else { P.K = 2048; P.N = 5120; P.W = A->in[6] + (size_t)hl * 2048 * 5120; P.WT = (bf16*)(ws + WS_WEI) + (size_t)hl * 2048 * 5120; }
        P.sc = A->in[23] + l * 2048; }
    else if ((r -= I_IN) < I_EO) { P.K = 2048; P.N = 2048; P.W = ((l & 1) ? A->in[19] : A->in[7]) + (size_t)hl * 2048 * 2048; P.WT = (bf16*)(ws + ((l & 1) ? WS_WOO : WS_WEO)) + (size_t)hl * 2048 * 2048; P.sc = nullptr; }
    else if ((r -= I_EO) < I_UP) { P.K = 2048; P.N = 8192; P.W = A->in[26] + (size_t)l * 2048 * 8192; P.WT = (bf16*)(ws + WS_WUP) + (size_t)l * 2048 * 8192; P.sc = A->in[24] + l * 2048; }
    else { r -= I_UP; P.K = 8192; P.N = 2048; P.W = A->in[27] + (size_t)l * 8192 * 2048; P.WT = (bf16*)(ws + WS_WDN) + (size_t)l * 8192 * 2048; P.sc = nullptr; }
    const int nblk = P.N / 32; P.k0 = 64 * (r / nblk); P.n0 = 32 * (r % nblk);
    return P;
}
__device__ __forceinline__ void p0_load(const P0Item& P, f32x4 (&v)[8], int lane) {
    const int kr = lane >> 3, c4 = (lane & 7) * 4;
#pragma unroll
    for (int i = 0; i < 8; ++i) v[i] = __builtin_nontemporal_load((const GAS f32x4*)(P.W + (size_t)(P.k0 + 8 * i + kr) * P.N + P.n0 + c4));
}
__device__ __forceinline__ void p0_finish(const P0Item& P, const f32x4 (&v)[8], LAS float* scr, int lane) {
    const int kr = lane >> 3, c4 = (lane & 7) * 4;
#pragma unroll
    for (int i = 0; i < 8; ++i) { const int kk = 8 * i + kr; const float s = P.sc ? P.sc[P.k0 + kk] : 1.0f; LAS float* d = scr + kk * 33 + c4; d[0] = v[i].x * s; d[1] = v[i].y * s; d[2] = v[i].z * s; d[3] = v[i].w * s; }
    LDS_WAIT(); asm volatile("" ::: "memory");
    const int c = lane & 7;
#pragma unroll
    for (int j = 0; j < 4; ++j) { const int n = (lane >> 3) + 8 * j; const LAS float* s = scr + (8 * c) * 33 + n;
        v4u o; o.x = pk2(s[0 * 33], s[1 * 33]); o.y = pk2(s[2 * 33], s[3 * 33]); o.z = pk2(s[4 * 33], s[5 * 33]); o.w = pk2(s[6 * 33], s[7 * 33]);
        __builtin_nontemporal_store(o, (GAS v4u*)(P.WT + (size_t)(P.n0 + n) * P.K + P.k0 + 8 * c)); }
    LDS_WAIT(); asm volatile("" ::: "memory");
}
__device__ __forceinline__ void p0_prologue(const Frame& F0) {
    const ArgsP A = args_ptr();
    const Frame F = phase_frame(F0);
    LAS float* scr = (LAS float*)(F.lds + F.wave * 16384);
    const int gw = F.vcu * NWAVES + F.wave, NGW = F.G * NWAVES;
    unsigned char* ws = A->ws;
    constexpr int NIT = 32 * 160 + 32 * 64;
    {
        f32x4 va[8], vb[8]; P0Item Pa, Pb;
        int it = gw;
        if (it < NIT) { Pa = p0_decode(A, ws, 0, it); p0_load(Pa, va, F.lane); }
        for (; it < NIT; it += 2 * NGW) {
            const bool hb = it + NGW < NIT;
            if (hb) { Pb = p0_decode(A, ws, 0, it + NGW); p0_load(Pb, vb, F.lane); }
            p0_finish(Pa, va, scr, F.lane);
            if (it + 2 * NGW < NIT) { Pa = p0_decode(A, ws, 0, it + 2 * NGW); p0_load(Pa, va, F.lane); }
            if (hb) p0_finish(Pb, vb, scr, F.lane);
        }
    }
    bf16* Xb = (bf16*)(ws + WS_XB); pg8::ssq_t* ssq0 = (pg8::ssq_t*)((float*)(ws + WS_CTL) + CW_SSQ);
    for (int m = gw; m < MT; m += NGW) {
        const float* src = m < SEQ ? A->in[0] + (size_t)m * DM : A->in[1] + (size_t)(m - SEQ) * DM;
        f32x4 v[8]; float s = 0.f;
#pragma unroll
        for (int j = 0; j < 8; ++j) { v[j] = ((const GAS f32x4*)src)[F.lane + 64 * j]; s += (v[j].x * v[j].x + v[j].y * v[j].y) + (v[j].z * v[j].z + v[j].w * v[j].w); }
        s = wave_sum(s);
#pragma unroll
        for (int j = 0; j < 8; ++j)
            ((GAS unsigned long long*)(Xb + (size_t)m * DM))[F.lane + 64 * j] = (unsigned long long)pk2(v[j].x, v[j].y) | ((unsigned long long)pk2(v[j].z, v[j].w) << 32);
        if (F.lane == 0) ssq0[m] = pg8::ssq_fx(s);
    }
    const int gt = gw * 64 + F.lane, NGT = NGW * 64;
    bf16* waT = (bf16*)(ws + WS_WAT); bf16* wxT = (bf16*)(ws + WS_WXT); bf16* wsb = (bf16*)(ws + WS_WSB);
    for (int idx = gt; idx < 2 * 16 * 64 * 64; idx += NGT) { const int eg = idx >> 12, j = (idx >> 6) & 63, i = idx & 63; const int src = (eg * 64 + i) * 64 + j;
        waT[idx] = (bf16)f2bf(A->in[10][src]); wxT[idx] = (bf16)f2bf(A->in[12][src]); }
    for (int idx = gt; idx < 2 * 16 * 128 * 128; idx += NGT) { const int t = (idx >> 7) & 127, s = idx & 127; wsb[idx] = s <= t ? (bf16)f2bf(A->in[21][idx]) : (bf16)0; }
}

__device__ __forceinline__ void weight_items(const Frame& F0, int l, int first, int n, int cui, int ncu) {
    const ArgsP A = args_ptr();
    const Frame F = phase_frame(F0);
    LAS float* scr = (LAS float*)(F.lds + F.wave * 16384);
    unsigned char* ws = A->ws;
    const int end = first + n, stride = ncu * NWAVES;
    f32x4 va[8], vb[8]; P0Item Pa, Pb;
    int it = first + cui * NWAVES + F.wave;
    if (it < end) { Pa = p0_decode(A, ws, l, it); p0_load(Pa, va, F.lane); }
    for (; it < end; it += 2 * stride) {
        const bool hb = it + stride < end;
        if (hb) { Pb = p0_decode(A, ws, l, it + stride); p0_load(Pb, vb, F.lane); }
        p0_finish(Pa, va, scr, F.lane);
        if (it + 2 * stride < end) { Pa = p0_decode(A, ws, l, it + 2 * stride); p0_load(Pa, va, F.lane); }
        if (hb) p0_finish(Pb, vb, scr, F.lane);
    }
}
constexpr int GE_E1 = 224, GE_O1 = 176, GE_F1 = 216;
__device__ __forceinline__ void conv_phase(const Frame& F, int kind  , int l, int cui, int ncu) {
    constexpr int IE = 32 * 160, IO = 32 * 128, IX = 32 * 64, IU = 32 * 256, ID = 128 * 64;
    int la, fa, na, nb;
    if (kind == 0) { la = l; fa = IE + IX; na = IU; nb = 0; }
    else if (kind == 1) { la = l; fa = IO; na = IX + IU + ID; nb = 0; }
    else if (!(l & 1)) { la = l; fa = IE + IX + IU; na = ID; nb = IO; }
    else { la = l; fa = 0; na = 0; nb = l < 3 ? IE + IX : 0; }
    if (na) weight_items(F, la, fa, na, cui, ncu);
    if (nb) weight_items(F, l + 1, 0, nb, cui, ncu);
}

typedef short bf16x8 __attribute__((ext_vector_type(8)));
typedef float f32x16 __attribute__((ext_vector_type(16)));
template <int PASS>
__device__ __forceinline__ void lru_tasks(const Frame& F0, int e) {
    const ArgsP A = args_ptr();
    const Frame F = phase_frame(F0);
    LAS unsigned char* wl = F.lds + F.wave * 10752;
    LAS unsigned short* xcT = (LAS unsigned short*)wl;
    LAS float* GR = (LAS float*)(wl + 2304);
    LAS float* GI = GR + 1024;
    const int lane = F.lane, j16 = lane & 15, q4 = lane >> 4;
    const int gw = F.vcu * NWAVES + F.wave, NGW = F.G * NWAVES;
    unsigned char* ws = A->ws;
    const float* XR = (const float*)(ws + WS_XR); const bf16* G = (const bf16*)(ws + WS_G); bf16* YC = (bf16*)(ws + WS_YC);
    float* CSA = (float*)(ws + WS_CS); float* CSB = CSA + 128 * 1024;
    const bf16* waT = (const bf16*)(ws + WS_WAT); const bf16* wxT = (const bf16*)(ws + WS_WXT);
    constexpr int NTASK = PASS == 1 ? 2048 : 2304;
    for (int task = gw; task < NTASK; task += NGW) {
        const bool smp = task >= 2048;
        const int g = task & 15, ci = smp ? ((task - 2048) >> 4) : (task >> 4);
        const int R0 = smp ? SEQ + 16 * ci : 64 * ci, ntile = smp ? 1 : 4, chb = 64 * g, c = chb + lane;
        const float cw0 = A->in[8][(e * 4 + 0) * 1024 + c], cw1 = A->in[8][(e * 4 + 1) * 1024 + c], cw2 = A->in[8][(e * 4 + 2) * 1024 + c], cw3 = A->in[8][(e * 4 + 3) * 1024 + c];
        const float cb = A->in[9][e * 1024 + c], ba = A->in[11][e * 1024 + c], bx = A->in[13][e * 1024 + c];
        const float nl8 = -8.0f * LOG2E * log1pf(__expf(-A->in[14][e * 1024 + c]));
        float h = 0.f;
        if (PASS == 2) {
            if (smp) h = A->in[3][(e * 16 + ci) * 1024 + c];
            else {
                const int len = (ci + 7) >> 3;
                float As[8], Bs[8]; float one_ = 1.f, zero_ = 0.f; asm volatile("" : "+v"(one_), "+v"(zero_));
#pragma unroll
                for (int q = 0; q < 8; ++q) { As[q] = one_; Bs[q] = zero_; }
                for (int j0 = 0; j0 < len; j0 += 4) {
                    float av[4][8], bv[4][8];
#pragma unroll
                    for (int dj = 0; dj < 4; ++dj)
#pragma unroll
                        for (int q = 0; q < 8; ++q) { const int jj = q * len + j0 + dj; const bool ok = j0 + dj < len && jj < ci; const int jc = ok ? jj : 0;
                            const float a = ((const GAS float*)CSA)[jc * 1024 + c], bq = ((const GAS float*)CSB)[jc * 1024 + c]; av[dj][q] = ok ? a : one_; bv[dj][q] = ok ? bq : zero_; }
#pragma unroll
                    for (int dj = 0; dj < 4; ++dj)
#pragma unroll
                        for (int q = 0; q < 8; ++q) { Bs[q] = av[dj][q] * Bs[q] + bv[dj][q]; As[q] = av[dj][q] * As[q]; }
                }
#pragma unroll
                for (int q = 0; q < 8; ++q) h = As[q] * h + Bs[q];
            }
        }
        bf16x8 waB[4][2], wxB[4][2];
#pragma unroll
        for (int n = 0; n < 4; ++n)
#pragma unroll
            for (int ks = 0; ks < 2; ++ks) { const size_t off = ((size_t)((e * 16 + g) * 64 + 16 * n + j16)) * 64 + 32 * ks + 8 * q4;
                waB[n][ks] = *(const bf16x8*)(waT + off); wxB[n][ks] = *(const bf16x8*)(wxT + off); }
        float Ac = 1.f, Bc = 0.f;
        float xv[19];
#pragma unroll
        for (int rr = 0; rr < 3; ++rr) {
            if (!smp) { const int row = R0 - 3 + rr; xv[rr] = row >= 0 ? XR[(size_t)row * 1024 + c] : 0.f; }
            else xv[rr] = A->in[2][((e * 16 + ci) * 3 + rr) * 1024 + c];
        }
#pragma unroll
        for (int rr = 0; rr < 16; ++rr) xv[3 + rr] = XR[(size_t)(R0 + rr) * 1024 + c];
        for (int ti = 0; ti < ntile; ++ti) {
            const int t0 = R0 + 16 * ti;
            float xn[16]; unsigned short gv[16];
            if (ti + 1 < ntile) {
#pragma unroll
                for (int rr = 0; rr < 16; ++rr) xn[rr] = XR[(size_t)(t0 + 16 + rr) * 1024 + c];
            }
            if (PASS == 2) {
#pragma unroll
                for (int rr = 0; rr < 16; ++rr) gv[rr] = G[(size_t)(t0 + rr) * 1024 + c];
            }
            float xc[16];
#pragma unroll
            for (int t = 0; t < 16; ++t) { xc[t] = cb + cw0 * xv[t] + cw1 * xv[t + 1] + cw2 * xv[t + 2] + cw3 * xv[t + 3]; xcT[t * 72 + lane] = (unsigned short)f2bf(xc[t]); }
            bf16x8 xa[2];
#pragma unroll
            for (int ks = 0; ks < 2; ++ks) xa[ks] = *(const LAS bf16x8*)((const LAS unsigned char*)xcT + j16 * 144 + (32 * ks + 8 * q4) * 2);
#pragma unroll
            for (int n = 0; n < 4; ++n) { const f32x4 z = {0.f, 0.f, 0.f, 0.f};
                f32x4 ra = __builtin_amdgcn_mfma_f32_16x16x32_bf16(xa[0], waB[n][0], z, 0, 0, 0); ra = __builtin_amdgcn_mfma_f32_16x16x32_bf16(xa[1], waB[n][1], ra, 0, 0, 0);
                f32x4 ia = __builtin_amdgcn_mfma_f32_16x16x32_bf16(xa[0], wxB[n][0], z, 0, 0, 0); ia = __builtin_amdgcn_mfma_f32_16x16x32_bf16(xa[1], wxB[n][1], ia, 0, 0, 0);
#pragma unroll
                for (int v = 0; v < 4; ++v) { GR[(4 * q4 + v) * 64 + 16 * n + j16] = ra[v]; GI[(4 * q4 + v) * 64 + 16 * n + j16] = ia[v]; } }
            f32x4 av[4], uv[4];
#pragma unroll
            for (int q = 0; q < 4; ++q) {
                f32x4 gr, gi, xq;
#pragma unroll
                for (int v = 0; v < 4; ++v) { gr[v] = GR[(4 * q + v) * 64 + lane]; gi[v] = GI[(4 * q + v) * 64 + lane]; xq[v] = xc[4 * q + v]; }
                gr = (gr + ba) * (-LOG2E); gi = (gi + bx) * (-LOG2E);
                f32x4 er, ei;
#pragma unroll
                for (int v = 0; v < 4; ++v) { er[v] = __builtin_amdgcn_exp2f(gr[v]); ei[v] = __builtin_amdgcn_exp2f(gi[v]); }
                er = er + 1.0f; ei = ei + 1.0f;
                f32x4 rr, ig;
#pragma unroll
                for (int v = 0; v < 4; ++v) { rr[v] = __builtin_amdgcn_rcpf(er[v]); ig[v] = __builtin_amdgcn_rcpf(ei[v]); }
                rr = rr * nl8;
                f32x4 a4;
#pragma unroll
                for (int v = 0; v < 4; ++v) a4[v] = __builtin_amdgcn_exp2f(rr[v]);
                f32x4 om = 1.0f - a4 * a4;
#pragma unroll
                for (int v = 0; v < 4; ++v) om[v] = __builtin_amdgcn_sqrtf(fmaxf(om[v], 0.f));
                av[q] = a4; uv[q] = om * ig * xq;
            }
#pragma unroll
            for (int t = 0; t < 16; ++t) {
                const float a = av[t >> 2][t & 3], uu = uv[t >> 2][t & 3];
                if (PASS == 1) { Bc = a * Bc + uu; Ac = a * Ac; }
                else { h = a * h + uu; YC[(size_t)(t0 + t) * 2048 + c] = (bf16)f2bf(__uint_as_float((unsigned)gv[t] << 16) * h); }
            }
#pragma unroll
            for (int rr = 0; rr < 3; ++rr) xv[rr] = xv[16 + rr];
            if (ti + 1 < ntile) {
#pragma unroll
                for (int rr = 0; rr < 16; ++rr) xv[3 + rr] = xn[rr];
            }
        }
        if (PASS == 1) { CSA[ci * 1024 + c] = Ac; CSB[ci * 1024 + c] = Bc; }
        else {
            if (smp) { A->out[O_SLRU + (size_t)(e * 16 + ci) * 1024 + c] = h;
#pragma unroll
                for (int rr = 0; rr < 3; ++rr) A->out[O_SCONV + (size_t)((e * 16 + ci) * 3 + rr) * 1024 + c] = xv[rr]; }
            else if (ci == 127) { A->out[O_PLRU + (size_t)e * 1024 + c] = h;
#pragma unroll
                for (int rr = 0; rr < 3; ++rr) A->out[O_PCONV + (size_t)(e * 3 + rr) * 1024 + c] = xv[rr]; }
        }
    }
}

namespace att {
constexpr int PKT = 8192, PBUF = PKT + 16384;
constexpr int KP = 144, VP = 320, KT = 64 * KP, VT = 64 * VP, BUFB = KT + VT, NBUF = 4  , LUT_OFF = NBUF * BUFB, LUT_N = 832, LUT_Z = 767;
constexpr float NEG = -1e30f;
__device__ __forceinline__ int crow(int r, int hi) { return (r & 3) + 8 * (r >> 2) + 4 * hi; }
__device__ __forceinline__ int rel_bucket(int rel) {
    const int n = rel < 0 ? -rel : rel;
    const int b = n < 8 ? n : (n < 14 ? 8 : n < 23 ? 9 : n < 39 ? 10 : n < 64 ? 11 : n < 108 ? 12 : n < 182 ? 13 : n < 305 ? 14 : 15);
    return (rel > 0 ? 16 : 0) + b;
}
typedef short v4i16_t __attribute__((ext_vector_type(4)));
__device__ __forceinline__ float max3f(float a, float b, float c) { return __builtin_fmaxf(__builtin_fmaxf(a, b), c); }
__device__ __forceinline__ v4i16_t vtr(const LAS unsigned char* p) { return __builtin_amdgcn_ds_read_tr16_b64_v4i16((LAS v4i16_t*)p); }
#define ATT_BAR() do { asm volatile("s_waitcnt lgkmcnt(0)" ::: "memory"); __builtin_amdgcn_s_barrier(); asm volatile("" ::: "memory"); } while (0)

template <bool SAMPLE>
__device__ __forceinline__ void attn_sweep(const Frame& F0, int e, int s, int h, int qi  ) {
    const ArgsP A = args_ptr();
    const Frame F = phase_frame(F0);
    LAS unsigned char* lds = F.lds;
    LAS float* lut = (LAS float*)(lds + LUT_OFF);
    const int tid = F.tid, lane = F.lane, w = F.wave, r32 = lane & 31, hi = lane >> 5;
    unsigned char* ws = A->ws;
    const bf16* Qb = (const bf16*)(ws + WS_Q); const bf16* Kb = (const bf16*)(ws + WS_KB); const bf16* Vb = (const bf16*)(ws + WS_VB);
    bf16* OS = (bf16*)(ws + WS_OS) + (size_t)s * MT * 1024;
    const float* ck = A->in[4] + (size_t)(e * 16 + qi) * 1024 * 1024; const float* cv = A->in[5] + (size_t)(e * 16 + qi) * 1024 * 1024;
    const int NT = SAMPLE ? 17 : 4 * qi + 4;
    const int tfar = SAMPLE ? 10 : (4 * qi - 6 > 0 ? 4 * qi - 6 : 0);
    const int tmax = SAMPLE ? (w == 0 ? 16 : -1) : 4 * qi + (w >> 1);
    const int grow = SAMPLE ? SEQ + 16 * qi + (r32 & 15) : 256 * qi + 32 * w + r32;
    const int qpos = SAMPLE ? 1024 + (r32 & 15) : grow;
    for (int i = tid; i < LUT_N; i += 512) lut[i] = LOG2E * A->in[17][rel_bucket(i - LUT_Z) * 8 + h];
    const float c15 = LOG2E * A->in[17][15 * 8 + h];
    bf16x8 qf[4];
#pragma unroll
    for (int d0 = 0; d0 < 4; ++d0) qf[d0] = *(const bf16x8*)(Qb + (size_t)grow * 1024 + h * 128 + s * 64 + d0 * 16 + hi * 8);
    const int kr = tid >> 3, kc = tid & 7, vr = tid >> 4, vc = tid & 15;
    struct TileRegs { v4u k, v0, v1; };
    TileRegs RA, RB;
    auto load_tile = [&](int t, TileRegs& R) __attribute__((always_inline)) {
        if (!SAMPLE) {
            R.k = *(const v4u*)(Kb + (size_t)(64 * t + kr) * 1024 + h * 128 + s * 64 + kc * 8);
            R.v0 = *(const v4u*)(Vb + (size_t)(64 * t + vr) * 1024 + h * 128 + vc * 8);
            R.v1 = *(const v4u*)(Vb + (size_t)(64 * t + vr + 32) * 1024 + h * 128 + vc * 8);
        } else if (t < 16) {
            { const float* p = ck + (size_t)(64 * t + kr) * 1024 + h * 128 + s * 64 + kc * 8; const f32x4 a = *(const f32x4*)p, b = *(const f32x4*)(p + 4);
              R.k.x = pk2(a.x, a.y); R.k.y = pk2(a.z, a.w); R.k.z = pk2(b.x, b.y); R.k.w = pk2(b.z, b.w); }
            { const float* p = cv + (size_t)(64 * t + vr) * 1024 + h * 128 + vc * 8; const f32x4 a = *(const f32x4*)p, b = *(const f32x4*)(p + 4);
              R.v0.x = pk2(a.x, a.y); R.v0.y = pk2(a.z, a.w); R.v0.z = pk2(b.x, b.y); R.v0.w = pk2(b.z, b.w); }
            { const float* p = cv + (size_t)(64 * t + vr + 32) * 1024 + h * 128 + vc * 8; const f32x4 a = *(const f32x4*)p, b = *(const f32x4*)(p + 4);
              R.v1.x = pk2(a.x, a.y); R.v1.y = pk2(a.z, a.w); R.v1.z = pk2(b.x, b.y); R.v1.w = pk2(b.z, b.w); }
        } else {
            const v4u z = {0u, 0u, 0u, 0u};
            R.k = kr < 16 ? *(const v4u*)(Kb + (size_t)(SEQ + 16 * qi + kr) * 1024 + h * 128 + s * 64 + kc * 8) : z;
            R.v0 = vr < 16 ? *(const v4u*)(Vb + (size_t)(SEQ + 16 * qi + vr) * 1024 + h * 128 + vc * 8) : z;
            R.v1 = z;
        }
    };
    auto store_tile = [&](int boff, const TileRegs& R) __attribute__((always_inline)) {
        LAS unsigned char* Kt = lds + boff; LAS unsigned char* Vt = Kt + KT;
        *(LAS v4u*)(Kt + kr * KP + kc * 16) = R.k;
        *(LAS v4u*)(Vt + vr * VP + vc * 16) = R.v0;
        *(LAS v4u*)(Vt + (vr + 32) * VP + vc * 16) = R.v1;
    };
    constexpr float THR = 8.0f;
    float m = 0.f, l = 0.f, alpha = 1.f; bool resc = false, first = true;
    bf16x8 pb[4];
    f32x16 o[4];
#pragma unroll
    for (int c = 0; c < 4; ++c)
#pragma unroll
        for (int r = 0; r < 16; ++r) o[c][r] = 0.f;
    f32x16 pA0, pA1, pB0, pB1;
    bf16x8 ka[4]; int kboff = 0;
    auto KRD = [&](int boff) __attribute__((always_inline)) {
        const LAS unsigned char* Kt = lds + boff; kboff = boff;
#pragma unroll
        for (int d0 = 0; d0 < 4; ++d0) ka[d0] = *(const LAS bf16x8*)(SAMPLE ? Kt + r32 * KP + d0 * 32 + hi * 16 : Kt + d0 * 2048 + hi * 1024 + r32 * 16);
        __builtin_amdgcn_sched_barrier(0);
    };
    auto QKM = [&](f32x16& d0_, f32x16& d1_, bool nearb) __attribute__((always_inline)) {
        const LAS unsigned char* Kt = lds + kboff;
        bf16x8 kb[4];
#pragma unroll
        for (int d0 = 0; d0 < 4; ++d0) kb[d0] = *(const LAS bf16x8*)(SAMPLE ? Kt + (32 + r32) * KP + d0 * 32 + hi * 16 : Kt + d0 * 2048 + hi * 1024 + 512 + r32 * 16);
        const float ci = (nearb ? 0.f : c15) - m;
#pragma unroll
        for (int r = 0; r < 16; ++r) { d0_[r] = ci; d1_[r] = ci; }
        __builtin_amdgcn_sched_barrier(0);
#pragma unroll
        for (int d0 = 0; d0 < 4; ++d0) d0_ = __builtin_amdgcn_mfma_f32_32x32x16_bf16(ka[d0], qf[d0], d0_, 0, 0, 0);
        __builtin_amdgcn_sched_barrier(0);
#pragma unroll
        for (int d0 = 0; d0 < 4; ++d0) d1_ = __builtin_amdgcn_mfma_f32_32x32x16_bf16(kb[d0], qf[d0], d1_, 0, 0, 0);
        __builtin_amdgcn_sched_barrier(0);
    };
    auto SMA = [&](f32x16& p0, f32x16& p1, int t, bool nearb) __attribute__((always_inline)) {
        if (nearb) {
            const LAS float* lp = lut + (64 * t - qpos + LUT_Z + 4 * hi);
#pragma unroll
            for (int r = 0; r < 16; ++r) { p0[r] += lp[(r & 3) + 8 * (r >> 2)]; p1[r] += lp[32 + (r & 3) + 8 * (r >> 2)]; }
            if (SAMPLE && t == 16) {
#pragma unroll
                for (int r = 0; r < 16; ++r) { if (r >= 8) p0[r] = NEG; p1[r] = NEG; }
            }
        }
        float mx = max3f(p0[0], p0[1], p1[0]), mx2 = max3f(p0[2], p0[3], p1[1]);
#pragma unroll
        for (int r = 2; r < 8; ++r) { mx = max3f(mx, p0[2 * r], p0[2 * r + 1]); mx2 = max3f(mx2, p1[2 * r], p1[2 * r + 1]); }
        mx = max3f(mx, p1[2], p1[3]); mx = fmaxf(mx, mx2);
        mx = pg8::max_x32(mx);
        const bool upd = first || (mx > THR);
        const float delta = upd ? mx : 0.f;
        m += delta; alpha = (upd && !first) ? __builtin_amdgcn_exp2f(-delta) : 1.f;
        first = false;
        resc = __any(upd);
        if (resc) {
#pragma unroll
            for (int r = 0; r < 16; ++r) { p0[r] -= delta; p1[r] -= delta; }
        }
        __builtin_amdgcn_sched_barrier(0);
    };
    auto SMB = [&](f32x16& p0, f32x16& p1) __attribute__((always_inline)) {
        float rsum = 0.f;
#pragma unroll
        for (int r = 0; r < 16; ++r) { p0[r] = __builtin_amdgcn_exp2f(p0[r]); p1[r] = __builtin_amdgcn_exp2f(p1[r]); rsum += p0[r] + p1[r]; }
        rsum = pg8::sum_x32(rsum);
        l = l * alpha + rsum;
        v4u w0, w1, w2, w3;
        w0.x = pk2(p0[0], p0[1]); w0.y = pk2(p0[2], p0[3]); w0.z = pk2(p0[4], p0[5]); w0.w = pk2(p0[6], p0[7]);
        w1.x = pk2(p0[8], p0[9]); w1.y = pk2(p0[10], p0[11]); w1.z = pk2(p0[12], p0[13]); w1.w = pk2(p0[14], p0[15]);
        w2.x = pk2(p1[0], p1[1]); w2.y = pk2(p1[2], p1[3]); w2.z = pk2(p1[4], p1[5]); w2.w = pk2(p1[6], p1[7]);
        w3.x = pk2(p1[8], p1[9]); w3.y = pk2(p1[10], p1[11]); w3.z = pk2(p1[12], p1[13]); w3.w = pk2(p1[14], p1[15]);
        pb[0] = __builtin_bit_cast(bf16x8, w0); pb[1] = __builtin_bit_cast(bf16x8, w1); pb[2] = __builtin_bit_cast(bf16x8, w2); pb[3] = __builtin_bit_cast(bf16x8, w3);
    };
    auto PV = [&](int boff) __attribute__((always_inline)) {
        const LAS unsigned char* Vt = lds + boff + (SAMPLE ? KT : PKT);
        if (resc) {
#pragma unroll
            for (int c = 0; c < 4; ++c)
#pragma unroll
                for (int r = 0; r < 16; ++r) o[c][r] *= alpha;
        }
        const LAS unsigned char* vb = Vt + (4 * hi + ((lane & 15) >> 2)) * (SAMPLE ? VP : 64) + ((lane >> 4) & 1) * 32 + (lane & 3) * 8;
        bf16x8 vfa[4], vfb[4];
#define ATT_RDV(dst, s4) do { _Pragma("unroll") for (int c = 0; c < 4; ++c) { const v4i16_t lo = vtr(SAMPLE ? vb + (16 * (s4)) * VP + 64 * c : vb + (s4) * 1024 + c * 4096), hh = vtr(SAMPLE ? vb + (16 * (s4) + 8) * VP + 64 * c : vb + (s4) * 1024 + 512 + c * 4096); \
            dst[c] = (bf16x8){lo[0], lo[1], lo[2], lo[3], hh[0], hh[1], hh[2], hh[3]}; } } while (0)
#define ATT_PV(src, s4) do { _Pragma("unroll") for (int c = 0; c < 4; ++c) o[c] = __builtin_amdgcn_mfma_f32_32x32x16_bf16(src[c], pb[s4], o[c], 0, 0, 0); } while (0)
        ATT_RDV(vfa, 0); ATT_RDV(vfb, 1); __builtin_amdgcn_sched_barrier(0);
        ATT_PV(vfa, 0); __builtin_amdgcn_sched_barrier(0);
        ATT_RDV(vfa, 2); __builtin_amdgcn_sched_barrier(0);
        ATT_PV(vfb, 1); __builtin_amdgcn_sched_barrier(0);
        ATT_RDV(vfb, 3); __builtin_amdgcn_sched_barrier(0);
        ATT_PV(vfa, 2); __builtin_amdgcn_sched_barrier(0);
        ATT_PV(vfb, 3); __builtin_amdgcn_sched_barrier(0);
#undef ATT_RDV
#undef ATT_PV
    };
    if (!SAMPLE) {
        const bf16* psrc[3]; int pdst[3];
        psrc[0] = Kb + (size_t)lane * 1024 + h * 128 + s * 64 + w * 8; pdst[0] = w * 1024;
#pragma unroll
        for (int i = 1; i < 3; ++i) { const int p = w + 8 * (i - 1);
            psrc[i] = Vb + (size_t)(16 * (p & 3) + (lane >> 2)) * 1024 + h * 128 + (p >> 2) * 32 + (lane & 3) * 8; pdst[i] = PKT + p * 1024; }
        const unsigned lds0 = (unsigned)(uintptr_t)lds;
        auto dma_tile = [&](int t, int boff) __attribute__((always_inline)) {
#pragma unroll
            for (int i = 0; i < 3; ++i) { unsigned keep; const bf16* g = psrc[i] + (size_t)t * 65536; const unsigned d = (unsigned)__builtin_amdgcn_readfirstlane((int)(lds0 + (unsigned)(boff + pdst[i])));
                asm volatile("s_mov_b32 %0, m0\n\ts_mov_b32 m0, %2\n\ts_nop 0\n\tglobal_load_lds_dwordx4 %1, off\n\ts_mov_b32 m0, %0" : "=&s"(keep) : "v"(g), "s"(d) : "memory"); }
        };
        dma_tile(0, 0); dma_tile(1, PBUF); dma_tile(2, 2 * PBUF);
        asm volatile("s_waitcnt vmcnt(3)" ::: "memory");
        ATT_BAR();
        int bcur = 0, bnx = PBUF, bdma = 3 * PBUF;
#define ATT_DMA(t) do { if ((t) + 3 < NT) dma_tile((t) + 3, bdma); } while (0)
#define ATT_END(t) do { if ((t) + 3 < NT) asm volatile("s_waitcnt vmcnt(3)" ::: "memory"); else asm volatile("s_waitcnt vmcnt(0)" ::: "memory"); \
        ATT_BAR(); bcur = bnx; bnx = bnx == 3 * PBUF ? 0 : bnx + PBUF; bdma = bdma == 3 * PBUF ? 0 : bdma + PBUF; } while (0)
        auto NEARADD = [&](f32x16& p0, f32x16& p1, int t) __attribute__((always_inline)) {
            const LAS float* lp = lut + (64 * t - qpos + LUT_Z + 4 * hi);
#pragma unroll
            for (int r = 0; r < 16; ++r) { p0[r] += lp[(r & 3) + 8 * (r >> 2)]; p1[r] += lp[32 + (r & 3) + 8 * (r >> 2)]; }
            __builtin_amdgcn_sched_barrier(0);
        };
        auto ROWMAX = [&](const f32x16& p0, const f32x16& p1) __attribute__((always_inline)) -> float {
            float mx = max3f(p0[0], p0[1], p1[0]), mx2 = max3f(p0[2], p0[3], p1[1]);
#pragma unroll
            for (int r = 2; r < 8; ++r) { mx = max3f(mx, p0[2 * r], p0[2 * r + 1]); mx2 = max3f(mx2, p1[2 * r], p1[2 * r + 1]); }
            mx = max3f(mx, p1[2], p1[3]); return fmaxf(mx, mx2);
        };
        auto REFUPD = [&](f32x16& p0, f32x16& p1, float mx) __attribute__((always_inline)) {
            mx = pg8::max_x32(mx);
            const bool upd = first || (mx > THR);
            const float delta = upd ? mx : 0.f;
            m += delta; alpha = (upd && !first) ? __builtin_amdgcn_exp2f(-delta) : 1.f;
            first = false;
            if (__any(upd)) {
#pragma unroll
                for (int r = 0; r < 16; ++r) { p0[r] -= delta; p1[r] -= delta; }
#pragma unroll
                for (int c = 0; c < 4; ++c)
#pragma unroll
                    for (int r = 0; r < 16; ++r) o[c][r] *= alpha;
            }
            __builtin_amdgcn_sched_barrier(0);
        };
        auto B1 = [&](f32x16& n0, f32x16& n1, bool nearn, f32x16& c0, f32x16& c1) __attribute__((always_inline)) {
            const LAS unsigned char* Kt = lds + kboff;
            bf16x8 kb[4];
#pragma unroll
            for (int d0 = 0; d0 < 4; ++d0) kb[d0] = *(const LAS bf16x8*)(SAMPLE ? Kt + (32 + r32) * KP + d0 * 32 + hi * 16 : Kt + d0 * 2048 + hi * 1024 + 512 + r32 * 16);
            const float ci = (nearn ? 0.f : c15) - m;
#pragma unroll
            for (int r = 0; r < 16; ++r) { n0[r] = ci; n1[r] = ci; }
            __builtin_amdgcn_sched_barrier(0);
            float rs0 = 0.f, rs1 = 0.f; unsigned wq[16];
#define ATT_CH(i, MF) do { MF; \
            c0[2 * (i)] = __builtin_amdgcn_exp2f(c0[2 * (i)]); c0[2 * (i) + 1] = __builtin_amdgcn_exp2f(c0[2 * (i) + 1]); c1[2 * (i)] = __builtin_amdgcn_exp2f(c1[2 * (i)]); c1[2 * (i) + 1] = __builtin_amdgcn_exp2f(c1[2 * (i) + 1]); \
            rs0 += c0[2 * (i)] + c0[2 * (i) + 1]; rs1 += c1[2 * (i)] + c1[2 * (i) + 1]; \
            wq[(i)] = pk2(c0[2 * (i)], c0[2 * (i) + 1]); wq[8 + (i)] = pk2(c1[2 * (i)], c1[2 * (i) + 1]); \
            __builtin_amdgcn_sched_barrier(0); } while (0)
            ATT_CH(0, n0 = __builtin_amdgcn_mfma_f32_32x32x16_bf16(ka[0], qf[0], n0, 0, 0, 0));
            ATT_CH(1, n0 = __builtin_amdgcn_mfma_f32_32x32x16_bf16(ka[1], qf[1], n0, 0, 0, 0));
            ATT_CH(2, n0 = __builtin_amdgcn_mfma_f32_32x32x16_bf16(ka[2], qf[2], n0, 0, 0, 0));
            ATT_CH(3, n0 = __builtin_amdgcn_mfma_f32_32x32x16_bf16(ka[3], qf[3], n0, 0, 0, 0));
            ATT_CH(4, n1 = __builtin_amdgcn_mfma_f32_32x32x16_bf16(kb[0], qf[0], n1, 0, 0, 0));
            ATT_CH(5, n1 = __builtin_amdgcn_mfma_f32_32x32x16_bf16(kb[1], qf[1], n1, 0, 0, 0));
            ATT_CH(6, n1 = __builtin_amdgcn_mfma_f32_32x32x16_bf16(kb[2], qf[2], n1, 0, 0, 0));
            ATT_CH(7, n1 = __builtin_amdgcn_mfma_f32_32x32x16_bf16(kb[3], qf[3], n1, 0, 0, 0));
#undef ATT_CH
            const float rsum = pg8::sum_x32(rs0 + rs1);
            l = l * alpha + rsum;
            { const v4u w0 = {wq[0], wq[1], wq[2], wq[3]}, w1 = {wq[4], wq[5], wq[6], wq[7]}, w2 = {wq[8], wq[9], wq[10], wq[11]}, w3 = {wq[12], wq[13], wq[14], wq[15]};
              pb[0] = __builtin_bit_cast(bf16x8, w0); pb[1] = __builtin_bit_cast(bf16x8, w1); pb[2] = __builtin_bit_cast(bf16x8, w2); pb[3] = __builtin_bit_cast(bf16x8, w3); }
            __builtin_amdgcn_sched_barrier(0);
        };
        auto B2 = [&](int boff, const f32x16& n0, const f32x16& n1) __attribute__((always_inline)) -> float {
            const LAS unsigned char* vb = lds + boff + PKT + (4 * hi + ((lane & 15) >> 2)) * 64 + ((lane >> 4) & 1) * 32 + (lane & 3) * 8;
            bf16x8 vfa[4], vfb[4];
#define ATT_RDV(dst, s4) do { _Pragma("unroll") for (int c = 0; c < 4; ++c) { const v4i16_t lo = vtr(vb + (s4) * 1024 + c * 4096), hh = vtr(vb + (s4) * 1024 + 512 + c * 4096); \
            dst[c] = (bf16x8){lo[0], lo[1], lo[2], lo[3], hh[0], hh[1], hh[2], hh[3]}; } } while (0)
#define ATT_PV(src, s4) do { _Pragma("unroll") for (int c = 0; c < 4; ++c) o[c] = __builtin_amdgcn_mfma_f32_32x32x16_bf16(src[c], pb[s4], o[c], 0, 0, 0); } while (0)
            ATT_RDV(vfa, 0); ATT_RDV(vfb, 1);
            ATT_PV(vfa, 0); ATT_RDV(vfa, 2); ATT_PV(vfb, 1); ATT_RDV(vfb, 3); ATT_PV(vfa, 2); ATT_PV(vfb, 3);
            const float mx = ROWMAX(n0, n1);
            __builtin_amdgcn_sched_group_barrier(0x100, 16, 0);
#pragma unroll
            for (int i = 0; i < 8; ++i) { __builtin_amdgcn_sched_group_barrier(0x008, 1, 0); __builtin_amdgcn_sched_group_barrier(0x100, 2, 0); __builtin_amdgcn_sched_group_barrier(0x002, 2, 0); }
#pragma unroll
            for (int i = 0; i < 8; ++i) { __builtin_amdgcn_sched_group_barrier(0x008, 1, 0); __builtin_amdgcn_sched_group_barrier(0x002, 2, 0); }
            __builtin_amdgcn_sched_barrier(0);
#undef ATT_RDV
#undef ATT_PV
            return mx;
        };
#define ATT_STEP(t, C0, C1, N0, N1) do { ATT_DMA(t); KRD(bnx); \
        B1(N0, N1, (t) + 1 >= tfar, C0, C1); \
        if ((t) + 1 >= tfar) NEARADD(N0, N1, (t) + 1); \
        { const float mx_ = B2(bcur, N0, N1); REFUPD(N0, N1, mx_); } \
        ATT_END(t); } while (0)
        KRD(0); QKM(pA0, pA1, tfar == 0);
        if (0 >= tfar) NEARADD(pA0, pA1, 0);
        { const float mx_ = ROWMAX(pA0, pA1); REFUPD(pA0, pA1, mx_); }
        int t = 0;
        for (; t + 1 < tmax; t += 2) { ATT_STEP(t, pA0, pA1, pB0, pB1); ATT_STEP(t + 1, pB0, pB1, pA0, pA1); }
        if (t < tmax) { ATT_STEP(t, pA0, pA1, pB0, pB1); ATT_DMA(tmax); SMB(pB0, pB1); PV(bcur); ATT_END(tmax); }
        else { ATT_DMA(tmax); SMB(pA0, pA1); PV(bcur); ATT_END(tmax); }
        for (int ti = tmax + 1; ti < NT; ++ti) { asm volatile("s_waitcnt vmcnt(0)" ::: "memory"); ATT_BAR(); }
#undef ATT_STEP
#undef ATT_DMA
#undef ATT_END
    } else if (w == 0) {
        ATT_BAR();
        int bcur = 0, bnx = BUFB, bst = 2 * BUFB;
        KRD(0); QKM(pA0, pA1, false);
#define ATT_SIT(t, C0, C1, N0, N1) do { const bool on_ = (t) < 17, onn_ = (t) + 1 < 17; \
        if (onn_) KRD(bnx); \
        if (on_) SMA(C0, C1, (t), (t) >= tfar); \
        if (onn_) QKM(N0, N1, (t) + 1 >= tfar); \
        if (on_) { SMB(C0, C1); PV(bcur); } \
        ATT_BAR(); { const int x_ = bcur; bcur = bnx; bnx = bst; bst = x_; } } while (0)
        for (int t = 0; t < 18; t += 2) { ATT_SIT(t, pA0, pA1, pB0, pB1); ATT_SIT(t + 1, pB0, pB1, pA0, pA1); }
#undef ATT_SIT
    } else {
        const int lt = tid - 64;
        struct Chunk { f32x4 a, b; };
        Chunk S0[4], S1[4], S2[4];
        auto ldt = [&](int t, Chunk (&S)[4]) __attribute__((always_inline)) {
#pragma unroll
            for (int i = 0; i < 4; ++i) { const int c = lt + 448 * i;
                if (c < 1536) {
                    const bool isk = c < 512; const int cc = isk ? c : c - 512, row = isk ? cc >> 3 : cc >> 4, col = isk ? s * 64 + (cc & 7) * 8 : (cc & 15) * 8;
                    if (t < 16) { const float* p = (isk ? ck : cv) + (size_t)(64 * t + row) * 1024 + h * 128 + col; S[i].a = *(const f32x4*)p; S[i].b = *(const f32x4*)(p + 4); }
                    else {
                        const v4u z = {0u, 0u, 0u, 0u};
                        const v4u r = row < 16 ? *(const v4u*)((isk ? Kb : Vb) + (size_t)(SEQ + 16 * qi + row) * 1024 + h * 128 + col) : z;
                        S[i].a = (f32x4){bf_lo(r.x), bf_hi(r.x), bf_lo(r.y), bf_hi(r.y)}; S[i].b = (f32x4){bf_lo(r.z), bf_hi(r.z), bf_lo(r.w), bf_hi(r.w)}; }
                } }
        };
        auto stt = [&](int boff, const Chunk (&S)[4]) __attribute__((always_inline)) {
#pragma unroll
            for (int i = 0; i < 4; ++i) { const int c = lt + 448 * i;
                if (c < 1536) {
                    const bool isk = c < 512; const int cc = isk ? c : c - 512;
                    v4u wv; wv.x = pk2(S[i].a.x, S[i].a.y); wv.y = pk2(S[i].a.z, S[i].a.w); wv.z = pk2(S[i].b.x, S[i].b.y); wv.w = pk2(S[i].b.z, S[i].b.w);
                    LAS unsigned char* dst = isk ? lds + boff + (cc >> 3) * KP + (cc & 7) * 16 : lds + boff + KT + (cc >> 4) * VP + (cc & 15) * 16;
                    *(LAS v4u*)dst = wv; } }
        };
        ldt(0, S0); ldt(1, S1); ldt(2, S2);
        stt(0, S0); ldt(3, S0);
        stt(BUFB, S1); ldt(4, S1);
        ATT_BAR();
        int bst = 2 * BUFB;
#define ATT_LIT(t, S) do { if ((t) + 2 < 17) { stt(bst, S); if ((t) + 5 < 17) ldt((t) + 5, S); } ATT_BAR(); bst = bst == 2 * BUFB ? 0 : bst + BUFB; } while (0)
        for (int t = 0; t < 18; t += 3) { ATT_LIT(t, S2); ATT_LIT(t + 1, S0); ATT_LIT(t + 2, S1); }
#undef ATT_LIT
    }
    if (tmax >= 0) {
        const float inv = 1.0f / l;
        LAS float* ot = (LAS float*)(lds + w * 8704);
        const int rowbase = SAMPLE ? SEQ + 16 * qi : 256 * qi + 32 * w;
#pragma unroll
        for (int half = 0; half < 2; ++half) {
#pragma unroll
            for (int cc = 0; cc < 2; ++cc)
#pragma unroll
                for (int r = 0; r < 16; ++r) ot[r32 * 68 + 32 * cc + crow(r, hi)] = o[2 * half + cc][r] * inv;
#pragma unroll
            for (int j = 0; j < 4; ++j) { const int id = lane + 64 * j, row = id >> 3, chn = id & 7;
                const f32x4 va = *(const LAS f32x4*)(ot + row * 68 + chn * 8), vb2 = *(const LAS f32x4*)(ot + row * 68 + chn * 8 + 4);
                v4u wv; wv.x = pk2(va.x, va.y); wv.y = pk2(va.z, va.w); wv.z = pk2(vb2.x, vb2.y); wv.w = pk2(vb2.z, vb2.w);
                if (!SAMPLE || row < 16) *(v4u*)(OS + (size_t)(rowbase + row) * 1024 + h * 128 + half * 64 + chn * 8) = wv; }
        }
    }
    ATT_BAR();
}
#undef ATT_BAR
}

__device__ __forceinline__ void attn_combine(const Frame& F0, int e0) {
    const ArgsP A = args_ptr();
    int e = e0; asm volatile("" : "+s"(e));
    const float lam_init = e == 0 ? 0.2f : 0.47071302f;
    const Frame F = phase_frame(F0);
    const int lane = F.lane, gw = F.vcu * NWAVES + F.wave, NGW = F.G * NWAVES;
    const float* lv = A->in[15] + e * 256;
    const float s1 = wave_sum(lv[lane] * lv[64 + lane]), s2 = wave_sum(lv[128 + lane] * lv[192 + lane]);
    const float lam = __expf(s1) - __expf(s2) + lam_init;
    const bf16* OS0 = (const bf16*)(A->ws + WS_OS); const bf16* OS1 = OS0 + (size_t)MT * 1024; bf16* YC = (bf16*)(A->ws + WS_YC);
    const int hd = lane >> 3, d0 = (lane & 7) * 16;
    f32x4 sw[4];
#pragma unroll
    for (int j = 0; j < 4; ++j) sw[j] = *(const f32x4*)(A->in[16] + e * 128 + d0 + 4 * j);
    for (int row0 = gw; row0 < MT; row0 += 5 * NGW) {
        v4u ra[5][2], rb[5][2];
#pragma unroll
        for (int k = 0; k < 5; ++k) { const int row = row0 + k * NGW;
            if (row < MT) { const size_t off = (size_t)row * 1024 + hd * 128 + d0;
#pragma unroll
                for (int j = 0; j < 2; ++j) { ra[k][j] = *(const GAS v4u*)(OS0 + off + 8 * j); rb[k][j] = *(const GAS v4u*)(OS1 + off + 8 * j); } } }
#pragma unroll
        for (int k = 0; k < 5; ++k) { const int row = row0 + k * NGW;
            if (row < MT) {
                f32x4 d[4]; float q = 0.f;
#pragma unroll
                for (int j = 0; j < 2; ++j) { const v4u xa = ra[k][j], xb = rb[k][j];
                    const f32x4 a0 = {bf_lo(xa.x), bf_hi(xa.x), bf_lo(xa.y), bf_hi(xa.y)}, a1 = {bf_lo(xa.z), bf_hi(xa.z), bf_lo(xa.w), bf_hi(xa.w)};
                    const f32x4 b0 = {bf_lo(xb.x), bf_hi(xb.x), bf_lo(xb.y), bf_hi(xb.y)}, b1 = {bf_lo(xb.z), bf_hi(xb.z), bf_lo(xb.w), bf_hi(xb.w)};
                    d[2 * j] = a0 - lam * b0; d[2 * j + 1] = a1 - lam * b1; }
#pragma unroll
                for (int j = 0; j < 4; ++j) q += (d[j].x * d[j].x + d[j].y * d[j].y) + (d[j].z * d[j].z + d[j].w * d[j].w);
                q += pg8::xorl<1>(q); q += pg8::xorl<2>(q); q += pg8::xorl<4>(q);
                const float sc = __builtin_amdgcn_rsqf(q * (1.0f / 128.0f) + RMS_EPS) * (1.0f - lam_init);
                v4u w0, w1;
                { const f32x4 a = d[0] * sw[0] * sc, b = d[1] * sw[1] * sc; w0.x = pk2(a.x, a.y); w0.y = pk2(a.z, a.w); w0.z = pk2(b.x, b.y); w0.w = pk2(b.z, b.w); }
                { const f32x4 a = d[2] * sw[2] * sc, b = d[3] * sw[3] * sc; w1.x = pk2(a.x, a.y); w1.y = pk2(a.z, a.w); w1.z = pk2(b.x, b.y); w1.w = pk2(b.z, b.w); }
                bf16* yp = YC + (size_t)row * 2048 + 1024 + hd * 128 + d0;
                *(GAS v4u*)yp = w0; *(GAS v4u*)(yp + 8) = w1; } }
    }
}

__device__ __forceinline__ void gmlp_phase(const Frame& F0, int o) {
    const ArgsP A = args_ptr();
    const Frame F = phase_frame(F0);
    constexpr int VP = 320, VBUF = 128 * VP;
    constexpr int MP = 272, MOFF = 2 * VBUF;
    const int tid = F.tid, lane = F.lane, w = F.wave, r32 = lane & 31, hi = lane >> 5;
    unsigned char* ws = A->ws;
    const bf16* U = (const bf16*)(ws + WS_U); const bf16* VR = (const bf16*)(ws + WS_VR); bf16* YC = (bf16*)(ws + WS_YC);
    const bf16* wsb = (const bf16*)(ws + WS_WSB);
    const pg8::ssq_t* ssqv = (const pg8::ssq_t*)((const float*)(ws + WS_CTL) + CW_SSQ) + (9 + o) * MT;
    const float* vnw = A->in[20] + o * 2048; const float* bs = A->in[22] + o * 16 * 128;
    const int tb = w & 3, chh = w >> 2, ch = tid & 15;
    LAS unsigned char* Mt = F.lds + MOFF;
    bf16x8 af[8]; float bsv[16]; f32x4 n0, n1; int gcur = -1;
    v4u rawA[4], urawA[4], rawB[4], urawB[4]; pg8::ssq_t rqA[4], rqB[4];
    auto prefetch = [&](int u, v4u (&raw)[4], v4u (&uraw)[4], pg8::ssq_t (&rq)[4]) __attribute__((always_inline)) {
        const bool smp = u >= 1024; const int g = u & 15;
        const int R0 = smp ? SEQ + 16 * ((u - 1024) >> 4) : 128 * (u >> 4), nrows = smp ? 16 : 128;
#pragma unroll
        for (int i = 0; i < 4; ++i) { const int row = (tid + 512 * i) >> 4;
            if (row < nrows) { const size_t grow = (size_t)(R0 + row); raw[i] = *(const GAS v4u*)(VR + grow * 2048 + 128 * g + ch * 8); uraw[i] = *(const GAS v4u*)(U + grow * 2048 + 128 * g + ch * 8); rq[i] = *(const GAS pg8::ssq_t*)(ssqv + grow); } }
    };
    auto unit = [&](int u, int k, v4u (&raw)[4], v4u (&uraw)[4], pg8::ssq_t (&rq)[4]) __attribute__((always_inline)) {
        const bool smp = u >= 1024; const int g = u & 15;
        const int R0 = smp ? SEQ + 16 * ((u - 1024) >> 4) : 128 * (u >> 4), nrows = smp ? 16 : 128;
        LAS unsigned char* Vt = F.lds + (k & 1) * VBUF;
        if (g != gcur) {
            gcur = g;
            const bf16* arow = wsb + ((size_t)(o * 16 + g) * 128 + 32 * tb + r32) * 128 + 8 * hi;
#pragma unroll
            for (int ks = 0; ks < 8; ++ks) af[ks] = *(const bf16x8*)(arow + 16 * ks);
#pragma unroll
            for (int r = 0; r < 16; ++r) bsv[r] = bs[g * 128 + 32 * tb + att::crow(r, hi)];
            n0 = *(const f32x4*)(vnw + 128 * g + ch * 8); n1 = *(const f32x4*)(vnw + 128 * g + ch * 8 + 4);
        }
#pragma unroll
        for (int i = 0; i < 4; ++i) { const int row = (tid + 512 * i) >> 4; v4u wv = {0u, 0u, 0u, 0u};
            if (row < nrows) { const size_t grow = (size_t)(R0 + row); const float rs = pg8::ssq_rstd(rq[i]);
                f32x4 a = {bf_lo(raw[i].x), bf_hi(raw[i].x), bf_lo(raw[i].y), bf_hi(raw[i].y)}, b = {bf_lo(raw[i].z), bf_hi(raw[i].z), bf_lo(raw[i].w), bf_hi(raw[i].w)};
                a = a * rs * n0; b = b * rs * n1;
                if (smp) { float* gv = A->out + O_SGV + ((size_t)o * NSMP + (grow - SEQ)) * 2048 + 128 * g + ch * 8; *(f32x4*)gv = a; *(f32x4*)(gv + 4) = b; }
                wv.x = pk2(a.x, a.y); wv.y = pk2(a.z, a.w); wv.z = pk2(b.x, b.y); wv.w = pk2(b.z, b.w); }
            *(LAS v4u*)(Vt + row * VP + ch * 16) = wv; }
        __syncthreads();
        if (!smp || tb == 0) {
            const LAS unsigned char* vb = Vt + (8 * hi + ((lane & 15) >> 2)) * VP + ((lane >> 4) & 1) * 32 + (lane & 3) * 8;
#pragma unroll
            for (int nn = 0; nn < 2; ++nn) { const int cb = chh * 2 + nn;
                bf16x8 bfr[8];
#pragma unroll
                for (int ks = 0; ks < 8; ++ks) { const att::v4i16_t lo = att::vtr(vb + (16 * ks) * VP + 64 * cb), hh = att::vtr(vb + (16 * ks + 4) * VP + 64 * cb);
                    bfr[ks] = (bf16x8){lo[0], lo[1], lo[2], lo[3], hh[0], hh[1], hh[2], hh[3]}; }
                f32x16 acc;
#pragma unroll
                for (int r = 0; r < 16; ++r) acc[r] = 0.f;
#pragma unroll
                for (int ks = 0; ks < 8; ++ks) acc = __builtin_amdgcn_mfma_f32_32x32x16_bf16(af[ks], bfr[ks], acc, 0, 0, 0);
#pragma unroll
                for (int r = 0; r < 16; ++r) { const int t = 32 * tb + att::crow(r, hi);
                    *(LAS unsigned short*)(Mt + t * MP + (32 * cb + r32) * 2) = (unsigned short)f2bf(acc[r] + bsv[r]); }
            }
        }
        __syncthreads();
#pragma unroll
        for (int i = 0; i < 4; ++i) { const int row = (tid + 512 * i) >> 4;
            if (row < nrows) { const size_t grow = (size_t)(R0 + row); const v4u mx = *(const LAS v4u*)(Mt + row * MP + ch * 16);
                v4u wv;
                wv.x = pk2(bf_lo(uraw[i].x) * bf_lo(mx.x), bf_hi(uraw[i].x) * bf_hi(mx.x)); wv.y = pk2(bf_lo(uraw[i].y) * bf_lo(mx.y), bf_hi(uraw[i].y) * bf_hi(mx.y));
                wv.z = pk2(bf_lo(uraw[i].z) * bf_lo(mx.z), bf_hi(uraw[i].z) * bf_hi(mx.z)); wv.w = pk2(bf_lo(uraw[i].w) * bf_lo(mx.w), bf_hi(uraw[i].w) * bf_hi(mx.w));
                *(v4u*)(YC + grow * 2048 + 128 * g + ch * 8) = wv; } }
            if (u + 2 * F.G < 1280) prefetch(u + 2 * F.G, raw, uraw, rq);
    };
    if (F.vcu < 1280) prefetch(F.vcu, rawA, urawA, rqA);
    if (F.vcu + F.G < 1280) prefetch(F.vcu + F.G, rawB, urawB, rqB);
    for (int u = F.vcu, k = 0; u < 1280; u += 2 * F.G, k += 2) {
        unit(u, k, rawA, urawA, rqA);
        if (u + F.G < 1280) unit(u + F.G, k + 1, rawB, urawB, rqB);
    }
    __syncthreads();
}

__device__ __forceinline__ void final_norm(const Frame& F0) {
    const ArgsP A = args_ptr();
    const Frame F = phase_frame(F0);
    const int gw = F.vcu * NWAVES + F.wave, NGW = F.G * NWAVES;
    const bf16* Xb = (const bf16*)(A->ws + WS_XB); const pg8::ssq_t* ssq = (const pg8::ssq_t*)((const float*)(A->ws + WS_CTL) + CW_SSQ) + 8 * MT;
    f32x4 wv[8];
#pragma unroll
    for (int j = 0; j < 4; ++j) { wv[2 * j] = ((const f32x4*)A->in[25])[2 * (F.lane + 64 * j)]; wv[2 * j + 1] = ((const f32x4*)A->in[25])[2 * (F.lane + 64 * j) + 1]; }
    for (int m = gw; m < SEQ; m += NGW) {
        const float rs = pg8::ssq_rstd(ssq[m]);
        float* dst = A->out + O_YP + (size_t)m * DM;
        v4u rr[4];
#pragma unroll
        for (int j = 0; j < 4; ++j) rr[j] = ((const GAS v4u*)(Xb + (size_t)m * DM))[F.lane + 64 * j];
#pragma unroll
        for (int j = 0; j < 4; ++j) { const v4u r = rr[j];
            const f32x4 a = {bf_lo(r.x), bf_hi(r.x), bf_lo(r.y), bf_hi(r.y)}, b = {bf_lo(r.z), bf_hi(r.z), bf_lo(r.w), bf_hi(r.w)};
            ((f32x4*)dst)[2 * (F.lane + 64 * j)] = a * rs * wv[2 * j]; ((f32x4*)dst)[2 * (F.lane + 64 * j) + 1] = b * rs * wv[2 * j + 1]; }
    }
}

__device__ __forceinline__ void resid_finalize(const Frame& F0, int nsplit, int ssq_idx) {
    const ArgsP A = args_ptr();
    const Frame F = phase_frame(F0);
    unsigned char* ws = A->ws;
    const float* slab = (const float*)(ws + WS_SLAB); bf16* Xb = (bf16*)(ws + WS_XB); pg8::ssq_t* ssq = (pg8::ssq_t*)((float*)(ws + WS_CTL) + CW_SSQ) + (size_t)ssq_idx * MT;
    LAS float* red = (LAS float*)F.lds;
    for (int r = F.vcu; r < NSMP; r += F.G) {
        const size_t grow = (size_t)(SEQ + r); const int c = F.tid * 4;
        const unsigned long long xr = *(const unsigned long long*)(Xb + grow * DM + c);
        f32x4 v = {bf_lo((unsigned)xr), bf_hi((unsigned)xr), bf_lo((unsigned)(xr >> 32)), bf_hi((unsigned)(xr >> 32))};
        for (int ks = 0; ks < nsplit; ks += 8) {
            f32x4 t[8];
#pragma unroll
            for (int j = 0; j < 8; ++j) t[j] = *(const GAS f32x4*)(slab + ((size_t)((ks + j) * 256 + r)) * DM + c);
#pragma unroll
            for (int j = 0; j < 8; ++j) v += t[j];
        }
        *(unsigned long long*)(Xb + grow * DM + c) = (unsigned long long)pk2(v.x, v.y) | ((unsigned long long)pk2(v.z, v.w) << 32);
        const float q = wave_sum((v.x * v.x + v.y * v.y) + (v.z * v.z + v.w * v.w));
        if (F.lane == 0) red[F.wave] = q;
        __syncthreads();
        if (F.tid == 0) { float t = 0.f;
#pragma unroll
            for (int i = 0; i < NWAVES; ++i) t += red[i];
            ssq[grow] = pg8::ssq_fx(t); }
        __syncthreads();
    }
}

__device__ __forceinline__ void final_sample(const Frame& F0) {
    const ArgsP A = args_ptr();
    const Frame F = phase_frame(F0);
    unsigned char* ws = A->ws;
    const float* slab = (const float*)(ws + WS_SLAB); const bf16* Xb = (const bf16*)(ws + WS_XB);
    LAS float* red = (LAS float*)F.lds;
    for (int r = F.vcu; r < NSMP; r += F.G) {
        const size_t grow = (size_t)(SEQ + r); const int c = F.tid * 4;
        const unsigned long long xr = *(const GAS unsigned long long*)(Xb + grow * DM + c);
        const f32x4 wv = *(const GAS f32x4*)(A->in[25] + c);
        f32x4 v = {bf_lo((unsigned)xr), bf_hi((unsigned)xr), bf_lo((unsigned)(xr >> 32)), bf_hi((unsigned)(xr >> 32))};
        for (int ks = 0; ks < 32; ks += 8) {
            f32x4 t[8];
#pragma unroll
            for (int j = 0; j < 8; ++j) t[j] = *(const GAS f32x4*)(slab + ((size_t)((ks + j) * 256 + r)) * DM + c);
#pragma unroll
            for (int j = 0; j < 8; ++j) v += t[j];
        }
        const float q = wave_sum((v.x * v.x + v.y * v.y) + (v.z * v.z + v.w * v.w));
        if (F.lane == 0) red[F.wave] = q;
        __syncthreads();
        float t = 0.f;
#pragma unroll
        for (int i = 0; i < NWAVES; ++i) t += red[i];
        const float rs = pg8::ssq_rstd(pg8::ssq_fx(t));
        const unsigned p0 = pk2(v.x, v.y), p1 = pk2(v.z, v.w);
        const f32x4 xb = {bf_lo(p0), bf_hi(p0), bf_lo(p1), bf_hi(p1)};
        *(GAS f32x4*)(A->out + O_YS + (size_t)r * DM + c) = xb * rs * wv;
        __syncthreads();
    }
}

__device__ __forceinline__ void resid_finalize_pub(const Frame& F0, int nsplit, int ssq_idx, int first, int stride) {
    const ArgsP A = args_ptr();
    const Frame F = phase_frame(F0);
    unsigned char* ws = A->ws;
    const float* slab = (const float*)(ws + WS_SLAB); bf16* Xb = (bf16*)(ws + WS_XB); pg8::ssq_t* ssq = (pg8::ssq_t*)((float*)(ws + WS_CTL) + CW_SSQ) + (size_t)ssq_idx * MT;
    unsigned* cnt = (unsigned*)(ws + WS_CTL) + CW_FIN + 64 * ssq_idx;
    LAS float* red = (LAS float*)F.lds;
    for (int r = first; r < NSMP; r += stride) {
        const size_t grow = (size_t)(SEQ + r); const int c = F.tid * 4;
        const unsigned long long xr = *(const GAS unsigned long long*)(Xb + grow * DM + c);
        f32x4 v = {bf_lo((unsigned)xr), bf_hi((unsigned)xr), bf_lo((unsigned)(xr >> 32)), bf_hi((unsigned)(xr >> 32))};
        for (int ks = 0; ks < nsplit; ks += 4) {
            f32x4 t[4];
#pragma unroll
            for (int j = 0; j < 4; ++j) t[j] = *(const GAS f32x4*)(slab + ((size_t)((ks + j) * 256 + r)) * DM + c);
#pragma unroll
            for (int j = 0; j < 4; ++j) v += t[j];
        }
        __hip_atomic_store((gu64*)(Xb + grow * DM + c), (unsigned long long)pk2(v.x, v.y) | ((unsigned long long)pk2(v.z, v.w) << 32), __ATOMIC_RELAXED, __HIP_MEMORY_SCOPE_AGENT);
        const float q = wave_sum((v.x * v.x + v.y * v.y) + (v.z * v.z + v.w * v.w));
        if (F.lane == 0) red[F.wave] = q;
        __syncthreads();
        if (F.tid == 0) { float t = 0.f;
#pragma unroll
            for (int i = 0; i < NWAVES; ++i) t += red[i];
            __hip_atomic_store((gu64*)(ssq + grow), pg8::ssq_fx(t), __ATOMIC_RELAXED, __HIP_MEMORY_SCOPE_AGENT); }
        asm volatile("s_waitcnt vmcnt(0)" ::: "memory");
        __syncthreads();
        if (F.tid == 0) __hip_atomic_fetch_add(cnt, 1u, __ATOMIC_RELAXED, __HIP_MEMORY_SCOPE_AGENT);
    }
}

__device__ __forceinline__ bool idle_last_round(int nwg, int G, int c) { const int last = (nwg - 1) / G; return c + last * G >= nwg; }
__device__ __forceinline__ int busy_last_round(int nwg, int G) { const int last = (nwg - 1) / G; return nwg - last * G; }
#define SAMPLE_DOWN_IN_NEXT(j_) do { \
    { pg8::Gemm g{(const bf16*)(ws + WS_H), (const bf16*)(ws + WS_WDN) + (size_t)(lq - 1) * 2048 * 8192, MT, 2048, 2048, 8192}; pg8::SplitOrder S{32, 8, 4, 32, (j_)}; \
      pg8::EpiSlab E{(float*)(ws + WS_SLAB), 2048}; \
      pg8::gemm_phase<pg8::EpiSlab, pg8::SplitOrder, true, true>(F.lds, g, S, E, F.wave); } \
    { unsigned* ca_ = (unsigned*)(ws + WS_CTL) + CW_FIN2 + 64 * (2 * lq); \
      __builtin_amdgcn_fence(__ATOMIC_RELEASE, "agent"); asm volatile("s_waitcnt vmcnt(0)" ::: "memory"); __syncthreads(); \
      if (F.wave == 0 && lane_id() == 0) { __hip_atomic_fetch_add(ca_, 1u, __ATOMIC_RELAXED, __HIP_MEMORY_SCOPE_AGENT); unsigned sp_ = 0u; \
          while (__hip_atomic_load(ca_, __ATOMIC_RELAXED, __HIP_MEMORY_SCOPE_AGENT) < 32u) { __builtin_amdgcn_s_sleep(4); if (++sp_ > (1u << 20)) break; } } \
      __syncthreads(); __builtin_amdgcn_fence(__ATOMIC_ACQUIRE, "agent"); asm volatile("s_waitcnt vmcnt(0)" ::: "memory"); } \
    resid_finalize_pub(F, 4, 2 * lq, (j_), 32); } while (0)

__global__ void __launch_bounds__(NWAVES * 64, 2) __attribute__((amdgpu_waves_per_eu(2, 2))) mk_fwd(Args Aval) {
    extern __shared__ __attribute__((aligned(16))) unsigned char lds[];
    Frame F;
    F.lds = (LAS unsigned char*)lds;
    volatile LAS unsigned* MISC = (volatile LAS unsigned*)(F.lds + MISC_OFF);
    F.tid = threadIdx.x; F.lane = F.tid & 63; F.wave = __builtin_amdgcn_readfirstlane(F.tid >> 6);
    F.G = gridDim.x; { const int bx = blockIdx.x; F.vcu = (F.G % 8 == 0) ? (bx % 8) * (F.G / 8) + bx / 8 : bx; }
    for (int u = F.tid; u < (LDS_BYTES - LDSCTL_OFF) / 4; u += NWAVES * 64) ((LAS unsigned*)(F.lds + LDSCTL_OFF))[u] = 0u;
    __syncthreads();
    (void)xcd_barrier_post((unsigned*)(Aval.ws + WS_CTL) + CW_BAR, MISC + 8);
#define GRID_BAR() do { XcdBarrier b_; b_.bar = (unsigned*)(args_ptr()->ws + WS_CTL) + CW_BAR; b_.x = xb_xcc_id(); b_.st = (volatile LAS unsigned*)(F.lds + MISC_OFF) + 8; xcd_barrier(b_); } while (0)
#define PHASE_PTRS() const ArgsP A = args_ptr(); unsigned char* ws = A->ws; pg8::ssq_t* SSQ = (pg8::ssq_t*)((float*)(ws + WS_CTL) + CW_SSQ); (void)SSQ; int bid = blockIdx.x, GG = F.G, lq = l; asm volatile("" : "+s"(bid), "+s"(GG), "+s"(lq))

    p0_prologue(F);
    GRID_BAR();

    for (int l = 0; l < 4; ++l) {
        for (int sub = 0; sub < 2; ++sub) {
            if (sub == 0) {
                if ((l & 1) == 0) {
                    const int e = l >> 1;
                    {
                        PHASE_PTRS();
                        const int GE = GG == 256 ? GE_E1 : GG;
                        if (lq > 0) { const int sj = GE == GG ? F.vcu : bid - GE; if (sj >= 0 && sj < 32) SAMPLE_DOWN_IN_NEXT(sj); }
                        if (bid < GE) {
                            pg8::Gemm g{(const bf16*)(ws + WS_XB), (const bf16*)(ws + WS_WEI) + (size_t)(lq >> 1) * 2048 * 5120, MT, 5120, 2048, 2048};
                            pg8::DepOrder S; S.init(MT, 5120, GE, bid); S.cnt = (unsigned*)(ws + WS_CTL) + CW_FIN + 64 * (2 * lq); S.need = lq > 0 ? NSMP : 0; S.dep_pm = 32; S.tmo = (unsigned*)(ws + WS_CTL) + CW_BAR + XB_TMO;
                            pg8::EpiEvenIn E{SSQ + (2 * lq) * MT, ws + WS_T, A->out, lq >> 1};
                            pg8::gemm_phase<pg8::EpiEvenIn, pg8::DepOrder, true, true>(F.lds, g, S, E, F.wave);
                        } else conv_phase(F, 0, lq, bid - GE, GG - GE);
                        if (GE == GG) conv_phase(F, 0, lq, F.vcu, F.G);
                    }
                    GRID_BAR();
                    {
                        lru_tasks<1>(F, e);
                        __syncthreads();
                        for (int u = F.vcu; u < 256; u += F.G) {
                            const int h = u >> 5, s = (u >> 4) & 1, p = u & 15;
                            const int ord = u % 3;
#pragma nounroll
                            for (int k = 0; k < 3; ++k) {
                                if (k == ord) att::attn_sweep<true>(F, e, s, h, p);
                                if (k < 2) att::attn_sweep<false>(F, e, s, h, k ? p : 31 - p);
                            }
                        }
                    }
                    GRID_BAR();
                    {
                        if (F.vcu & 1) { attn_combine(F, e); lru_tasks<2>(F, e); }
                        else { lru_tasks<2>(F, e); attn_combine(F, e); }
                    }
                } else {
                    const int o = l >> 1;
                    {
                        PHASE_PTRS();
                        const int GE = GG == 256 ? GE_O1 : GG;
                        { const int sj = GE == GG ? F.vcu : bid - GE; if (sj >= 0 && sj < 32) SAMPLE_DOWN_IN_NEXT(sj); }
                        if (bid < GE) {
                            pg8::Gemm g{(const bf16*)(ws + WS_XB), (const bf16*)(ws + WS_WOI) + (size_t)(lq >> 1) * 2048 * 4096, MT, 4096, 2048, 2048};
                            pg8::DepOrder S; S.init(MT, 4096, GE, bid); S.cnt = (unsigned*)(ws + WS_CTL) + CW_FIN + 64 * (2 * lq); S.need = NSMP; S.dep_pm = 32; S.tmo = (unsigned*)(ws + WS_CTL) + CW_BAR + XB_TMO;
                            pg8::EpiOddIn E{SSQ + (2 * lq) * MT, (bf16*)(ws + WS_U), (bf16*)(ws + WS_VR), SSQ + (9 + (lq >> 1)) * MT};
                            pg8::gemm_phase<pg8::EpiOddIn, pg8::DepOrder, true, true>(F.lds, g, S, E, F.wave);
                        } else conv_phase(F, 1, lq, bid - GE, GG - GE);
                        if (GE == GG) conv_phase(F, 1, lq, F.vcu, F.G);
                    }
                    GRID_BAR();
                    gmlp_phase(F, o);
                }
            } else {
              {
                PHASE_PTRS();
                const int GE = GG == 256 ? GE_F1 : GG;
                {
                    const int sj = GE == GG ? F.vcu : bid - GE;
                    if (sj >= 0 && sj < 8) {
                        const bf16* Wt = (lq & 1) == 0 ? (const bf16*)(ws + WS_WEO) + (size_t)(lq >> 1) * 2048 * 2048 : (const bf16*)(ws + WS_WOO) + (size_t)(lq >> 1) * 2048 * 2048;
                        pg8::Gemm g{(const bf16*)(ws + WS_YC), Wt, MT, 2048, 2048, 2048};
                        pg8::StaticOrder S; S.init(MT, 2048, 1 << 20, (25 + sj) * 8 + 7);
                        pg8::EpiResid E{(bf16*)(ws + WS_XB), SSQ + (2 * lq + 1) * MT};
                        pg8::gemm_phase<pg8::EpiResid, pg8::StaticOrder, true, true>(F.lds, g, S, E, F.wave);
                        __builtin_amdgcn_fence(__ATOMIC_RELEASE, "agent");
                        asm volatile("s_waitcnt vmcnt(0)" ::: "memory");
                        __syncthreads();
                        if (F.wave == 0 && lane_id() == 0) __hip_atomic_fetch_add((unsigned*)(ws + WS_CTL) + CW_FIN + 64 * (2 * lq + 1), 1u, __ATOMIC_RELAXED, __HIP_MEMORY_SCOPE_AGENT);
                    }
                }
              }
              {
                PHASE_PTRS();
                const int GE = GG == 256 ? GE_F1 : GG;
                if (bid < GE) {
                    pg8::Gemm g{(const bf16*)(ws + WS_XB), (const bf16*)(ws + WS_WUP) + (size_t)lq * 2048 * 8192, MT, 8192, 2048, 2048};
                    pg8::DepOrder S; S.init(MT, 8192, GE, bid); S.cnt = (unsigned*)(ws + WS_CTL) + CW_FIN + 64 * (2 * lq + 1); S.need = 8; S.dep_pm = 32; S.tmo = (unsigned*)(ws + WS_CTL) + CW_BAR + XB_TMO;
                    pg8::EpiUp E{SSQ + (2 * lq + 1) * MT, (bf16*)(ws + WS_H)};
                    pg8::gemm_phase<pg8::EpiUp, pg8::DepOrder, true, true>(F.lds, g, S, E, F.wave);
                } else if (lq < 3) conv_phase(F, 2, lq, bid - GE, GG - GE);
                if (GE == GG && lq < 3) conv_phase(F, 2, lq, F.vcu, F.G);
              }
            }
            GRID_BAR();
            {
                PHASE_PTRS();
                const bf16* Wt = sub == 0 ? ((lq & 1) == 0 ? (const bf16*)(ws + WS_WEO) + (size_t)(lq >> 1) * 2048 * 2048 : (const bf16*)(ws + WS_WOO) + (size_t)(lq >> 1) * 2048 * 2048)
                                          : (const bf16*)(ws + WS_WDN) + (size_t)lq * 2048 * 8192;
                const int Kf = sub == 0 ? 2048 : 8192;
                const bf16* Ap = sub == 0 ? (const bf16*)(ws + WS_YC) : (const bf16*)(ws + WS_H);
                {
                    pg8::Gemm g{Ap, Wt, SEQ, 2048, Kf, Kf}; pg8::StaticOrder S; S.init(SEQ, 2048, GG, bid);
                    pg8::EpiResid E{(bf16*)(ws + WS_XB), SSQ + (2 * lq + 1 + sub) * MT};
                    pg8::gemm_phase<pg8::EpiResid, pg8::StaticOrder, true, true>(F.lds, g, S, E, F.wave);
                }
                if (sub == 1 && lq == 3) {
                    pg8::Gemm g{Ap, Wt, MT, 2048, 256, Kf}; pg8::SplitOrder S{32, 8, Kf / 256, GG, bid};
                    pg8::EpiSlab E{(float*)(ws + WS_SLAB), 2048};
                    pg8::gemm_phase<pg8::EpiSlab, pg8::SplitOrder, true, true>(F.lds, g, S, E, F.wave);
                }
            }
            GRID_BAR();
        }
    }
    final_sample(F);
    final_norm(F);
}

extern "C" void kernel_launch(void* const* d_in, const int* in_sizes, int n_in, void* d_out, int out_size, void* d_ws, size_t ws_size, hipStream_t stream) {
    static int grid = 0;
    if (grid == 0) {
        if (n_in != 28 || (size_t)out_size != O_END || ws_size < WS_END) { fprintf(stderr, "kernel_launch: unexpected shapes (n_in %d out %d ws %zu)\n", n_in, out_size, ws_size); grid = -1; return; }
        int dev = 0, cus = 0, per_cu = 0;
        if (hipGetDevice(&dev) != hipSuccess || hipDeviceGetAttribute(&cus, hipDeviceAttributeMultiprocessorCount, dev) != hipSuccess) { grid = -1; return; }
        if (hipFuncSetAttribute((const void*)mk_fwd, hipFuncAttributeMaxDynamicSharedMemorySize, LDS_BYTES) != hipSuccess) { fprintf(stderr, "kernel_launch: hipFuncSetAttribute failed\n"); grid = -1; return; }
        if (hipOccupancyMaxActiveBlocksPerMultiprocessor(&per_cu, (const void*)mk_fwd, NWAVES * 64, LDS_BYTES) != hipSuccess || per_cu < 1) { fprintf(stderr, "kernel_launch: occupancy query says %d\n", per_cu); }
        (void)hipGetLastError();
        grid = cus;
    }
    if (grid < 0) return;
    if (hipMemsetAsync((char*)d_ws + WS_CTL, 0, CTL_ZERO_BYTES, stream) != hipSuccess) return;
    Args a{};
    for (int i = 0; i < 28; ++i) a.in[i] = (const float*)d_in[i];
    a.out = (float*)d_out; a.ws = (unsigned char*)d_ws;
    hipLaunchKernelGGL(mk_fwd, dim3(grid), dim3(NWAVES * 64), LDS_BYTES, stream, a);
}
```
